# Optimizing an MI355X kernel written in HIP

```python
import math
import jax, jax.numpy as jnp
from jax import lax
import numpy as np

D_MODEL = 1024
BATCH = 8
SEQ = 4096
DEPTH = 4

N_MIXERS = 4
QB = 128
HEAD_DIM = 64
NORM_EPS = 1e-6
A_PATTERN = ((128, 1), (512, 4), (2048, 16))
A_GROUPS = len(A_PATTERN)
A_HEADS_PER_GROUP = 8
DIFF_HEADS = 8
DIFF_QK_DIM = 64
SUBLN_EPS = 1e-5
MLA_HEADS = 16
MLA_Q_RANK = 384
MLA_KV_RANK = 256
MLA_NOPE_DIM = 64
MLA_ROPE_DIM = 32
MLA_V_DIM = 64
ROPE_THETA = 10000.0
SB_HEADS = 16
D_FF_DENSE = 128 * (-(-(-(-8 * D_MODEL // 3)) // 128))
N_EXPERTS = 8
TOP_K = 2
D_FF_EXPERT = 7 * D_MODEL // 2
MOE_BLOCK = 256

kernel_name = 'hybrid_interleaved_mixer_trunk'


def rmsnorm(x, g, eps=NORM_EPS):
    xf = x.astype(jnp.float32)
    y = xf * lax.rsqrt(jnp.mean(xf * xf, axis=-1, keepdims=True) + eps)
    return (y * g.astype(jnp.float32)).astype(x.dtype)


def alibi_slopes(n):
    return jnp.asarray(2.0 ** (-8.0 * np.arange(1, n + 1) / n), dtype=jnp.float32)


def rope(x, pos):
    half = x.shape[-1] // 2
    inv_freq = ROPE_THETA ** (-jnp.arange(half, dtype=jnp.float32) / half)
    ang = pos.astype(jnp.float32)[:, None] * inv_freq[None, :]
    cos = jnp.cos(ang)[None, :, None, :]
    sin = jnp.sin(ang)[None, :, None, :]
    xf = x.astype(jnp.float32)
    x1, x2 = xf[..., :half], xf[..., half:]
    return jnp.concatenate([x1 * cos - x2 * sin, x1 * sin + x2 * cos], axis=-1).astype(x.dtype)


def sweep_query_blocks(block_fn, batch, seq):
    out = lax.map(block_fn, jnp.arange(seq // QB))
    out = jnp.moveaxis(out, 0, 1)
    return out.reshape((batch, seq) + out.shape[3:])


def causal_rel(j, seq):
    t = j * QB + jnp.arange(QB)
    return t[:, None] - jnp.arange(seq)[None, :]


def dilated_window_attention(q, k, v, window, dilation, slopes):
    B, S, H, dh = q.shape
    taps = window // dilation
    L = S // dilation
    Lp = -(-L // QB) * QB
    nb = Lp // QB

    def by_residue(t):
        t = t.reshape(B, L, dilation, H, dh).transpose(0, 2, 3, 1, 4)
        t = jnp.pad(t, ((0, 0), (0, 0), (0, 0), (0, Lp - L), (0, 0)))
        return t.reshape(B, dilation, H, nb, QB, dh)

    def with_prev(t):
        prev = jnp.pad(t, ((0, 0), (0, 0), (0, 0), (1, 0), (0, 0), (0, 0)))[:, :, :, :-1]
        return jnp.concatenate([prev, t], axis=-2)

    qr = by_residue(q)
    kk = with_prev(by_residue(k))
    vv = with_prev(by_residue(v))
    n_q = jnp.arange(nb)[:, None, None] * QB + jnp.arange(QB)[None, :, None]
    n_k = jnp.arange(nb)[:, None, None] * QB - QB + jnp.arange(2 * QB)[None, None, :]
    rel = n_q - n_k
    valid = (rel >= 0) & (rel <= taps) & (n_k >= 0)
    s = jnp.einsum('bdhnqe,bdhnke->bdhnqk', qr, kk).astype(jnp.float32) * (dh ** -0.5)
    s = s - slopes[None, None, :, None, None, None] * (dilation * rel).astype(jnp.float32)
    s = jnp.where(valid, s, -jnp.inf)
    lse = jax.nn.logsumexp(s, axis=-1)
    p = jnp.exp(s - lse[..., None])
    o = jnp.einsum('bdhnqk,bdhnke->bdhnqe', p.astype(v.dtype), vv)
    o = o.reshape(B, dilation, H, Lp, dh)[:, :, :, :L].transpose(0, 3, 1, 2, 4).reshape(B, S, H, dh)
    lse = lse.reshape(B, dilation, H, Lp)[..., :L].transpose(0, 3, 1, 2).reshape(B, S, H)
    return o, lse


def dilated_mixture_attention(h, w_qkv, w_o):
    B, S, _ = h.shape
    qkv = (h @ w_qkv).reshape(B, S, 3, A_GROUPS, A_HEADS_PER_GROUP, HEAD_DIM)
    slopes = alibi_slopes(A_GROUPS * A_HEADS_PER_GROUP).reshape(A_GROUPS, A_HEADS_PER_GROUP)
    outs, lses = [], []
    for g, (window, dilation) in enumerate(A_PATTERN):
        o, lse = dilated_window_attention(qkv[:, :, 0, g], qkv[:, :, 1, g], qkv[:, :, 2, g],
                                          window, dilation, slopes[g])
        outs.append(o)
        lses.append(lse)
    wgt = jax.nn.softmax(jnp.stack(lses), axis=0)
    mixed = jnp.sum(wgt[..., None].astype(h.dtype) * jnp.stack(outs), axis=0)
    return mixed.reshape(B, S, A_HEADS_PER_GROUP * HEAD_DIM) @ w_o


def differential_attention(h, w_qkv, lq1, lk1, lq2, lk2, subln, w_o, layer):
    B, S, _ = h.shape
    f32 = jnp.float32
    qkv = (h @ w_qkv).reshape(B, S, 3, DIFF_HEADS, 2, DIFF_QK_DIM)
    q, k = qkv[:, :, 0], qkv[:, :, 1]
    v = qkv[:, :, 2].reshape(B, S, DIFF_HEADS, 2 * DIFF_QK_DIM)
    lam_init = 0.8 - 0.6 * math.exp(-0.3 * layer)
    lam = (jnp.exp(jnp.sum(lq1.astype(f32) * lk1.astype(f32)))
           - jnp.exp(jnp.sum(lq2.astype(f32) * lk2.astype(f32))) + lam_init)
    slopes = alibi_slopes(DIFF_HEADS)
    scale = DIFF_QK_DIM ** -0.5

    def block(j):
        qb = lax.dynamic_slice_in_dim(q, j * QB, QB, axis=1)
        s = jnp.einsum('bqhme,bkhme->bhmqk', qb, k).astype(f32) * scale
        rel = causal_rel(j, S)
        s = s - slopes[None, :, None, None, None] * rel.astype(f32)
        s = jnp.where(rel >= 0, s, -jnp.inf)
        p = jax.nn.softmax(s, axis=-1)
        a = p[:, :, 0] - lam * p[:, :, 1]
        return jnp.einsum('bhqk,bkhe->bqhe', a.astype(v.dtype), v)

    o = sweep_query_blocks(block, B, S)
    o = rmsnorm(o, subln, eps=SUBLN_EPS) * (1.0 - lam_init)
    return o.reshape(B, S, DIFF_HEADS * 2 * DIFF_QK_DIM) @ w_o


def latent_attention(h, w_in, q_norm, w_q_up, kv_norm, w_kv_up, w_o):
    B, S, _ = h.shape
    f32 = jnp.float32
    lat = h @ w_in
    q_lat, kv_lat, k_pe = jnp.split(lat, [MLA_Q_RANK, MLA_Q_RANK + MLA_KV_RANK], axis=-1)
    q = (rmsnorm(q_lat, q_norm) @ w_q_up).reshape(B, S, MLA_HEADS, MLA_NOPE_DIM + MLA_ROPE_DIM)
    kv = (rmsnorm(kv_lat, kv_norm) @ w_kv_up).reshape(B, S, MLA_HEADS, MLA_NOPE_DIM + MLA_V_DIM)
    pos = jnp.arange(S)
    q_nope, q_pe = q[..., :MLA_NOPE_DIM], rope(q[..., MLA_NOPE_DIM:], pos)
    k_nope, v = kv[..., :MLA_NOPE_DIM], kv[..., MLA_NOPE_DIM:]
    k_pe = rope(k_pe[:, :, None, :], pos)[:, :, 0]
    scale = (MLA_NOPE_DIM + MLA_ROPE_DIM) ** -0.5

    def block(j):
        qn = lax.dynamic_slice_in_dim(q_nope, j * QB, QB, axis=1)
        qr = lax.dynamic_slice_in_dim(q_pe, j * QB, QB, axis=1)
        s = (jnp.einsum('bqhe,bkhe->bhqk', qn, k_nope)
             + jnp.einsum('bqhr,bkr->bhqk', qr, k_pe)).astype(f32) * scale
        s = jnp.where(causal_rel(j, S) >= 0, s, -jnp.inf)
        p = jax.nn.softmax(s, axis=-1)
        return jnp.einsum('bhqk,bkhe->bqhe', p.astype(v.dtype), v)

    o = sweep_query_blocks(block, B, S)
    return o.reshape(B, S, MLA_HEADS * MLA_V_DIM) @ w_o


def stick_breaking_attention(h, w_qkv, w_o):
    B, S, _ = h.shape
    f32 = jnp.float32
    qkv = (h @ w_qkv).reshape(B, S, 3, SB_HEADS, HEAD_DIM)
    q, k, v = qkv[:, :, 0], qkv[:, :, 1], qkv[:, :, 2]
    scale = HEAD_DIM ** -0.5

    def block(j):
        qb = lax.dynamic_slice_in_dim(q, j * QB, QB, axis=1)
        z = jnp.einsum('bqhe,bkhe->bhqk', qb, k).astype(f32) * scale
        strict = causal_rel(j, S) > 0
        log_keep = jnp.where(strict, jax.nn.log_sigmoid(-z), 0.0)
        tail = lax.cumsum(log_keep, axis=3, reverse=True) - log_keep
        a = jnp.where(strict, jnp.exp(jax.nn.log_sigmoid(z) + tail), 0.0)
        return jnp.einsum('bhqk,bkhe->bqhe', a.astype(v.dtype), v)

    o = sweep_query_blocks(block, B, S)
    return o.reshape(B, S, SB_HEADS * HEAD_DIM) @ w_o


def swiglu(h, w_gate, w_up, w_down):
    return (jax.nn.silu(h @ w_gate) * (h @ w_up)) @ w_down


def moe_swiglu(h, w_router, w_gate, w_up, w_down):
    B, S, D = h.shape
    x2 = h.reshape(-1, D)
    N = x2.shape[0]
    NK = N * TOP_K
    logits = (x2 @ w_router).astype(jnp.float32)
    top_logit, top_e = lax.top_k(logits, TOP_K)
    gates = jax.nn.softmax(top_logit, axis=-1)
    flat_e = top_e.reshape(-1)
    flat_g = gates.reshape(-1)
    flat_tok = jnp.arange(NK, dtype=jnp.int32) // TOP_K
    order = jnp.argsort(flat_e)
    se, stok, sg = flat_e[order], flat_tok[order], flat_g[order]
    counts = jnp.bincount(flat_e, length=N_EXPERTS)
    padded = (counts + MOE_BLOCK - 1) // MOE_BLOCK * MOE_BLOCK
    pad_end = jnp.cumsum(padded)
    pad_start = pad_end - padded
    start = jnp.cumsum(counts) - counts
    dest = pad_start[se] + jnp.arange(NK, dtype=jnp.int32) - start[se]
    n_blocks = -(-NK // MOE_BLOCK) + N_EXPERTS
    slot_tok = jnp.full((n_blocks * MOE_BLOCK,), N, jnp.int32).at[dest].set(stok)
    slot_gate = jnp.zeros((n_blocks * MOE_BLOCK,), jnp.float32).at[dest].set(sg)
    block_e = jnp.minimum(jnp.searchsorted(pad_end, jnp.arange(n_blocks) * MOE_BLOCK, side='right'),
                          N_EXPERTS - 1)
    x_pad = jnp.concatenate([x2, jnp.zeros((1, D), x2.dtype)], axis=0)
    xb = x_pad[slot_tok].reshape(n_blocks, MOE_BLOCK, D)

    def expert_block(args):
        xe, e = args
        return (jax.nn.silu(xe @ w_gate[e]) * (xe @ w_up[e])) @ w_down[e]

    yb = lax.map(expert_block, (xb, block_e)).reshape(-1, D)
    yb = yb * slot_gate[:, None].astype(yb.dtype)
    y = jnp.zeros((N + 1, D), yb.dtype).at[slot_tok].add(yb)
    return y[:N].reshape(B, S, D)


def setup_inputs(seed: int = 0) -> dict:
    key = jax.random.key(seed)
    ks = iter(jax.random.split(key, 64))
    f32 = jnp.float32

    def w(shape, fan_in):
        return jax.random.normal(next(ks), shape, f32) * (fan_in ** -0.5)

    def gain(n):
        return 1.0 + 0.01 * jax.random.normal(next(ks), (n,), f32)

    def small(n):
        return 0.1 * jax.random.normal(next(ks), (n,), f32)

    D = D_MODEL
    a_width = A_GROUPS * A_HEADS_PER_GROUP * HEAD_DIM
    d_width = DIFF_HEADS * 2 * DIFF_QK_DIM
    return {
        'x': jax.random.normal(next(ks), (BATCH, SEQ, D), f32),
        'a_norm': gain(D),
        'a_w_qkv': w((D, 3 * a_width), D),
        'a_w_o': w((A_HEADS_PER_GROUP * HEAD_DIM, D), A_HEADS_PER_GROUP * HEAD_DIM),
        'ffn0_norm': gain(D),
        'ffn0_w_gate': w((D, D_FF_DENSE), D),
        'ffn0_w_up': w((D, D_FF_DENSE), D),
        'ffn0_w_down': w((D_FF_DENSE, D), D_FF_DENSE),
        'b_norm': gain(D),
        'b_w_qkv': w((D, 3 * d_width), D),
        'b_lambda_q1': small(DIFF_QK_DIM),
        'b_lambda_k1': small(DIFF_QK_DIM),
        'b_lambda_q2': small(DIFF_QK_DIM),
        'b_lambda_k2': small(DIFF_QK_DIM),
        'b_subln': gain(2 * DIFF_QK_DIM),
        'b_w_o': w((d_width, D), d_width),
        'moe1_norm': gain(D),
        'moe1_w_router': w((D, N_EXPERTS), D),
        'moe1_w_gate': w((N_EXPERTS, D, D_FF_EXPERT), D),
        'moe1_w_up': w((N_EXPERTS, D, D_FF_EXPERT), D),
        'moe1_w_down': w((N_EXPERTS, D_FF_EXPERT, D), D_FF_EXPERT),
        'c_norm': gain(D),
        'c_w_in': w((D, MLA_Q_RANK + MLA_KV_RANK + MLA_ROPE_DIM), D),
        'c_q_norm': gain(MLA_Q_RANK),
        'c_w_q_up': w((MLA_Q_RANK, MLA_HEADS * (MLA_NOPE_DIM + MLA_ROPE_DIM)), MLA_Q_RANK),
        'c_kv_norm': gain(MLA_KV_RANK),
        'c_w_kv_up': w((MLA_KV_RANK, MLA_HEADS * (MLA_NOPE_DIM + MLA_V_DIM)), MLA_KV_RANK),
        'c_w_o': w((MLA_HEADS * MLA_V_DIM, D), MLA_HEADS * MLA_V_DIM),
        'ffn2_norm': gain(D),
        'ffn2_w_gate': w((D, D_FF_DENSE), D),
        'ffn2_w_up': w((D, D_FF_DENSE), D),
        'ffn2_w_down': w((D_FF_DENSE, D), D_FF_DENSE),
        'd_norm': gain(D),
        'd_w_qkv': w((D, 3 * SB_HEADS * HEAD_DIM), D),
        'd_w_o': w((SB_HEADS * HEAD_DIM, D), SB_HEADS * HEAD_DIM),
        'moe3_norm': gain(D),
        'moe3_w_router': w((D, N_EXPERTS), D),
        'moe3_w_gate': w((N_EXPERTS, D, D_FF_EXPERT), D),
        'moe3_w_up': w((N_EXPERTS, D, D_FF_EXPERT), D),
        'moe3_w_down': w((N_EXPERTS, D_FF_EXPERT, D), D_FF_EXPERT),
        'final_norm': gain(D),
    }


def reference(x, a_norm, a_w_qkv, a_w_o,
              ffn0_norm, ffn0_w_gate, ffn0_w_up, ffn0_w_down,
              b_norm, b_w_qkv, b_lambda_q1, b_lambda_k1, b_lambda_q2, b_lambda_k2, b_subln, b_w_o,
              moe1_norm, moe1_w_router, moe1_w_gate, moe1_w_up, moe1_w_down,
              c_norm, c_w_in, c_q_norm, c_w_q_up, c_kv_norm, c_w_kv_up, c_w_o,
              ffn2_norm, ffn2_w_gate, ffn2_w_up, ffn2_w_down,
              d_norm, d_w_qkv, d_w_o,
              moe3_norm, moe3_w_router, moe3_w_gate, moe3_w_up, moe3_w_down,
              final_norm):
    token_mixers = (
        lambda h, layer: dilated_mixture_attention(h, a_w_qkv, a_w_o),
        lambda h, layer: differential_attention(h, b_w_qkv, b_lambda_q1, b_lambda_k1, b_lambda_q2,
                                                b_lambda_k2, b_subln, b_w_o, layer),
        lambda h, layer: latent_attention(h, c_w_in, c_q_norm, c_w_q_up, c_kv_norm, c_w_kv_up, c_w_o),
        lambda h, layer: stick_breaking_attention(h, d_w_qkv, d_w_o),
    )
    mixer_norms = (a_norm, b_norm, c_norm, d_norm)
    channel_mixers = (
        lambda h: swiglu(h, ffn0_w_gate, ffn0_w_up, ffn0_w_down),
        lambda h: moe_swiglu(h, moe1_w_router, moe1_w_gate, moe1_w_up, moe1_w_down),
        lambda h: swiglu(h, ffn2_w_gate, ffn2_w_up, ffn2_w_down),
        lambda h: moe_swiglu(h, moe3_w_router, moe3_w_gate, moe3_w_up, moe3_w_down),
    )
    channel_norms = (ffn0_norm, moe1_norm, ffn2_norm, moe3_norm)
    for i in range(DEPTH):
        m = i % N_MIXERS
        x = x + token_mixers[m](rmsnorm(x, mixer_norms[m]), i)
        x = x + channel_mixers[i](rmsnorm(x, channel_norms[i]))
    return rmsnorm(x, final_norm)
```

```cpp
#include <hip/hip_runtime.h>
#include <cstdio>
#include <cstdint>
#include <cmath>

namespace pg8 {
#define PG8_LAS __attribute__((address_space(3)))
typedef unsigned short bf16_t;
typedef short bf16x8 __attribute__((ext_vector_type(8)));
typedef float f32x4 __attribute__((ext_vector_type(4)));
typedef unsigned u32x4 __attribute__((ext_vector_type(4)));
constexpr int BM = 256, BK = 64, HALF = 128, HTB = HALF * BK * 2  , STAGE_BYTES = 8 * HTB, NXCD = 8, WGM = 8;

__host__ __device__ __forceinline__ int lds_byte(int r, int c) { const int st = (r >> 4) * 2 + (c >> 5), rr = r & 15, cc = c & 31, ob = rr * 64 + cc * 2; return st * 1024 + (ob ^ (((ob >> 9) & 1) << 5)); }
__host__ __device__ __forceinline__ void stage_rc(int b, int& R, int& C) { const int st = b / 1024, sb = b % 1024, swz = sb ^ (((sb >> 9) & 1) << 5); R = (st >> 1) * 16 + swz / 64; C = (st & 1) * 32 + (swz % 64) / 2; }
__host__ __device__ __forceinline__ int perm32(int rho) { const int n = rho >> 4, i = rho & 15; return 8 * (i >> 2) + 4 * n + (i & 3); }

struct Unit { int pm, pn, e; };
struct Gemm { const bf16_t* A; const bf16_t* Bt; int M, N, K; size_t estride; };

struct StaticOrder {
    int nM, nN, nwg, G, c;
    __host__ __device__ void init(int M, int N, int G_, int c_) { nM = M / BM; nN = N / BM; nwg = nM * nN; G = G_; c = c_; }
    __host__ __device__ bool next(int i, Unit& u) const {
        const long L = (long)i * G + c; if (L >= nwg) return false;
        int wgid = (int)L; { const int q = nwg / NXCD, r = nwg % NXCD, xcd = wgid % NXCD, off = wgid / NXCD; wgid = (xcd < r ? xcd * (q + 1) : r * (q + 1) + (xcd - r) * q) + off; }
        const int nig = WGM * nN, gid = wgid / nig, fm = gid * WGM, gsz = (nM - fm) < WGM ? (nM - fm) : WGM;
        u.pm = fm + ((wgid % nig) % gsz); u.pn = (wgid % nig) / gsz; u.e = 0; return true;
    }
    __device__ __forceinline__ void a_ready(const Unit&) const {}
    __device__ __forceinline__ void done(const Unit&) const {}
};
struct MoeOrder {
    StaticOrder so; int pend[8];
    __device__ __forceinline__ bool next(int i, Unit& u) const {
        if (!so.next(i, u)) return false;
        int e = 0;
#pragma unroll
        for (int j = 0; j < 7; ++j) e += (u.pm >= pend[j]) ? 1 : 0;
        u.e = e; return true;
    }
    __device__ __forceinline__ void a_ready(const Unit&) const {}
    __device__ __forceinline__ void done(const Unit&) const {}
};

__device__ __forceinline__ unsigned cvt_pk_bf16(float lo, float hi) { unsigned r; asm volatile("v_cvt_pk_bf16_f32 %0, %1, %2" : "=v"(r) : "v"(lo), "v"(hi)); return r; }

struct EpiBf16 {
    static constexpr bool PERM = true, AFTER_DRAIN = false;
    bf16_t* O; int ldc;
    __device__ __forceinline__ void operator()(const f32x4 (&acc)[2][2][4][2], const Unit& u, int wr, int wc, int fr, int fq) const {
        const int row0 = u.pm * BM + wr * 64 + fr, col0 = u.pn * BM + wc * 32 + 8 * fq;
#pragma unroll
        for (int ai = 0; ai < 2; ++ai)
#pragma unroll
            for (int m = 0; m < 4; ++m) { bf16_t* rowp = O + (size_t)(row0 + ai * HALF + m * 16) * ldc + col0;
#pragma unroll
                for (int bj = 0; bj < 2; ++bj) { const f32x4 v0 = acc[ai][bj][m][0], v1 = acc[ai][bj][m][1];
                    u32x4 w; w.x = cvt_pk_bf16(v0[0], v0[1]); w.y = cvt_pk_bf16(v0[2], v0[3]); w.z = cvt_pk_bf16(v1[0], v1[1]); w.w = cvt_pk_bf16(v1[2], v1[3]);
                    *(u32x4*)(rowp + bj * HALF) = w; } }
    }
};
__device__ __forceinline__ float silu_mul(float g, float u) { return g * u * __builtin_amdgcn_rcpf(1.0f + __builtin_amdgcn_exp2f(-1.4426950408889634f * g)); }
struct EpiSwiglu {
    static constexpr bool PERM = true, AFTER_DRAIN = false;
    bf16_t* O; int ldc;
    __device__ __forceinline__ void operator()(const f32x4 (&acc)[2][2][4][2], const Unit& u, int wr, int wc, int fr, int fq) const {
        const int row0 = u.pm * BM + wr * 64 + fr, col0 = u.pn * HALF + wc * 32 + 8 * fq;
#pragma unroll
        for (int ai = 0; ai < 2; ++ai)
#pragma unroll
            for (int m = 0; m < 4; ++m) { bf16_t* rowp = O + (size_t)(row0 + ai * HALF + m * 16) * ldc + col0;
                const f32x4 g0 = acc[ai][0][m][0], g1 = acc[ai][0][m][1], u0 = acc[ai][1][m][0], u1 = acc[ai][1][m][1];
                u32x4 w; w.x = cvt_pk_bf16(silu_mul(g0[0], u0[0]), silu_mul(g0[1], u0[1])); w.y = cvt_pk_bf16(silu_mul(g0[2], u0[2]), silu_mul(g0[3], u0[3]));
                w.z = cvt_pk_bf16(silu_mul(g1[0], u1[0]), silu_mul(g1[1], u1[1])); w.w = cvt_pk_bf16(silu_mul(g1[2], u1[2]), silu_mul(g1[3], u1[3]));
                *(u32x4*)rowp = w; }
    }
};
struct EpiResid {
    static constexpr bool PERM = false, AFTER_DRAIN = false;
    const float* base; float* out; int ldc;
    __device__ __forceinline__ void operator()(const f32x4 (&acc)[2][2][4][2], const Unit& u, int wr, int wc, int fr, int fq) const {
        const int row0 = u.pm * BM + wr * 64 + fr, col0 = u.pn * BM + wc * 32 + 4 * fq;
#pragma unroll
        for (int ai = 0; ai < 2; ++ai)
#pragma unroll
            for (int m = 0; m < 4; ++m) { const size_t off = (size_t)(row0 + ai * HALF + m * 16) * ldc + col0;
#pragma unroll
                for (int bj = 0; bj < 2; ++bj)
#pragma unroll
                    for (int n = 0; n < 2; ++n) { const f32x4 b = *(const f32x4*)(base + off + bj * HALF + n * 16); *(f32x4*)(out + off + bj * HALF + n * 16) = b + acc[ai][bj][m][n]; } }
    }
};
struct EpiMoeDown {
    static constexpr bool PERM = true, AFTER_DRAIN = false;
    bf16_t* O; int ldc; const float* gate;
    __device__ __forceinline__ void operator()(const f32x4 (&acc)[2][2][4][2], const Unit& u, int wr, int wc, int fr, int fq) const {
        const int row0 = u.pm * BM + wr * 64 + fr, col0 = u.pn * BM + wc * 32 + 8 * fq;
#pragma unroll
        for (int ai = 0; ai < 2; ++ai)
#pragma unroll
            for (int m = 0; m < 4; ++m) { const int row = row0 + ai * HALF + m * 16; const float gt = gate[row]; bf16_t* rowp = O + (size_t)row * ldc + col0;
#pragma unroll
                for (int bj = 0; bj < 2; ++bj) { const f32x4 v0 = acc[ai][bj][m][0] * gt, v1 = acc[ai][bj][m][1] * gt;
                    u32x4 w; w.x = cvt_pk_bf16(v0[0], v0[1]); w.y = cvt_pk_bf16(v0[2], v0[3]); w.z = cvt_pk_bf16(v1[0], v1[1]); w.w = cvt_pk_bf16(v1[2], v1[3]);
                    *(u32x4*)(rowp + bj * HALF) = w; } }
    }
};
struct EpiRope {
    static constexpr bool PERM = true, AFTER_DRAIN = false;
    bf16_t* O; int ldc; const float* tab; int rope_pn0, seq;
    __device__ __forceinline__ void operator()(const f32x4 (&acc)[2][2][4][2], const Unit& u, int wr, int wc, int fr, int fq) const {
        const int row0 = u.pm * BM + wr * 64 + fr, col0 = u.pn * BM + wc * 32 + 8 * fq;
        if (u.pn < rope_pn0) {
#pragma unroll
            for (int ai = 0; ai < 2; ++ai)
#pragma unroll
                for (int m = 0; m < 4; ++m) { bf16_t* rowp = O + (size_t)(row0 + ai * HALF + m * 16) * ldc + col0;
#pragma unroll
                    for (int bj = 0; bj < 2; ++bj) { const f32x4 v0 = acc[ai][bj][m][0], v1 = acc[ai][bj][m][1];
                        u32x4 w; w.x = cvt_pk_bf16(v0[0], v0[1]); w.y = cvt_pk_bf16(v0[2], v0[3]); w.z = cvt_pk_bf16(v1[0], v1[1]); w.w = cvt_pk_bf16(v1[2], v1[3]);
                        *(u32x4*)(rowp + bj * HALF) = w; } }
        } else {
#pragma unroll
            for (int ai = 0; ai < 2; ++ai)
#pragma unroll
                for (int m = 0; m < 4; ++m) { const int row = row0 + ai * HALF + m * 16; bf16_t* rowp = O + (size_t)row * ldc + col0;
                    const float* t = tab + (size_t)(row % seq) * 32 + 8 * fq; const f32x4 c0 = *(const f32x4*)t, c1 = *(const f32x4*)(t + 4);
#pragma unroll
                    for (int bj = 0; bj < 2; ++bj) { const f32x4 v0 = acc[ai][bj][m][0], v1 = acc[ai][bj][m][1];
                        u32x4 w; w.x = cvt_pk_bf16(v0[0] * c0[0] - v0[1] * c0[1], v0[0] * c0[1] + v0[1] * c0[0]); w.y = cvt_pk_bf16(v0[2] * c0[2] - v0[3] * c0[3], v0[2] * c0[3] + v0[3] * c0[2]);
                        w.z = cvt_pk_bf16(v1[0] * c1[0] - v1[1] * c1[1], v1[0] * c1[1] + v1[1] * c1[0]); w.w = cvt_pk_bf16(v1[2] * c1[2] - v1[3] * c1[3], v1[2] * c1[3] + v1[3] * c1[2]);
                        *(u32x4*)(rowp + bj * HALF) = w; }
                    asm volatile("" ::: "memory"); }
        }
    }
};

template <class Epi, class Sched, bool ALIGN_EPI = false, bool SP2 = false>
__device__ __forceinline__ void gemm_phase(PG8_LAS unsigned char* lds, const Gemm g, const Sched& S, const Epi& E) {
    const int tid = threadIdx.x, wid = __builtin_amdgcn_readfirstlane(tid >> 6), lane = tid & 63, wr = wid >> 2, wc = wid & 3, fr = lane & 15, fq = lane >> 4;
    const int K = g.K, nt = K / BK;
    unsigned voffA[2], voffB[2];
#pragma unroll
    for (int i = 0; i < 2; ++i) { int R, C; stage_rc(tid * 16 + i * 8192, R, C); const int Rb = Epi::PERM ? ((R & ~31) + perm32(R & 31)) : R;
        voffA[i] = (unsigned)(R * K + C) * 2u; voffB[i] = (unsigned)(Rb * K + C) * 2u; }
    const size_t kstep = (size_t)(BK * 2);
    const size_t hstep = (size_t)HALF * K * 2;
    const size_t tstep = 2 * hstep;
    const unsigned ldsw = (unsigned)wid * 1024u;
    const int aoff = lds_byte(wr * 64 + fr, fq * 8), boff = lds_byte(wc * 32 + fr, fq * 8);
#define PG8_SA(b, h) (((b) * 2 + (h)) * HTB)
#define PG8_SB(b, h) ((4 + (b) * 2 + (h)) * HTB)
#define PG8_STAGE(bufoff, gbase, voff) do { _Pragma("unroll") for (int _i = 0; _i < 2; ++_i) \
        __builtin_amdgcn_global_load_lds((const unsigned*)((const char*)(gbase) + (voff)[_i]), (PG8_LAS unsigned*)(lds + (bufoff) + ldsw + _i * 8192), 16, 0, 0); } while (0)
#define PG8_LDA(dst, b, h) do { _Pragma("unroll") for (int m = 0; m < 4; ++m) _Pragma("unroll") for (int k = 0; k < 2; ++k) dst[m][k] = *(const PG8_LAS bf16x8*)(lds + PG8_SA(b, h) + aoff + m * 2048 + k * 1024); } while (0)
#define PG8_LDB(dst, b, h) do { _Pragma("unroll") for (int n = 0; n < 2; ++n) _Pragma("unroll") for (int k = 0; k < 2; ++k) dst[n][k] = *(const PG8_LAS bf16x8*)(lds + PG8_SB(b, h) + boff + n * 2048 + k * 1024); } while (0)
#define PG8_MMA(ai, bj, At, Bt) do { __builtin_amdgcn_s_setprio(1); _Pragma("unroll") for (int m = 0; m < 4; ++m) _Pragma("unroll") for (int n = 0; n < 2; ++n) _Pragma("unroll") for (int k = 0; k < 2; ++k) \
        acc[ai][bj][m][n] = __builtin_amdgcn_mfma_f32_16x16x32_bf16(Bt[n][k], At[m][k], acc[ai][bj][m][n], 0, 0, 0); __builtin_amdgcn_s_setprio(0); } while (0)
#define PG8_WAIT_V(n) asm volatile("s_waitcnt vmcnt(" #n ")" ::: "memory")
#define PG8_WAIT_L(n) asm volatile("s_waitcnt lgkmcnt(" #n ")" ::: "memory")
#define PG8_BAR __builtin_amdgcn_s_barrier()
#define PG8_SCHED __builtin_amdgcn_sched_barrier(0)
    Unit cur, nxt; int ui = 0;
    if (!S.next(0, cur)) return;
    f32x4 acc[2][2][4][2];
#pragma unroll
    for (int a = 0; a < 2; ++a)
#pragma unroll
        for (int b = 0; b < 2; ++b)
#pragma unroll
            for (int m = 0; m < 4; ++m)
#pragma unroll
                for (int n = 0; n < 2; ++n) acc[a][b][m][n] = (f32x4){0.f, 0.f, 0.f, 0.f};
    bf16x8 At[4][2], B0[2][2], B1[2][2];
    const char* cA = (const char*)g.A + (size_t)cur.pm * tstep; const char* cB = (const char*)g.Bt + (size_t)cur.e * g.estride + (size_t)cur.pn * tstep;
    S.a_ready(cur);
    if constexpr (SP2) {
        PG8_STAGE(PG8_SB(0, 0), cB, voffB); PG8_STAGE(PG8_SB(0, 1), cB + hstep, voffB); PG8_STAGE(PG8_SA(0, 0), cA, voffA); PG8_STAGE(PG8_SA(0, 1), cA + hstep, voffA);
        if (wr == 1) PG8_BAR;
        PG8_WAIT_V(2); PG8_BAR;
        PG8_STAGE(PG8_SB(1, 0), cB + kstep, voffB); PG8_STAGE(PG8_SA(1, 0), cA + kstep, voffA); PG8_STAGE(PG8_SB(1, 1), cB + hstep + kstep, voffB);
        PG8_WAIT_V(6); PG8_BAR;
    } else {
        PG8_STAGE(PG8_SB(0, 0), cB, voffB); PG8_STAGE(PG8_SA(0, 0), cA, voffA); PG8_STAGE(PG8_SB(0, 1), cB + hstep, voffB); PG8_STAGE(PG8_SA(0, 1), cA + hstep, voffA);
        if (wr == 1) PG8_BAR;
        PG8_WAIT_V(4); PG8_BAR;
        PG8_STAGE(PG8_SB(1, 0), cB + kstep, voffB); PG8_STAGE(PG8_SA(1, 0), cA + kstep, voffA); PG8_STAGE(PG8_SB(1, 1), cB + hstep + kstep, voffB);
        PG8_WAIT_V(6); PG8_BAR;
    }
    for (;;) {
        const bool has_next = S.next(ui + 1, nxt);
        const char* nA = has_next ? (const char*)g.A + (size_t)nxt.pm * tstep : cA; const char* nB = has_next ? (const char*)g.Bt + (size_t)nxt.e * g.estride + (size_t)nxt.pn * tstep : cB;
        for (int t = 0; t < nt; t += 2) {
            const bool last = (t == nt - 2);
            const char* a1 = cA + (size_t)(t + 1) * kstep;
            const char* a2 = last ? nA : cA + (size_t)(t + 2) * kstep; const char* b2 = last ? nB : cB + (size_t)(t + 2) * kstep;
            const char* a3 = a2 + kstep; const char* b3 = b2 + kstep;
            if (last && has_next) S.a_ready(nxt);
            if constexpr (SP2) {
            PG8_LDB(B0, 0, 0); PG8_LDB(B1, 0, 1); PG8_SCHED; PG8_LDA(At, 0, 0); PG8_STAGE(PG8_SA(1, 1), a1 + hstep, voffA);
            PG8_WAIT_V(8); PG8_WAIT_L(0); PG8_BAR; PG8_MMA(0, 0, At, B0); PG8_MMA(0, 1, At, B1); PG8_BAR; PG8_SCHED;
            PG8_LDA(At, 0, 1); PG8_STAGE(PG8_SB(0, 0), b2, voffB); PG8_STAGE(PG8_SB(0, 1), b2 + hstep, voffB); PG8_STAGE(PG8_SA(0, 0), a2, voffA);
            PG8_WAIT_V(8); PG8_WAIT_L(0); PG8_BAR; PG8_MMA(1, 0, At, B0); PG8_MMA(1, 1, At, B1); PG8_BAR; PG8_SCHED;
            PG8_LDB(B0, 1, 0); PG8_LDB(B1, 1, 1); PG8_SCHED; PG8_LDA(At, 1, 0); PG8_STAGE(PG8_SA(0, 1), a2 + hstep, voffA);
            PG8_WAIT_V(8); PG8_WAIT_L(0); PG8_BAR; PG8_MMA(0, 0, At, B0); PG8_MMA(0, 1, At, B1); PG8_BAR; PG8_SCHED;
            PG8_LDA(At, 1, 1); PG8_STAGE(PG8_SB(1, 0), b3, voffB); PG8_STAGE(PG8_SB(1, 1), b3 + hstep, voffB); PG8_STAGE(PG8_SA(1, 0), a3, voffA);
            PG8_WAIT_V(8); PG8_WAIT_L(0); PG8_BAR; PG8_MMA(1, 0, At, B0); PG8_MMA(1, 1, At, B1); PG8_BAR; PG8_SCHED;
            } else {
            PG8_LDB(B0, 0, 0); PG8_SCHED; PG8_LDA(At, 0, 0); PG8_STAGE(PG8_SA(1, 1), a1 + hstep, voffA);
            PG8_WAIT_L(8); PG8_BAR; PG8_WAIT_L(0); PG8_MMA(0, 0, At, B0); PG8_BAR; PG8_SCHED;
            PG8_LDB(B1, 0, 1); PG8_STAGE(PG8_SB(0, 0), b2, voffB);
            PG8_BAR; PG8_WAIT_L(0); PG8_MMA(0, 1, At, B1); PG8_BAR;
            PG8_LDA(At, 0, 1); PG8_STAGE(PG8_SA(0, 0), a2, voffA);
            PG8_BAR; PG8_WAIT_L(0); PG8_MMA(1, 0, At, B0); PG8_BAR; PG8_SCHED;
            PG8_STAGE(PG8_SB(0, 1), b2 + hstep, voffB);
            PG8_WAIT_V(6); PG8_BAR; PG8_MMA(1, 1, At, B1); PG8_BAR;
            PG8_LDB(B0, 1, 0); PG8_SCHED; PG8_LDA(At, 1, 0); PG8_STAGE(PG8_SA(0, 1), a2 + hstep, voffA);
            PG8_WAIT_L(8); PG8_BAR; PG8_WAIT_L(0); PG8_MMA(0, 0, At, B0); PG8_BAR; PG8_SCHED;
            PG8_LDB(B1, 1, 1); PG8_STAGE(PG8_SB(1, 0), b3, voffB);
            PG8_BAR; PG8_WAIT_L(0); PG8_MMA(0, 1, At, B1); PG8_BAR;
            PG8_LDA(At, 1, 1); PG8_STAGE(PG8_SA(1, 0), a3, voffA);
            PG8_BAR; PG8_WAIT_L(0); PG8_MMA(1, 0, At, B0); PG8_BAR; PG8_SCHED;
            PG8_STAGE(PG8_SB(1, 1), b3 + hstep, voffB);
            PG8_WAIT_V(6); PG8_BAR; PG8_MMA(1, 1, At, B1); PG8_BAR;
            }
        }
        if constexpr (ALIGN_EPI) { if (wr == 0) PG8_BAR; }
        if constexpr (!Epi::AFTER_DRAIN) { E(acc, cur, wr, wc, fr, fq); S.done(cur); }
        if (!has_next) break;
#pragma unroll
        for (int a = 0; a < 2; ++a)
#pragma unroll
            for (int b = 0; b < 2; ++b)
#pragma unroll
                for (int m = 0; m < 4; ++m)
#pragma unroll
                    for (int n = 0; n < 2; ++n) acc[a][b][m][n] = (f32x4){0.f, 0.f, 0.f, 0.f};
        cur = nxt; cA = nA; cB = nB; ++ui;
        if constexpr (ALIGN_EPI) { if (wr == 1) PG8_BAR; }
    }
    PG8_WAIT_V(0);
    if constexpr (!ALIGN_EPI) { if (wr == 0) PG8_BAR; }
    PG8_BAR;
    if constexpr (Epi::AFTER_DRAIN) { E.fused(acc, cur, wr, wc, fr, fq, lds, wid, lane); S.done(cur); }
#undef PG8_SA
#undef PG8_SB
#undef PG8_STAGE
#undef PG8_LDA
#undef PG8_LDB
#undef PG8_MMA
#undef PG8_WAIT_V
#undef PG8_WAIT_L
#undef PG8_BAR
#undef PG8_SCHED
}
}
#ifndef PG8_SP2
#define PG8_SP2 true
#endif
#ifndef PG8_ALIGN
#define PG8_ALIGN true
#endif

constexpr int NWAVES = 8;
constexpr int BATCH = 8, SEQ = 4096, DM = 1024, NTOK = BATCH * SEQ;
constexpr int FFD = 2816, FFE = 3584, NEXP = 8;
constexpr int NSLOT = (NTOK * 2 / 256 + NEXP) * 256;
constexpr float NORM_EPS = 1e-6f, SUBLN_EPS = 1e-5f, LOG2E = 1.4426950408889634f;
constexpr int N_IN = 41;
enum { I_X = 0, I_A_NORM, I_A_WQKV, I_A_WO, I_F0_NORM, I_F0_WG, I_F0_WU, I_F0_WD, I_B_NORM, I_B_WQKV, I_B_LQ1, I_B_LK1, I_B_LQ2, I_B_LK2, I_B_SUBLN, I_B_WO,
       I_M1_NORM, I_M1_WR, I_M1_WG, I_M1_WU, I_M1_WD, I_C_NORM, I_C_WIN, I_C_QNORM, I_C_WQUP, I_C_KVNORM, I_C_WKVUP, I_C_WO, I_F2_NORM, I_F2_WG, I_F2_WU, I_F2_WD,
       I_D_NORM, I_D_WQKV, I_D_WO, I_M3_NORM, I_M3_WR, I_M3_WG, I_M3_WU, I_M3_WD, I_FINAL_NORM };

constexpr size_t MiB = 1ull << 20, KiB = 1024;
constexpr size_t WS_CTL = 0, CTL_ZERO_BYTES = 1 * MiB;
constexpr size_t WS_ROPE = 1 * MiB;
constexpr size_t WS_WGCNT = 1 * MiB + 512 * KiB;
constexpr size_t WS_TOKE = 2 * MiB, WS_TOKG = WS_TOKE + 256 * KiB, WS_TOKS = WS_TOKG + 256 * KiB;
constexpr size_t WS_SGATE = 3 * MiB;
constexpr size_t WS_W = 4 * MiB;
constexpr size_t W_QKV_A = WS_W, W_O_A = WS_W + 9 * MiB, W_GU0 = WS_W + 10 * MiB, W_D0 = WS_W + 21 * MiB, W_QKV_B = WS_W + 27 * MiB, W_O_B = WS_W + 33 * MiB,
                 W_IN_C = WS_W + 35 * MiB, W_QUP_C = WS_W + 37 * MiB, W_KVUP_C = WS_W + 39 * MiB, W_O_C = WS_W + 40 * MiB, W_GU2 = WS_W + 42 * MiB, W_D2 = WS_W + 53 * MiB,
                 W_QKV_D = WS_W + 59 * MiB, W_O_D = WS_W + 65 * MiB;
constexpr size_t W_MOE_GU = 72 * MiB, W_MOE_D = 184 * MiB;
constexpr size_t WS_H = 240 * MiB;
constexpr size_t WS_XB = 304 * MiB;
constexpr size_t WS_BIG = 436 * MiB;
constexpr size_t WS_END = 898 * MiB;
static_assert(WS_BIG + (size_t)NSLOT * FFE * 2 <= WS_END && WS_XB + (size_t)NSLOT * DM * 2 <= WS_BIG && WS_H + (size_t)NTOK * DM * 2 <= WS_XB && W_MOE_D + 8ull * 1024 * 3584 * 2 <= WS_H, "d_ws map");
constexpr size_t C_LAT = WS_BIG, C_Q = WS_BIG + 48 * MiB, C_KV = WS_BIG + 144 * MiB;
constexpr size_t C_QN = WS_XB, C_KVN = WS_XB + 24 * MiB, C_KPE = WS_XB + 40 * MiB;
constexpr int CW_TMO = 0, CW_BAR = 4096;

constexpr int RING_OFF = 0, RING_BYTES = 131072;
constexpr int MISC_OFF = RING_BYTES + 320;
constexpr int LDS_BYTES = 147456;
#define GAS __attribute__((address_space(1)))
#define LAS __attribute__((address_space(3)))
typedef unsigned short bf16;
typedef unsigned v4u __attribute__((ext_vector_type(4)));
typedef float f32x4 __attribute__((ext_vector_type(4)));
typedef short bf16x8 __attribute__((ext_vector_type(8)));
typedef GAS unsigned gu32;
typedef GAS unsigned long long gu64;
#define RLX_AGENT __ATOMIC_RELAXED, __HIP_MEMORY_SCOPE_AGENT
#define LDS_WAIT() asm volatile("s_waitcnt lgkmcnt(0)" ::: "memory")
#define VM_WAIT() asm volatile("s_waitcnt vmcnt(0)" ::: "memory")
__device__ __forceinline__ unsigned long long rt() { return __builtin_amdgcn_s_memrealtime(); }
__device__ __forceinline__ unsigned f2bf(float f) { unsigned u = __builtin_bit_cast(unsigned, f); return (u + 0x7fffu + ((u >> 16) & 1u)) >> 16; }
__device__ __forceinline__ unsigned pk2(float lo, float hi) { return f2bf(lo) | (f2bf(hi) << 16); }

#define XB_TMO      128
#define XB_XCNT(j)  (256  + 64 * (j))
#define XB_XSUB(j)  (1280 + 64 * (j))
#define XB_XGEN(j)  (2304 + 64 * (j))
#define XB_TOP      3328
#define XB_TOPGEN   3392
#define XCD_BAR_WORDS 3456
#define XB_SPIN_CAP (1u << 18)

__device__ __forceinline__ unsigned xb_ld(unsigned* p)              { return __hip_atomic_load(p, __ATOMIC_RELAXED, __HIP_MEMORY_SCOPE_AGENT); }
__device__ __forceinline__ unsigned xb_add(unsigned* p, unsigned v) { return __hip_atomic_fetch_add(p, v, __ATOMIC_RELAXED, __HIP_MEMORY_SCOPE_AGENT); }
__device__ __forceinline__ unsigned xb_xcc_id() { return (unsigned)__builtin_amdgcn_s_getreg((3 << 11) | 20) & 0xFu; }
#define XB_SPIN(cond, bar) do { unsigned _sp = 0; while (cond) { __builtin_amdgcn_s_sleep(1); \
    if ((++_sp & 255u) == 0u) { if (xb_ld(&(bar)[XB_TMO])) break; if (_sp > XB_SPIN_CAP) { atomicAdd(&(bar)[XB_TMO], 1u); break; } } } } while (0)

struct XcdBarrier {
    unsigned* bar; unsigned x;
    volatile LAS unsigned* st;
};

__device__ __forceinline__ XcdBarrier xcd_barrier_post(unsigned* bar, volatile LAS unsigned* st) {
    XcdBarrier b; b.bar = bar; b.x = xb_xcc_id(); b.st = st;
    if (threadIdx.x == 0) (void)xb_add(&bar[XB_XCNT(b.x)], 1u);
    return b;
}
__device__ __forceinline__ void xcd_barrier_complete(unsigned* bar, unsigned x, unsigned& nloc, unsigned& nx) {
    const unsigned G = gridDim.x * gridDim.y * gridDim.z;
    unsigned sum, cnt, mine, sp = 0u;
    for (;;) {
        sum = 0u; cnt = 0u; mine = 0u;
#pragma unroll
        for (unsigned j = 0; j < 16; ++j) { const unsigned c = xb_ld(&bar[XB_XCNT(j)]); sum += c; cnt += (c > 0u) ? 1u : 0u; mine = (j == x) ? c : mine; }
        if (sum == G) break;
        __builtin_amdgcn_s_sleep(1);
        if ((++sp & 255u) == 0u) { if (xb_ld(&bar[XB_TMO])) break; if (sp > XB_SPIN_CAP) { atomicAdd(&bar[XB_TMO], 1u); break; } }
    }
    nloc = mine > 0u ? mine : 1u; nx = cnt > 0u ? cnt : 1u;
}

__device__ __forceinline__ void xcd_barrier(const XcdBarrier& b) {
    asm volatile("s_waitcnt vmcnt(0)" ::: "memory");
    __syncthreads();
    if (threadIdx.x == 0) {
        unsigned* bar = b.bar;
        __builtin_amdgcn_s_waitcnt(0);
        unsigned nloc = b.st[0], nx = b.st[1];
        if (nloc == 0u) { xcd_barrier_complete(bar, b.x, nloc, nx); b.st[0] = nloc; b.st[1] = nx; }
        const unsigned old = xb_add(&bar[XB_XSUB(b.x)], 1u);
        const unsigned gen = old / nloc;
        if (old + 1u == (gen + 1u) * nloc) {
            __builtin_amdgcn_fence(__ATOMIC_RELEASE, "agent");
            asm volatile("s_waitcnt vmcnt(0)" ::: "memory");
            const unsigned og = xb_add(&bar[XB_TOP], 1u);
            const unsigned tg = og / nx;
            if (og + 1u == (tg + 1u) * nx) xb_add(&bar[XB_TOPGEN], 1u);
            else XB_SPIN(xb_ld(&bar[XB_TOPGEN]) == tg, bar);
            __builtin_amdgcn_fence(__ATOMIC_ACQUIRE, "agent");
            xb_add(&bar[XB_XGEN(b.x)], 1u);
            asm volatile("s_waitcnt vmcnt(0)" ::: "memory");
        } else {
            XB_SPIN(xb_ld(&bar[XB_XGEN(b.x)]) == gen, bar);
            __builtin_amdgcn_fence(__ATOMIC_ACQUIRE, "agent");
            asm volatile("s_waitcnt vmcnt(0)" ::: "memory");
        }
    }
    __syncthreads();
}

__device__ __forceinline__ float wave_sum(float v) {
#pragma unroll
    for (int o = 1; o < 64; o <<= 1) v += __shfl_xor(v, o);
    return v;
}
__device__ __forceinline__ float bf_lo(unsigned w) { return __builtin_bit_cast(float, w << 16); }
__device__ __forceinline__ float bf_hi(unsigned w) { return __builtin_bit_cast(float, w & 0xffff0000u); }
__device__ __forceinline__ void ld8(const bf16* p, float* f) {
    const v4u w = *(const GAS v4u*)p;
    f[0] = bf_lo(w.x); f[1] = bf_hi(w.x); f[2] = bf_lo(w.y); f[3] = bf_hi(w.y); f[4] = bf_lo(w.z); f[5] = bf_hi(w.z); f[6] = bf_lo(w.w); f[7] = bf_hi(w.w);
}
__device__ __forceinline__ float ex2(float x) { return __builtin_amdgcn_exp2f(x); }

struct Frame {
    LAS unsigned char* lds;
    volatile LAS unsigned* MISC;
    gu32* ctl;
    int tid, lane, wave, G, bid;
    const float* const* in;
};

enum { MAP_ID = 0, MAP_GATE, MAP_UP, MAP_CIN, MAP_CQUP, MAP_CKVUP };
__device__ __forceinline__ int map_row(int map, int n) {
    if (map == MAP_GATE) return ((n >> 7) << 8) + (n & 127);
    if (map == MAP_UP) return ((n >> 7) << 8) + 128 + (n & 127);
    if (map == MAP_CIN) { if (n < 640) return n; const int i = n - 640; return 640 + ((i & 15) << 1) + (i >> 4); }
    if (map == MAP_CQUP) { const int h = n / 96, j = n - 96 * h; if (j < 64) return 64 * h + j; const int i = j - 64; return 1024 + 32 * h + ((i & 15) << 1) + (i >> 4); }
    if (map == MAP_CKVUP) { const int h = n >> 7, j = n & 127; return j < 64 ? 64 * h + j : 1024 + 64 * h + (j - 64); }
    return n;
}
__device__ __forceinline__ void conv_item(const float* W, int K, int N, bf16* WT, int map, int nscale, float scale, LAS float* scr, int item, int lane) {
    const int nblk = N / 32, kb = item / nblk, nb = item - kb * nblk, k0 = 64 * kb, n0 = 32 * nb;
#pragma unroll 8
    for (int i = 0; i < 32; ++i) { const int kk = 2 * i + (lane >> 5); scr[kk * 33 + (lane & 31)] = W[(size_t)(k0 + kk) * N + n0 + (lane & 31)]; }
    LDS_WAIT(); asm volatile("" ::: "memory");
    const int c = lane & 7;
#pragma unroll
    for (int j = 0; j < 4; ++j) { const int n = (lane >> 3) + 8 * j; const LAS float* s = scr + (8 * c) * 33 + n; const int nn = n0 + n; const float sc = nn < nscale ? scale : 1.0f;
        v4u o; o.x = pk2(s[0 * 33] * sc, s[1 * 33] * sc); o.y = pk2(s[2 * 33] * sc, s[3 * 33] * sc); o.z = pk2(s[4 * 33] * sc, s[5 * 33] * sc); o.w = pk2(s[6 * 33] * sc, s[7 * 33] * sc);
        *(GAS v4u*)(WT + (size_t)map_row(map, nn) * K + k0 + 8 * c) = o; }
    LDS_WAIT(); asm volatile("" ::: "memory");
}
__device__ __forceinline__ void conv_matrix(const float* W, int K, int N, bf16* WT, int map, int nscale, float scale, LAS float* scr, int gw, int NGW, int& base, int lane) {
    const int nit = (K / 64) * (N / 32);
    int first = gw - base; if (first < 0) first += NGW;
    for (int it = first; it < nit; it += NGW) conv_item(W, K, N, WT, map, nscale, scale, scr, it, lane);
    base = (base + nit) % NGW;
}
__device__ __forceinline__ void conv_moe(const float* Wg, const float* Wu, const float* Wd, unsigned char* ws, LAS float* scr, int gw, int NGW, int lane) {
    int base = 0;
    for (int e = 0; e < NEXP; ++e) {
        bf16* gu = (bf16*)(ws + W_MOE_GU) + (size_t)e * 2 * FFE * DM;
        conv_matrix(Wg + (size_t)e * DM * FFE, DM, FFE, gu, MAP_GATE, 0, 1.f, scr, gw, NGW, base, lane);
        conv_matrix(Wu + (size_t)e * DM * FFE, DM, FFE, gu, MAP_UP, 0, 1.f, scr, gw, NGW, base, lane);
        conv_matrix(Wd + (size_t)e * FFE * DM, FFE, DM, (bf16*)(ws + W_MOE_D) + (size_t)e * DM * FFE, MAP_ID, 0, 1.f, scr, gw, NGW, base, lane);
    }
}

__device__ __forceinline__ void row_load(const float* xrow, int lane, f32x4 (&v)[4]) {
    const GAS f32x4* xr = (const GAS f32x4*)xrow + lane;
#pragma unroll
    for (int j = 0; j < 4; ++j) v[j] = xr[64 * j];
}
__device__ __forceinline__ float row_rstd(const f32x4 (&v)[4]) {
    float s = 0.f;
#pragma unroll
    for (int j = 0; j < 4; ++j) s += (v[j].x * v[j].x + v[j].y * v[j].y) + (v[j].z * v[j].z + v[j].w * v[j].w);
    return 1.0f / sqrtf(wave_sum(s) * (1.0f / DM) + NORM_EPS);
}
__device__ __forceinline__ void row_scale_gain(f32x4 (&v)[4], float rstd, const float* g, int lane) {
    const GAS f32x4* gr = (const GAS f32x4*)g + lane;
#pragma unroll
    for (int j = 0; j < 4; ++j) { const f32x4 gg = gr[64 * j]; v[j] = v[j] * rstd * gg; }
}
__device__ __forceinline__ void row_store_bf16(bf16* orow, int lane, const f32x4 (&v)[4]) {
    GAS unsigned long long* o8 = (GAS unsigned long long*)orow + lane;
#pragma unroll
    for (int j = 0; j < 4; ++j) o8[64 * j] = (unsigned long long)pk2(v[j].x, v[j].y) | ((unsigned long long)pk2(v[j].z, v[j].w) << 32);
}
__device__ __forceinline__ void row_store_f32(float* orow, int lane, const f32x4 (&v)[4]) {
    GAS f32x4* o = (GAS f32x4*)orow + lane;
#pragma unroll
    for (int j = 0; j < 4; ++j) o[64 * j] = v[j];
}
__device__ __forceinline__ void row_add_bf16(const bf16* yrow, int lane, f32x4 (&v)[4]) {
    const GAS unsigned long long* y8 = (const GAS unsigned long long*)yrow + lane;
#pragma unroll
    for (int j = 0; j < 4; ++j) { const unsigned long long w = y8[64 * j]; const unsigned lo = (unsigned)w, hi = (unsigned)(w >> 32);
        v[j].x += bf_lo(lo); v[j].y += bf_hi(lo); v[j].z += bf_lo(hi); v[j].w += bf_hi(hi); }
}
template <int MODE>
__device__ __forceinline__ void norm_phase(Frame& F, const float* src, const float* g, bf16* H, float* xout, const bf16* Y, const int* toks,
                                           const float* Wr, int* toke, float* tokg, int* wgcnt) {
    const int RPW = (NTOK + F.G - 1) / F.G; const int r0 = F.bid * RPW, r1 = (r0 + RPW < NTOK) ? r0 + RPW : NTOK;
    LAS int* cnt = (LAS int*)(F.lds + RING_OFF);
    if (MODE == 1) { if (F.tid < 8) cnt[F.tid] = 0; __syncthreads(); }
    for (int r = r0 + F.wave; r < r1; r += NWAVES) {
        f32x4 v[4]; row_load(src + (size_t)r * DM, F.lane, v);
        if (MODE >= 2) { const int s0 = toks[2 * r], s1 = toks[2 * r + 1]; row_add_bf16(Y + (size_t)s0 * DM, F.lane, v); row_add_bf16(Y + (size_t)s1 * DM, F.lane, v);
            if (MODE == 2) row_store_f32(xout + (size_t)r * DM, F.lane, v); }
        const float rstd = row_rstd(v);
        row_scale_gain(v, rstd, g, F.lane);
        if (MODE == 3) row_store_f32(xout + (size_t)r * DM, F.lane, v); else row_store_bf16(H + (size_t)r * DM, F.lane, v);
        if (MODE == 1) {
            float lg[8];
#pragma unroll
            for (int e = 0; e < 8; ++e) lg[e] = 0.f;
#pragma unroll
            for (int j = 0; j < 4; ++j)
#pragma unroll
                for (int c = 0; c < 4; ++c) { const int k = 4 * (F.lane + 64 * j) + c; const f32x4 w0 = *(const GAS f32x4*)(Wr + (size_t)k * 8), w1 = *(const GAS f32x4*)(Wr + (size_t)k * 8 + 4); const float hv = v[j][c];
                    lg[0] += hv * w0.x; lg[1] += hv * w0.y; lg[2] += hv * w0.z; lg[3] += hv * w0.w; lg[4] += hv * w1.x; lg[5] += hv * w1.y; lg[6] += hv * w1.z; lg[7] += hv * w1.w; }
#pragma unroll
            for (int e = 0; e < 8; ++e) lg[e] = wave_sum(lg[e]);
            int e0 = 0; float l0 = lg[0];
#pragma unroll
            for (int e = 1; e < 8; ++e) if (lg[e] > l0) { l0 = lg[e]; e0 = e; }
            int e1 = -1; float l1 = -INFINITY;
#pragma unroll
            for (int e = 0; e < 8; ++e) if (e != e0 && lg[e] > l1) { l1 = lg[e]; e1 = e; }
            const float g0 = 1.0f / (1.0f + __expf(l1 - l0)), g1 = 1.0f - g0;
            if (F.lane == 0) { toke[2 * r] = e0; toke[2 * r + 1] = e1; tokg[2 * r] = g0; tokg[2 * r + 1] = g1; __hip_atomic_fetch_add(&cnt[e0], 1, __ATOMIC_RELAXED, __HIP_MEMORY_SCOPE_WORKGROUP); __hip_atomic_fetch_add(&cnt[e1], 1, __ATOMIC_RELAXED, __HIP_MEMORY_SCOPE_WORKGROUP); }
        }
    }
    if (MODE == 1) { __syncthreads(); if (F.tid < 8) wgcnt[F.bid * 8 + F.tid] = cnt[F.tid]; __syncthreads(); }
}

__device__ __forceinline__ void slot_phase(Frame& F, LAS int* tot, const int* toke, const float* tokg, int* toks, float* sgate, const bf16* H, bf16* XB) {
    const int RPW = (NTOK + F.G - 1) / F.G; const int r0 = F.bid * RPW, r1 = (r0 + RPW < NTOK) ? r0 + RPW : NTOK;
    LAS int* slotof = tot + 64;
    const int np = 2 * (r1 - r0);
    for (int p = F.tid; p < np; p += NWAVES * 64) { const int idx = 2 * r0 + p; const int e = toke[idx]; const int slot = __hip_atomic_fetch_add(&tot[16 + e], 1, __ATOMIC_RELAXED, __HIP_MEMORY_SCOPE_WORKGROUP); toks[idx] = slot; sgate[slot] = tokg[idx]; slotof[p] = slot; }
    __syncthreads();
    for (int p = F.wave; p < np; p += NWAVES) { const int tok = r0 + (p >> 1); const int slot = slotof[p];
        const GAS v4u* s = (const GAS v4u*)(H + (size_t)tok * DM) + F.lane; GAS v4u* d = (GAS v4u*)(XB + (size_t)slot * DM) + F.lane;
        const v4u a = s[0], b = s[64]; d[0] = a; d[64] = b; }
    __syncthreads();
}

__device__ __forceinline__ void latpost_phase(Frame& F, const bf16* LAT, const float* qg, const float* kvg, const float* tab, bf16* QN, bf16* KVN, bf16* KPE) {
    const int gw = F.bid * NWAVES + F.wave, NGW = F.G * NWAVES;
    for (int r = gw; r < NTOK; r += NGW) {
        const bf16* row = LAT + (size_t)r * 768;
        float q[6]; float s = 0.f;
#pragma unroll
        for (int i = 0; i < 6; ++i) { q[i] = bf_lo((unsigned)row[F.lane + 64 * i]); s += q[i] * q[i]; }
        const float rq = 1.0f / sqrtf(wave_sum(s) * (1.0f / 384.0f) + NORM_EPS);
#pragma unroll
        for (int i = 0; i < 6; ++i) QN[(size_t)r * 384 + F.lane + 64 * i] = (bf16)f2bf(q[i] * rq * qg[F.lane + 64 * i]);
        float k[4]; s = 0.f;
#pragma unroll
        for (int i = 0; i < 4; ++i) { k[i] = bf_lo((unsigned)row[384 + F.lane + 64 * i]); s += k[i] * k[i]; }
        const float rk = 1.0f / sqrtf(wave_sum(s) * (1.0f / 256.0f) + NORM_EPS);
#pragma unroll
        for (int i = 0; i < 4; ++i) KVN[(size_t)r * 256 + F.lane + 64 * i] = (bf16)f2bf(k[i] * rk * kvg[F.lane + 64 * i]);
        if (F.lane < 16) { const float x1 = bf_lo((unsigned)row[640 + 2 * F.lane]), x2 = bf_lo((unsigned)row[640 + 2 * F.lane + 1]);
            const float c = tab[(size_t)(r % SEQ) * 32 + 2 * F.lane], sn = tab[(size_t)(r % SEQ) * 32 + 2 * F.lane + 1];
            *(GAS unsigned*)(KPE + (size_t)r * 32 + 2 * F.lane) = pk2(x1 * c - x2 * sn, x1 * sn + x2 * c); }
    }
}

#define ONLINE_UPDATE(S, NV, VP) do { const float mnew_ = fmaxf(mx, (S)); const float al_ = ex2(mx - mnew_), p_ = ex2((S) - mnew_); l = l * al_ + p_; mx = mnew_; \
    float vv_[NV]; _Pragma("unroll") for (int c_ = 0; c_ < NV / 8; ++c_) ld8((VP) + 8 * c_, vv_ + 8 * c_); \
    _Pragma("unroll") for (int e_ = 0; e_ < NV; ++e_) acc[e_] = acc[e_] * al_ + p_ * vv_[e_]; } while (0)
template <int N> __device__ __forceinline__ float dotq(const float* q, const bf16* kp) {
    float s = 0.f;
#pragma unroll
    for (int c = 0; c < N / 8; ++c) { float kk[8]; ld8(kp + 8 * c, kk);
#pragma unroll
        for (int e = 0; e < 8; ++e) s += q[8 * c + e] * kk[e]; }
    return s;
}
__device__ __forceinline__ void naive_attn_a(Frame& F, const bf16* QKV, bf16* OUT) {
    const int gw = F.bid * NWAVES + F.wave, NGW = F.G * NWAVES, qi = F.lane >> 2, part = F.lane & 3;
    for (int it = gw; it < BATCH * 8 * (SEQ / 16); it += NGW) {
        const int bh = it & 63, tb = it >> 6, b = bh >> 3, h = bh & 7, t = tb * 16 + qi; const size_t row = (size_t)b * SEQ + t;
        float mx = -INFINITY, l = 0.f, acc[16];
#pragma unroll
        for (int e = 0; e < 16; ++e) acc[e] = 0.f;
        for (int g = 0; g < 3; ++g) {
            const int d = 1 << (2 * g); const float slope2 = exp2f(-(float)(g * 8 + h + 1) / 3.0f) * LOG2E;
            float q[64];
#pragma unroll
            for (int c = 0; c < 8; ++c) ld8(QKV + row * 4608 + g * 512 + h * 64 + 8 * c, q + 8 * c);
            for (int n = 0; n <= 128; ++n) { const int tk = t - n * d;
                if (tk >= 0) { const bf16* kr = QKV + ((size_t)b * SEQ + tk) * 4608 + g * 512 + h * 64; const float s = dotq<64>(q, kr + 1536) - slope2 * (float)(n * d);
                    ONLINE_UPDATE(s, 16, kr + 3072 + part * 16); } }
        }
        const float rl = 1.0f / l; v4u o0, o1;
        o0.x = pk2(acc[0] * rl, acc[1] * rl); o0.y = pk2(acc[2] * rl, acc[3] * rl); o0.z = pk2(acc[4] * rl, acc[5] * rl); o0.w = pk2(acc[6] * rl, acc[7] * rl);
        o1.x = pk2(acc[8] * rl, acc[9] * rl); o1.y = pk2(acc[10] * rl, acc[11] * rl); o1.z = pk2(acc[12] * rl, acc[13] * rl); o1.w = pk2(acc[14] * rl, acc[15] * rl);
        GAS v4u* op = (GAS v4u*)(OUT + row * 512 + h * 64 + part * 16); op[0] = o0; op[1] = o1;
    }
}
__device__ __forceinline__ void naive_attn_b(Frame& F, const bf16* QKV, bf16* OUT, const float* lq1, const float* lk1, const float* lq2, const float* lk2, const float* subln) {
    const int gw = F.bid * NWAVES + F.wave, NGW = F.G * NWAVES, qi = F.lane >> 2, part = F.lane & 3;
    float d1 = 0.f, d2 = 0.f;
    for (int i = 0; i < 64; ++i) { d1 += lq1[i] * lk1[i]; d2 += lq2[i] * lk2[i]; }
    const float lam_init = 0.8f - 0.6f * expf(-0.3f * 1.0f), lam = expf(d1) - expf(d2) + lam_init;
    for (int it = gw; it < BATCH * 8 * (SEQ / 16); it += NGW) {
        const int bh = it & 63, tb = it >> 6, b = bh >> 3, h = bh & 7, t = tb * 16 + qi, tmax = tb * 16 + 15; const size_t row = (size_t)b * SEQ + t;
        const float slope2 = exp2f(-(float)(h + 1)) * LOG2E;
        float o[32];
        for (int m = 0; m < 2; ++m) {
            float q[64];
#pragma unroll
            for (int c = 0; c < 8; ++c) ld8(QKV + row * 3072 + h * 128 + m * 64 + 8 * c, q + 8 * c);
            float mx = -INFINITY, l = 0.f, acc[32];
#pragma unroll
            for (int e = 0; e < 32; ++e) acc[e] = 0.f;
            for (int j = 0; j <= tmax; ++j) {
                const bf16* kr = QKV + ((size_t)b * SEQ + j) * 3072 + h * 128; const float s = dotq<64>(q, kr + 1024 + m * 64) - slope2 * (float)(t - j);
                if (j <= t) ONLINE_UPDATE(s, 32, kr + 2048 + part * 32);
            }
            const float rl = 1.0f / l;
#pragma unroll
            for (int e = 0; e < 32; ++e) o[e] = (m == 0) ? acc[e] * rl : o[e] - lam * acc[e] * rl;
        }
        float ss = 0.f;
#pragma unroll
        for (int e = 0; e < 32; ++e) ss += o[e] * o[e];
        ss += __shfl_xor(ss, 1); ss += __shfl_xor(ss, 2);
        const float rs = (1.0f - lam_init) / sqrtf(ss * (1.0f / 128.0f) + SUBLN_EPS);
        GAS v4u* op = (GAS v4u*)(OUT + row * 1024 + h * 128 + part * 32);
#pragma unroll
        for (int c = 0; c < 4; ++c) { const float* sg = subln + part * 32 + 8 * c; const float* oo = o + 8 * c; v4u w;
            w.x = pk2(oo[0] * rs * sg[0], oo[1] * rs * sg[1]); w.y = pk2(oo[2] * rs * sg[2], oo[3] * rs * sg[3]); w.z = pk2(oo[4] * rs * sg[4], oo[5] * rs * sg[5]); w.w = pk2(oo[6] * rs * sg[6], oo[7] * rs * sg[7]); op[c] = w; }
    }
}
__device__ __forceinline__ void naive_attn_c(Frame& F, const bf16* Q, const bf16* KV, const bf16* KPE, bf16* OUT) {
    const int gw = F.bid * NWAVES + F.wave, NGW = F.G * NWAVES, qi = F.lane >> 2, part = F.lane & 3;
    for (int it = gw; it < BATCH * 16 * (SEQ / 16); it += NGW) {
        const int bh = it & 127, tb = it >> 7, b = bh >> 4, h = bh & 15, t = tb * 16 + qi, tmax = tb * 16 + 15; const size_t row = (size_t)b * SEQ + t;
        float q[96];
#pragma unroll
        for (int c = 0; c < 8; ++c) ld8(Q + row * 1536 + h * 64 + 8 * c, q + 8 * c);
#pragma unroll
        for (int c = 0; c < 4; ++c) ld8(Q + row * 1536 + 1024 + h * 32 + 8 * c, q + 64 + 8 * c);
        float mx = -INFINITY, l = 0.f, acc[16];
#pragma unroll
        for (int e = 0; e < 16; ++e) acc[e] = 0.f;
        for (int j = 0; j <= tmax; ++j) {
            const size_t kr = (size_t)b * SEQ + j; const float s = dotq<64>(q, KV + kr * 2048 + h * 64) + dotq<32>(q + 64, KPE + kr * 32);
            if (j <= t) ONLINE_UPDATE(s, 16, KV + kr * 2048 + 1024 + h * 64 + part * 16);
        }
        const float rl = 1.0f / l; v4u o0, o1;
        o0.x = pk2(acc[0] * rl, acc[1] * rl); o0.y = pk2(acc[2] * rl, acc[3] * rl); o0.z = pk2(acc[4] * rl, acc[5] * rl); o0.w = pk2(acc[6] * rl, acc[7] * rl);
        o1.x = pk2(acc[8] * rl, acc[9] * rl); o1.y = pk2(acc[10] * rl, acc[11] * rl); o1.z = pk2(acc[12] * rl, acc[13] * rl); o1.w = pk2(acc[14] * rl, acc[15] * rl);
        GAS v4u* op = (GAS v4u*)(OUT + row * 1024 + h * 64 + part * 16); op[0] = o0; op[1] = o1;
    }
}
__device__ __forceinline__ void naive_attn_d(Frame& F, const bf16* QKV, bf16* OUT) {
    const int gw = F.bid * NWAVES + F.wave, NGW = F.G * NWAVES, qi = F.lane >> 2, part = F.lane & 3;
    for (int it = gw; it < BATCH * 16 * (SEQ / 16); it += NGW) {
        const int bh = it & 127, tb = it >> 7, b = bh >> 4, h = bh & 15, t = tb * 16 + qi, tmax = tb * 16 + 15; const size_t row = (size_t)b * SEQ + t;
        float q[64];
#pragma unroll
        for (int c = 0; c < 8; ++c) ld8(QKV + row * 3072 + h * 64 + 8 * c, q + 8 * c);
        float carry = 1.0f, acc[16];
#pragma unroll
        for (int e = 0; e < 16; ++e) acc[e] = 0.f;
        for (int n = 1; n <= tmax; ++n) { const int tk = t - n;
            if (tk >= 0) { const bf16* kr = QKV + ((size_t)b * SEQ + tk) * 3072 + h * 64; const float ez = ex2(dotq<64>(q, kr + 1024)); const float keep = 1.0f / (1.0f + ez); const float a = ez * keep * carry; carry *= keep;
                float vv[16]; ld8(kr + 2048 + part * 16, vv); ld8(kr + 2048 + part * 16 + 8, vv + 8);
#pragma unroll
                for (int e = 0; e < 16; ++e) acc[e] += a * vv[e]; } }
        v4u o0, o1;
        o0.x = pk2(acc[0], acc[1]); o0.y = pk2(acc[2], acc[3]); o0.z = pk2(acc[4], acc[5]); o0.w = pk2(acc[6], acc[7]);
        o1.x = pk2(acc[8], acc[9]); o1.y = pk2(acc[10], acc[11]); o1.z = pk2(acc[12], acc[13]); o1.w = pk2(acc[14], acc[15]);
        GAS v4u* op = (GAS v4u*)(OUT + row * 1024 + h * 64 + part * 16); op[0] = o0; op[1] = o1;
    }
}

__device__ __forceinline__ int wave_sum_i(int v) {
#pragma unroll
    for (int o = 1; o < 64; o <<= 1) v += __shfl_xor(v, o);
    return v;
}
__device__ __forceinline__ void moe_layout(Frame& F, const int* wgcnt, LAS int* tot) {
    int t = 0, bfr = 0;
    for (int w = F.lane; w < F.G; w += 64) { const int c = wgcnt[w * 8 + F.wave]; t += c; bfr += (w < F.bid) ? c : 0; }
    t = wave_sum_i(t); bfr = wave_sum_i(bfr);
    if (F.lane == 0) { tot[F.wave] = t; tot[8 + F.wave] = bfr; }
    __syncthreads();
    if (F.tid == 0) { int ps = 0; for (int e = 0; e < 8; ++e) { tot[16 + e] = ps + tot[8 + e]; ps += ((tot[e] + 255) >> 8) << 8; F.MISC[16 + e] = (unsigned)(ps >> 8); } F.MISC[24] = (unsigned)(ps >> 8); }
    __syncthreads();
}

__device__ __forceinline__ void ropeq_phase(Frame& F, bf16* Q, const float* tab) {
    const int gw = F.bid * NWAVES + F.wave, NGW = F.G * NWAVES;
    for (int r = gw; r < NTOK; r += NGW) {
        GAS v4u* p = (GAS v4u*)(Q + (size_t)r * 1536 + 1024) + F.lane; v4u w = *p;
        const float* t = tab + (size_t)(r % SEQ) * 32 + 8 * (F.lane & 3); const f32x4 c0 = *(const GAS f32x4*)t, c1 = *(const GAS f32x4*)(t + 4);
        float a, b;
        a = bf_lo(w.x); b = bf_hi(w.x); w.x = pk2(a * c0[0] - b * c0[1], a * c0[1] + b * c0[0]);
        a = bf_lo(w.y); b = bf_hi(w.y); w.y = pk2(a * c0[2] - b * c0[3], a * c0[3] + b * c0[2]);
        a = bf_lo(w.z); b = bf_hi(w.z); w.z = pk2(a * c1[0] - b * c1[1], a * c1[1] + b * c1[0]);
        a = bf_lo(w.w); b = bf_hi(w.w); w.w = pk2(a * c1[2] - b * c1[3], a * c1[3] + b * c1[2]);
        *p = w;
    }
}

#ifndef MK_SPLIT
#define MK_SPLIT 0
#endif
#ifndef NAIVE_A
#define NAIVE_A 1
#endif
#ifndef NAIVE_B
#define NAIVE_B 1
#endif
#ifndef NAIVE_C
#define NAIVE_C 1
#endif
#ifndef NAIVE_D
#define NAIVE_D 1
#endif
constexpr int N_PHASES = 34;
struct Args { const float* in[N_IN]; float* out; unsigned char* ws; int ph_lo, ph_hi; };
static_assert(sizeof(Args) == N_IN * 8 + 8 + 8 + 8, "Args has no padding holes");

__global__ void __launch_bounds__(NWAVES * 64, 2) fwd_kernel(Args args) {
    extern __shared__ __attribute__((aligned(16))) unsigned char lds[];
    Frame F;
    F.lds = (LAS unsigned char*)lds;
    F.MISC = (volatile LAS unsigned*)(F.lds + MISC_OFF);
    F.tid = threadIdx.x; F.lane = F.tid & 63; F.wave = __builtin_amdgcn_readfirstlane(F.tid >> 6);
    F.G = gridDim.x; F.bid = blockIdx.x;
    unsigned char* ws = args.ws;
    F.ctl = (gu32*)(ws + WS_CTL);
    if (F.tid < 64) F.MISC[F.tid] = 0u;
    __syncthreads();
    XcdBarrier bar; bar.bar = (unsigned*)(F.ctl + CW_BAR); bar.x = 0; bar.st = nullptr;
    if (!MK_SPLIT) bar = xcd_barrier_post((unsigned*)(F.ctl + CW_BAR), F.MISC + 8);
    const int lo = args.ph_lo, hi = args.ph_hi;
#ifndef CT_LO
#define CT_LO 0
#endif
#ifndef CT_HI
#define CT_HI 1000
#endif
#define IN(k) ((k) >= CT_LO && (k) < CT_HI && lo <= (k) && (k) < hi)
#define SEAM(k) do { if (!MK_SPLIT && IN(k) && IN((k) + 1)) xcd_barrier(bar); } while (0)
#define WSP(T, off) ((T*)(ws + (off)))
#define GEMM_STATIC(EPI_T, Ap, Bp, M_, N_, K_, ...) do { pg8::Gemm g{(const pg8::bf16_t*)(Ap), (const pg8::bf16_t*)(Bp), M_, N_, K_, 0}; pg8::StaticOrder S; S.init(M_, N_, F.G, F.bid); \
        EPI_T E{__VA_ARGS__}; pg8::gemm_phase<EPI_T, pg8::StaticOrder, PG8_ALIGN, PG8_SP2>(F.lds + RING_OFF, g, S, E); } while (0)
#define GEMM_MOE(EPI_T, Ap, Bp, N_, K_, ...) do { moe_layout(F, WSP(int, WS_WGCNT), (LAS int*)(F.lds + RING_OFF)); \
        pg8::Gemm g{(const pg8::bf16_t*)(Ap), (const pg8::bf16_t*)(Bp), 0, N_, K_, (size_t)(N_) * (K_) * 2}; pg8::MoeOrder S; const int nblk_ = (int)F.MISC[24]; S.so.init(nblk_ * 256, N_, F.G, F.bid); \
        _Pragma("unroll") for (int j_ = 0; j_ < 8; ++j_) S.pend[j_] = __builtin_amdgcn_readfirstlane((int)F.MISC[16 + j_]); \
        __syncthreads(); EPI_T E{__VA_ARGS__}; pg8::gemm_phase<EPI_T, pg8::MoeOrder, PG8_ALIGN, PG8_SP2>(F.lds + RING_OFF, g, S, E); } while (0)
    const float* const* in = args.in;
    float* xres = args.out;
    bf16* H = WSP(bf16, WS_H); bf16* XB = WSP(bf16, WS_XB); bf16* BIG = WSP(bf16, WS_BIG);
    const float QS = 0.125f * LOG2E;
    const int gw = F.bid * NWAVES + F.wave, NGW = F.G * NWAVES;
    LAS float* scr = (LAS float*)(F.lds + RING_OFF + F.wave * 16384);

    if (IN(0)) {
        int base = 0;
        conv_matrix(in[I_A_WQKV], DM, 4608, WSP(bf16, W_QKV_A), MAP_ID, 1536, QS, scr, gw, NGW, base, F.lane);
        conv_matrix(in[I_A_WO], 512, DM, WSP(bf16, W_O_A), MAP_ID, 0, 1.f, scr, gw, NGW, base, F.lane);
        conv_matrix(in[I_F0_WG], DM, FFD, WSP(bf16, W_GU0), MAP_GATE, 0, 1.f, scr, gw, NGW, base, F.lane);
        conv_matrix(in[I_F0_WU], DM, FFD, WSP(bf16, W_GU0), MAP_UP, 0, 1.f, scr, gw, NGW, base, F.lane);
        conv_matrix(in[I_F0_WD], FFD, DM, WSP(bf16, W_D0), MAP_ID, 0, 1.f, scr, gw, NGW, base, F.lane);
        conv_matrix(in[I_B_WQKV], DM, 3072, WSP(bf16, W_QKV_B), MAP_ID, 1024, QS, scr, gw, NGW, base, F.lane);
        conv_matrix(in[I_B_WO], DM, DM, WSP(bf16, W_O_B), MAP_ID, 0, 1.f, scr, gw, NGW, base, F.lane);
        conv_matrix(in[I_C_WIN], DM, 672, WSP(bf16, W_IN_C), MAP_CIN, 0, 1.f, scr, gw, NGW, base, F.lane);
        conv_matrix(in[I_C_WQUP], 384, 1536, WSP(bf16, W_QUP_C), MAP_CQUP, 1536, 0.10206207261596575f * LOG2E, scr, gw, NGW, base, F.lane);
        conv_matrix(in[I_C_WKVUP], 256, 2048, WSP(bf16, W_KVUP_C), MAP_CKVUP, 0, 1.f, scr, gw, NGW, base, F.lane);
        conv_matrix(in[I_C_WO], DM, DM, WSP(bf16, W_O_C), MAP_ID, 0, 1.f, scr, gw, NGW, base, F.lane);
        conv_matrix(in[I_F2_WG], DM, FFD, WSP(bf16, W_GU2), MAP_GATE, 0, 1.f, scr, gw, NGW, base, F.lane);
        conv_matrix(in[I_F2_WU], DM, FFD, WSP(bf16, W_GU2), MAP_UP, 0, 1.f, scr, gw, NGW, base, F.lane);
        conv_matrix(in[I_F2_WD], FFD, DM, WSP(bf16, W_D2), MAP_ID, 0, 1.f, scr, gw, NGW, base, F.lane);
        conv_matrix(in[I_D_WQKV], DM, 3072, WSP(bf16, W_QKV_D), MAP_ID, 1024, QS, scr, gw, NGW, base, F.lane);
        conv_matrix(in[I_D_WO], DM, DM, WSP(bf16, W_O_D), MAP_ID, 0, 1.f, scr, gw, NGW, base, F.lane);
        conv_moe(in[I_M1_WG], in[I_M1_WU], in[I_M1_WD], ws, scr, gw, NGW, F.lane);
        { GAS v4u* z = (GAS v4u*)(ws + W_IN_C + (size_t)672 * DM * 2); const v4u zz = {0u, 0u, 0u, 0u};
          for (int i = F.bid * NWAVES * 64 + F.tid; i < 96 * DM * 2 / 16; i += F.G * NWAVES * 64) z[i] = zz; }
        { float* tab = WSP(float, WS_ROPE);
          for (int i = F.bid * NWAVES * 64 + F.tid; i < SEQ * 16; i += F.G * NWAVES * 64) { const int pos = i >> 4, fi = i & 15;
              const float inv = exp2f(-(float)fi * (13.287712379549449f / 16.0f)); const float ang = (float)pos * inv;
              const double rev = (double)ang * 0.15915494309189535; const float fr = (float)(rev - floor(rev + 0.5));
              tab[2 * i] = __builtin_amdgcn_cosf(fr); tab[2 * i + 1] = __builtin_amdgcn_sinf(fr); } }
        norm_phase<0>(F, in[I_X], in[I_A_NORM], H, nullptr, nullptr, nullptr, nullptr, nullptr, nullptr, nullptr);
    }
    SEAM(0);
    if (IN(1)) GEMM_STATIC(pg8::EpiBf16, H, ws + W_QKV_A, NTOK, 4608, DM, BIG, 4608);
    SEAM(1);
    if (IN(2)) { naive_attn_a(F, BIG, H); }
    SEAM(2);
    if (IN(3)) GEMM_STATIC(pg8::EpiResid, H, ws + W_O_A, NTOK, DM, 512, in[I_X], xres, DM);
    SEAM(3);
    if (IN(4)) norm_phase<0>(F, xres, in[I_F0_NORM], H, nullptr, nullptr, nullptr, nullptr, nullptr, nullptr, nullptr);
    SEAM(4);
    if (IN(5)) GEMM_STATIC(pg8::EpiSwiglu, H, ws + W_GU0, NTOK, 2 * FFD, DM, BIG, FFD);
    SEAM(5);
    if (IN(6)) GEMM_STATIC(pg8::EpiResid, BIG, ws + W_D0, NTOK, DM, FFD, xres, xres, DM);
    SEAM(6);
    if (IN(7)) norm_phase<0>(F, xres, in[I_B_NORM], H, nullptr, nullptr, nullptr, nullptr, nullptr, nullptr, nullptr);
    SEAM(7);
    if (IN(8)) GEMM_STATIC(pg8::EpiBf16, H, ws + W_QKV_B, NTOK, 3072, DM, BIG, 3072);
    SEAM(8);
    if (IN(9)) { naive_attn_b(F, BIG, H, in[I_B_LQ1], in[I_B_LK1], in[I_B_LQ2], in[I_B_LK2], in[I_B_SUBLN]); }
    SEAM(9);
    if (IN(10)) GEMM_STATIC(pg8::EpiResid, H, ws + W_O_B, NTOK, DM, DM, xres, xres, DM);
    SEAM(10);
    if (IN(11)) norm_phase<1>(F, xres, in[I_M1_NORM], H, nullptr, nullptr, nullptr, in[I_M1_WR], WSP(int, WS_TOKE), WSP(float, WS_TOKG), WSP(int, WS_WGCNT));
    SEAM(11);
    if (IN(12)) { LAS int* tot = (LAS int*)(F.lds + RING_OFF); moe_layout(F, WSP(int, WS_WGCNT), tot); slot_phase(F, tot, WSP(int, WS_TOKE), WSP(float, WS_TOKG), WSP(int, WS_TOKS), WSP(float, WS_SGATE), H, XB); }
    SEAM(12);
    if (IN(13)) GEMM_MOE(pg8::EpiSwiglu, XB, ws + W_MOE_GU, 2 * FFE, DM, BIG, FFE);
    SEAM(13);
    if (IN(14)) GEMM_MOE(pg8::EpiMoeDown, BIG, ws + W_MOE_D, DM, FFE, XB, DM, WSP(float, WS_SGATE));
    SEAM(14);
    if (IN(15)) { norm_phase<2>(F, xres, in[I_C_NORM], H, xres, XB, WSP(int, WS_TOKS), nullptr, nullptr, nullptr, nullptr);
                  conv_moe(in[I_M3_WG], in[I_M3_WU], in[I_M3_WD], ws, scr, gw, NGW, F.lane); }
    SEAM(15);
    if (IN(16)) GEMM_STATIC(pg8::EpiBf16, H, ws + W_IN_C, NTOK, 768, DM, WSP(bf16, C_LAT), 768);
    SEAM(16);
    if (IN(17)) latpost_phase(F, WSP(bf16, C_LAT), in[I_C_QNORM], in[I_C_KVNORM], WSP(float, WS_ROPE), WSP(bf16, C_QN), WSP(bf16, C_KVN), WSP(bf16, C_KPE));
    SEAM(17);
    if (IN(18)) GEMM_STATIC(pg8::EpiBf16, ws + C_QN, ws + W_QUP_C, NTOK, 1536, 384, WSP(bf16, C_Q), 1536);
    SEAM(18);
    if (IN(19)) { ropeq_phase(F, WSP(bf16, C_Q), WSP(float, WS_ROPE)); GEMM_STATIC(pg8::EpiBf16, ws + C_KVN, ws + W_KVUP_C, NTOK, 2048, 256, WSP(bf16, C_KV), 2048); }
    SEAM(19);
    if (IN(20)) { naive_attn_c(F, WSP(bf16, C_Q), WSP(bf16, C_KV), WSP(bf16, C_KPE), H); }
    SEAM(20);
    if (IN(21)) GEMM_STATIC(pg8::EpiResid, H, ws + W_O_C, NTOK, DM, DM, xres, xres, DM);
    SEAM(21);
    if (IN(22)) norm_phase<0>(F, xres, in[I_F2_NORM], H, nullptr, nullptr, nullptr, nullptr, nullptr, nullptr, nullptr);
    SEAM(22);
    if (IN(23)) GEMM_STATIC(pg8::EpiSwiglu, H, ws + W_GU2, NTOK, 2 * FFD, DM, BIG, FFD);
    SEAM(23);
    if (IN(24)) GEMM_STATIC(pg8::EpiResid, BIG, ws + W_D2, NTOK, DM, FFD, xres, xres, DM);
    SEAM(24);
    if (IN(25)) norm_phase<0>(F, xres, in[I_D_NORM], H, nullptr, nullptr, nullptr, nullptr, nullptr, nullptr, nullptr);
    SEAM(25);
    if (IN(26)) GEMM_STATIC(pg8::EpiBf16, H, ws + W_QKV_D, NTOK, 3072, DM, BIG, 3072);
    SEAM(26);
    if (IN(27)) { naive_attn_d(F, BIG, H); }
    SEAM(27);
    if (IN(28)) GEMM_STATIC(pg8::EpiResid, H, ws + W_O_D, NTOK, DM, DM, xres, xres, DM);
    SEAM(28);
    if (IN(29)) norm_phase<1>(F, xres, in[I_M3_NORM], H, nullptr, nullptr, nullptr, in[I_M3_WR], WSP(int, WS_TOKE), WSP(float, WS_TOKG), WSP(int, WS_WGCNT));
    SEAM(29);
    if (IN(30)) { LAS int* tot = (LAS int*)(F.lds + RING_OFF); moe_layout(F, WSP(int, WS_WGCNT), tot); slot_phase(F, tot, WSP(int, WS_TOKE), WSP(float, WS_TOKG), WSP(int, WS_TOKS), WSP(float, WS_SGATE), H, XB); }
    SEAM(30);
    if (IN(31)) GEMM_MOE(pg8::EpiSwiglu, XB, ws + W_MOE_GU, 2 * FFE, DM, BIG, FFE);
    SEAM(31);
    if (IN(32)) GEMM_MOE(pg8::EpiMoeDown, BIG, ws + W_MOE_D, DM, FFE, XB, DM, WSP(float, WS_SGATE));
    SEAM(32);
    if (IN(33)) norm_phase<3>(F, xres, in[I_FINAL_NORM], nullptr, xres, XB, WSP(int, WS_TOKS), nullptr, nullptr, nullptr, nullptr);
#undef IN
#undef SEAM
}

extern "C" void kernel_launch(void* const* d_in, const int* in_sizes, int n_in, void* d_out, int out_size, void* d_ws, size_t ws_size, hipStream_t stream) {
    static int grid = 0;
    if (grid == 0) {
        if (n_in != N_IN || out_size != NTOK * DM || ws_size < WS_END) { fprintf(stderr, "kernel_launch: unexpected problem shape (n_in %d, out %d, ws %zu)\n", n_in, out_size, ws_size); grid = -1; return; }
        int dev = 0, cus = 0, per_cu = 0;
        if (hipGetDevice(&dev) != hipSuccess || hipDeviceGetAttribute(&cus, hipDeviceAttributeMultiprocessorCount, dev) != hipSuccess) { grid = -1; return; }
        if (hipFuncSetAttribute((const void*)fwd_kernel, hipFuncAttributeMaxDynamicSharedMemorySize, LDS_BYTES) != hipSuccess) { fprintf(stderr, "kernel_launch: hipFuncSetAttribute failed\n"); grid = -1; return; }
        if (hipOccupancyMaxActiveBlocksPerMultiprocessor(&per_cu, (const void*)fwd_kernel, NWAVES * 64, LDS_BYTES) != hipSuccess || per_cu < 1) { fprintf(stderr, "kernel_launch: occupancy query reports %d\n", per_cu); }
        (void)hipGetLastError();
        grid = cus;
    }
    if (grid < 0) return;
    (void)hipMemsetAsync((char*)d_ws + WS_CTL, 0, CTL_ZERO_BYTES, stream);
    Args a{};
    for (int i = 0; i < N_IN; ++i) a.in[i] = (const float*)d_in[i];
    a.out = (float*)d_out; a.ws = (unsigned char*)d_ws;
#if MK_SPLIT
    for (int p = 0; p < N_PHASES; ++p) { a.ph_lo = p; a.ph_hi = p + 1; hipLaunchKernelGGL(fwd_kernel, dim3(grid), dim3(NWAVES * 64), LDS_BYTES, stream, a); }
#else
    a.ph_lo = 0; a.ph_hi = N_PHASES;
    hipLaunchKernelGGL(fwd_kernel, dim3(grid), dim3(NWAVES * 64), LDS_BYTES, stream, a);
#endif
}
```

```cpp
#include <hip/hip_runtime.h>
#include <cstdio>
#include <cstdint>
#include <cmath>

namespace pg8 {
#define PG8_LAS __attribute__((address_space(3)))
typedef unsigned short bf16_t;
typedef short bf16x8 __attribute__((ext_vector_type(8)));
typedef float f32x4 __attribute__((ext_vector_type(4)));
typedef unsigned u32x4 __attribute__((ext_vector_type(4)));
constexpr int BM = 256, BK = 64, HALF = 128, HTB = HALF * BK * 2  , STAGE_BYTES = 8 * HTB, NXCD = 8, WGM = 8;

__host__ __device__ __forceinline__ int lds_byte(int r, int c) { const int st = (r >> 4) * 2 + (c >> 5), rr = r & 15, cc = c & 31, ob = rr * 64 + cc * 2; return st * 1024 + (ob ^ (((ob >> 9) & 1) << 5)); }
__host__ __device__ __forceinline__ void stage_rc(int b, int& R, int& C) { const int st = b / 1024, sb = b % 1024, swz = sb ^ (((sb >> 9) & 1) << 5); R = (st >> 1) * 16 + swz / 64; C = (st & 1) * 32 + (swz % 64) / 2; }
__host__ __device__ __forceinline__ int perm32(int rho) { const int n = rho >> 4, i = rho & 15; return 8 * (i >> 2) + 4 * n + (i & 3); }

struct Unit { int pm, pn, e; };
struct Gemm { const bf16_t* A; const bf16_t* Bt; int M, N, K; size_t estride; int lda; };

struct StaticOrder {
    int nM, nN, nwg, G, c;
    __host__ __device__ void init(int M, int N, int G_, int c_) { nM = M / BM; nN = N / BM; nwg = nM * nN; G = G_; c = c_; }
    __host__ __device__ bool next(int i, Unit& u) const {
        const long L = (long)i * G + c; if (L >= nwg) return false;
        int wgid = (int)L; { const int q = nwg / NXCD, r = nwg % NXCD, xcd = wgid % NXCD, off = wgid / NXCD; wgid = (xcd < r ? xcd * (q + 1) : r * (q + 1) + (xcd - r) * q) + off; }
        const int nig = WGM * nN, gid = wgid / nig, fm = gid * WGM, gsz = (nM - fm) < WGM ? (nM - fm) : WGM;
        u.pm = fm + ((wgid % nig) % gsz); u.pn = (wgid % nig) / gsz; u.e = 0; return true;
    }
    __device__ __forceinline__ void a_ready(const Unit&) const {}
    __device__ __forceinline__ void done(const Unit&) const {}
};
struct MoeOrder {
    StaticOrder so; int pend[8];
    __device__ __forceinline__ bool next(int i, Unit& u) const {
        if (!so.next(i, u)) return false;
        int e = 0;
#pragma unroll
        for (int j = 0; j < 7; ++j) e += (u.pm >= pend[j]) ? 1 : 0;
        u.e = e; return true;
    }
    __device__ __forceinline__ void a_ready(const Unit&) const {}
    __device__ __forceinline__ void done(const Unit&) const {}
};

__device__ __forceinline__ unsigned cvt_pk_bf16(float lo, float hi) { unsigned r; asm volatile("v_cvt_pk_bf16_f32 %0, %1, %2" : "=v"(r) : "v"(lo), "v"(hi)); return r; }

constexpr int SSW = 4;
__device__ __forceinline__ float rstd_of(const float* ss, int row) {
    const f32x4 a = *(const f32x4*)(ss + (size_t)row * SSW);
    return __builtin_amdgcn_rsqf(((a[0] + a[1]) + (a[2] + a[3])) * (1.0f / 1024.0f) + 1e-6f); }
__device__ __forceinline__ void row_scales8(const float* ss, int row0, float (&rs)[8]) {
    f32x4 t[8];
#pragma unroll
    for (int i = 0; i < 8; ++i) t[i] = *(const f32x4*)(ss + (size_t)(row0 + (i >> 2) * HALF + (i & 3) * 16) * SSW);
#pragma unroll
    for (int i = 0; i < 8; ++i) rs[i] = __builtin_amdgcn_rsqf(((t[i][0] + t[i][1]) + (t[i][2] + t[i][3])) * (1.0f / 1024.0f) + 1e-6f);
}
constexpr int PRE_OFF = 131072 + 9216, PRE_SLOT = 4096;
__device__ __forceinline__ void row_scales8_pre(const PG8_LAS float* pre, int mode, int rl0, float (&rs)[8]) {
    if (mode == 1) {
#pragma unroll
        for (int i = 0; i < 8; ++i) { const f32x4 t = *(const PG8_LAS f32x4*)(pre + (rl0 + (i >> 2) * HALF + (i & 3) * 16) * 4); rs[i] = __builtin_amdgcn_rsqf(((t[0] + t[1]) + (t[2] + t[3])) * (1.0f / 1024.0f) + 1e-6f); }
    } else if (mode == 2) {
#pragma unroll
        for (int i = 0; i < 8; ++i) rs[i] = pre[rl0 + (i >> 2) * HALF + (i & 3) * 16];
    } else {
#pragma unroll
        for (int i = 0; i < 8; ++i) rs[i] = 1.0f; }
}
__device__ __forceinline__ float bflo(unsigned w) { return __builtin_bit_cast(float, w << 16); }
__device__ __forceinline__ float bfhi(unsigned w) { return __builtin_bit_cast(float, w & 0xffff0000u); }
struct EpiBf16 {
    static constexpr bool PERM = true, AFTER_DRAIN = false;
    bf16_t* O; int ldc; const float* ss; float cin;
    __device__ __forceinline__ int pre_desc(const Unit& u, const char*& src) const { src = (const char*)(ss + (size_t)u.pm * BM * SSW); return ss ? 1 : 0; }
    __device__ __forceinline__ void operator()(const f32x4 (&acc)[2][2][4][2], const Unit& u, int wr, int wc, int fr, int fq, const PG8_LAS float* pre) const {
        const int row0 = u.pm * BM + wr * 64 + fr, col0 = u.pn * BM + wc * 32 + 8 * fq;
        float rs8[8];
        row_scales8_pre(pre, ss ? 1 : 0, wr * 64 + fr, rs8);
#pragma unroll
        for (int i = 0; i < 8; ++i) rs8[i] *= cin;
#pragma unroll
        for (int ai = 0; ai < 2; ++ai)
#pragma unroll
            for (int m = 0; m < 4; ++m) { const int row = row0 + ai * HALF + m * 16; bf16_t* rowp = O + (size_t)row * ldc + col0; const float rs = rs8[ai * 4 + m];
#pragma unroll
                for (int bj = 0; bj < 2; ++bj) { const f32x4 v0 = acc[ai][bj][m][0] * rs, v1 = acc[ai][bj][m][1] * rs;
                    u32x4 w; w.x = cvt_pk_bf16(v0[0], v0[1]); w.y = cvt_pk_bf16(v0[2], v0[3]); w.z = cvt_pk_bf16(v1[0], v1[1]); w.w = cvt_pk_bf16(v1[2], v1[3]);
                    *(u32x4*)(rowp + bj * HALF) = w; } }
    }
};
struct EpiLat {
    static constexpr bool PERM = true, AFTER_DRAIN = false;
    bf16_t* O; const float* ss; float* ssq; float* sskv; PG8_LAS float* tab;
    __device__ __forceinline__ int pre_desc(const Unit& u, const char*& src) const { src = (const char*)(ss + (size_t)u.pm * BM * SSW); return 1; }
    __device__ __forceinline__ void operator()(const f32x4 (&acc)[2][2][4][2], const Unit& u, int wr, int wc, int fr, int fq, const PG8_LAS float* pre) const {
        const int row0 = u.pm * BM + wr * 64 + fr, col0 = u.pn * BM + wc * 32 + 8 * fq;
        float rs8[8];
        row_scales8_pre(pre, 1, wr * 64 + fr, rs8);
#pragma unroll
        for (int ai = 0; ai < 2; ++ai)
#pragma unroll
            for (int m = 0; m < 4; ++m) { const int row = row0 + ai * HALF + m * 16; bf16_t* rowp = O + (size_t)row * 768 + col0; const float rs = rs8[ai * 4 + m]; float part[2];
#pragma unroll
                for (int bj = 0; bj < 2; ++bj) { const f32x4 v0 = acc[ai][bj][m][0] * rs, v1 = acc[ai][bj][m][1] * rs;
                    u32x4 w; w.x = cvt_pk_bf16(v0[0], v0[1]); w.y = cvt_pk_bf16(v0[2], v0[3]); w.z = cvt_pk_bf16(v1[0], v1[1]); w.w = cvt_pk_bf16(v1[2], v1[3]);
                    *(u32x4*)(rowp + bj * HALF) = w;
                    part[bj] = (bflo(w.x) * bflo(w.x) + bfhi(w.x) * bfhi(w.x)) + (bflo(w.y) * bflo(w.y) + bfhi(w.y) * bfhi(w.y)) + (bflo(w.z) * bflo(w.z) + bfhi(w.z) * bfhi(w.z)) + (bflo(w.w) * bflo(w.w) + bfhi(w.w) * bfhi(w.w)); }
#pragma unroll
                for (int bj = 0; bj < 2; ++bj) { part[bj] += __shfl_xor(part[bj], 16); part[bj] += __shfl_xor(part[bj], 32); }
                if (fq == 0) { PG8_LAS float* t = tab + (ai * HALF + wr * 64 + m * 16 + fr) * 8 + wc; t[0] = part[0]; t[4] = part[1]; } }
        asm volatile("s_waitcnt lgkmcnt(0)" ::: "memory"); __builtin_amdgcn_s_barrier(); asm volatile("" ::: "memory");
        { const int t = wr * 256 + wc * 64 + fq * 16 + fr;
          if (t < 256) { const f32x4 q0 = *(const PG8_LAS f32x4*)(tab + t * 8), q1 = *(const PG8_LAS f32x4*)(tab + t * 8 + 4);
              const float p0 = (q0[0] + q0[1]) + (q0[2] + q0[3]), p1 = (q1[0] + q1[1]) + (q1[2] + q1[3]); const size_t o = (size_t)(u.pm * BM + t) * SSW;
              const float cq = 1024.0f / 384.0f, ckv = 4.0f;
              if (u.pn == 0) { ssq[o] = (p0 + p1) * cq; ssq[o + 2] = 0.f; ssq[o + 3] = 0.f; }
              else if (u.pn == 1) { ssq[o + 1] = p0 * cq; sskv[o] = p1 * ckv; sskv[o + 2] = 0.f; sskv[o + 3] = 0.f; }
              else { sskv[o + 1] = p0 * ckv; } } }
    }
};
__device__ __forceinline__ float silu_mul(float g, float u) { return g * u * __builtin_amdgcn_rcpf(1.0f + __builtin_amdgcn_exp2f(-1.4426950408889634f * g)); }
__device__ __forceinline__ f32x4 swiglu4(const f32x4 a, const f32x4 b, float kx, float kk) {
    const f32x4 t = a * kx; f32x4 r;
#pragma unroll
    for (int i = 0; i < 4; ++i) r[i] = __builtin_amdgcn_rcpf(1.0f + __builtin_amdgcn_exp2f(t[i]));
    return ((a * b) * r) * kk;
}
struct EpiSwiglu {
    static constexpr bool PERM = true, AFTER_DRAIN = false;
    bf16_t* O; int ldc; const float* ss;
    __device__ __forceinline__ int pre_desc(const Unit& u, const char*& src) const { src = (const char*)(ss + (size_t)u.pm * BM * SSW); return ss ? 1 : 0; }
    __device__ __forceinline__ void operator()(const f32x4 (&acc)[2][2][4][2], const Unit& u, int wr, int wc, int fr, int fq, const PG8_LAS float* pre) const {
        const int row0 = u.pm * BM + wr * 64 + fr, col0 = u.pn * HALF + wc * 32 + 8 * fq;
        float rs8[8];
        row_scales8_pre(pre, ss ? 1 : 0, wr * 64 + fr, rs8);
#pragma unroll
        for (int ai = 0; ai < 2; ++ai)
#pragma unroll
            for (int m = 0; m < 4; ++m) { const int row = row0 + ai * HALF + m * 16; bf16_t* rowp = O + (size_t)row * ldc + col0; const float rs = rs8[ai * 4 + m];
                const float kx = -1.4426950408889634f * rs, kk = rs * rs;
                const f32x4 s0 = swiglu4(acc[ai][0][m][0], acc[ai][1][m][0], kx, kk), s1 = swiglu4(acc[ai][0][m][1], acc[ai][1][m][1], kx, kk);
                u32x4 w; w.x = cvt_pk_bf16(s0[0], s0[1]); w.y = cvt_pk_bf16(s0[2], s0[3]); w.z = cvt_pk_bf16(s1[0], s1[1]); w.w = cvt_pk_bf16(s1[2], s1[3]);
                *(u32x4*)rowp = w; }
    }
};
__device__ __forceinline__ float clamp448(float x) { return __builtin_fminf(__builtin_fmaxf(x, -448.0f), 448.0f); }
__device__ __forceinline__ unsigned pk4_fp8(float a, float b, float c, float d) {
    int w = 0; w = __builtin_amdgcn_cvt_pk_fp8_f32(clamp448(a), clamp448(b), w, false); w = __builtin_amdgcn_cvt_pk_fp8_f32(clamp448(c), clamp448(d), w, true); return (unsigned)w; }
struct EpiSwigluF8 {
    static constexpr bool PERM = true, AFTER_DRAIN = false;
    unsigned char* O; int ldc; float cin, so; const float* rs; const float* ssp;
    __device__ __forceinline__ int pre_desc(const Unit& u, const char*& src) const { src = ssp ? (const char*)(ssp + (size_t)u.pm * BM * SSW) : (const char*)(rs + (size_t)u.pm * BM); return ssp ? 1 : (rs ? 2 : 0); }
    __device__ __forceinline__ void operator()(const f32x4 (&acc)[2][2][4][2], const Unit& u, int wr, int wc, int fr, int fq, const PG8_LAS float* pre) const {
        const int row0 = u.pm * BM + wr * 64 + fr, col0 = u.pn * HALF + wc * 32 + 16 * (fq >> 1);
        float cr[8];
        row_scales8_pre(pre, ssp ? 1 : (rs ? 2 : 0), wr * 64 + fr, cr);
#pragma unroll
        for (int i = 0; i < 8; ++i) cr[i] *= cin;
#pragma unroll
        for (int ai = 0; ai < 2; ++ai)
#pragma unroll
            for (int mp = 0; mp < 2; ++mp) { unsigned lo[2], hi[2];
#pragma unroll
                for (int q = 0; q < 2; ++q) { const int m = 2 * mp + q; const float c = cr[ai * 4 + m];
                    const float kx = -1.4426950408889634f * c, kk = c * c * so;
                    const f32x4 s0 = swiglu4(acc[ai][0][m][0], acc[ai][1][m][0], kx, kk), s1 = swiglu4(acc[ai][0][m][1], acc[ai][1][m][1], kx, kk);
                    lo[q] = pk4_fp8(s0[0], s0[1], s0[2], s0[3]); hi[q] = pk4_fp8(s1[0], s1[1], s1[2], s1[3]); }
                const auto s0 = __builtin_amdgcn_permlane16_swap(lo[0], lo[1], false, false); const auto s1 = __builtin_amdgcn_permlane16_swap(hi[0], hi[1], false, false);
                u32x4 w; w.x = s0[0]; w.y = s1[0]; w.z = s0[1]; w.w = s1[1];
                const int row = row0 + ai * HALF + (2 * mp + (fq & 1)) * 16;
                *(u32x4*)(O + (size_t)row * ldc + col0) = w; }
    }
};
struct EpiResid {
    static constexpr bool PERM = false, AFTER_DRAIN = false;
    const float* base; float* out; int ldc; float cin;
    __device__ __forceinline__ void operator()(const f32x4 (&acc)[2][2][4][2], const Unit& u, int wr, int wc, int fr, int fq) const {
        const int row0 = u.pm * BM + wr * 64 + fr, col0 = u.pn * BM + wc * 32 + 4 * fq;
#pragma unroll
        for (int ai = 0; ai < 2; ++ai)
#pragma unroll
            for (int m = 0; m < 4; ++m) { const size_t off = (size_t)(row0 + ai * HALF + m * 16) * ldc + col0;
#pragma unroll
                for (int bj = 0; bj < 2; ++bj)
#pragma unroll
                    for (int n = 0; n < 2; ++n) { const f32x4 b = *(const f32x4*)(base + off + bj * HALF + n * 16); *(f32x4*)(out + off + bj * HALF + n * 16) = b + acc[ai][bj][m][n] * cin; } }
    }
};
template <bool COPY8> struct EpiResidBT {
    static constexpr bool PERM = true, AFTER_DRAIN = false;
    bf16_t* x; int ldc; float cin; float* ssq; PG8_LAS float* tab; unsigned char* x8; float s8;
    __device__ __forceinline__ int pre_desc(const Unit&, const char*& src) const { src = nullptr; return 0; }
    __device__ __forceinline__ void operator()(const f32x4 (&acc)[2][2][4][2], const Unit& u, int wr, int wc, int fr, int fq, const PG8_LAS float*) const {
        const int row0 = u.pm * BM + wr * 64 + fr, col0 = u.pn * BM + wc * 32 + 8 * fq;
#pragma unroll
        for (int ai = 0; ai < 2; ++ai) { u32x4 b[4][2];
#pragma unroll
            for (int m = 0; m < 4; ++m)
#pragma unroll
                for (int bj = 0; bj < 2; ++bj) b[m][bj] = *(const u32x4*)(x + (size_t)(row0 + ai * HALF + m * 16) * ldc + col0 + bj * HALF);
#pragma unroll
            for (int m = 0; m < 4; ++m) { const int row = row0 + ai * HALF + m * 16; bf16_t* rowp = x + (size_t)row * ldc + col0; float part = 0.f;
#pragma unroll
                for (int bj = 0; bj < 2; ++bj) { const u32x4 bb = b[m][bj]; const f32x4 a0 = acc[ai][bj][m][0], a1 = acc[ai][bj][m][1];
                    const float y0 = __builtin_fmaf(a0[0], cin, bflo(bb.x)), y1 = __builtin_fmaf(a0[1], cin, bfhi(bb.x)), y2 = __builtin_fmaf(a0[2], cin, bflo(bb.y)), y3 = __builtin_fmaf(a0[3], cin, bfhi(bb.y));
                    const float y4 = __builtin_fmaf(a1[0], cin, bflo(bb.z)), y5 = __builtin_fmaf(a1[1], cin, bfhi(bb.z)), y6 = __builtin_fmaf(a1[2], cin, bflo(bb.w)), y7 = __builtin_fmaf(a1[3], cin, bfhi(bb.w));
                    u32x4 w; w.x = cvt_pk_bf16(y0, y1); w.y = cvt_pk_bf16(y2, y3); w.z = cvt_pk_bf16(y4, y5); w.w = cvt_pk_bf16(y6, y7);
                    *(u32x4*)(rowp + bj * HALF) = w;
                    if (COPY8) { const unsigned lo8 = pk4_fp8(y0 * s8, y1 * s8, y2 * s8, y3 * s8), hi8 = pk4_fp8(y4 * s8, y5 * s8, y6 * s8, y7 * s8);
                        *(unsigned long long*)(x8 + (size_t)row * ldc + col0 + bj * HALF) = (unsigned long long)lo8 | ((unsigned long long)hi8 << 32); }
                    part += (y0 * y0 + y1 * y1) + (y2 * y2 + y3 * y3) + (y4 * y4 + y5 * y5) + (y6 * y6 + y7 * y7); }
                part += __shfl_xor(part, 16); part += __shfl_xor(part, 32);
                if (fq == 0) tab[(ai * HALF + wr * 64 + m * 16 + fr) * 4 + wc] = part; } }
        asm volatile("s_waitcnt lgkmcnt(0)" ::: "memory"); __builtin_amdgcn_s_barrier(); asm volatile("" ::: "memory");
        { const int t = wr * 256 + wc * 64 + fq * 16 + fr;
          if (t < 256) { const f32x4 q = *(const PG8_LAS f32x4*)(tab + t * 4); ssq[(size_t)(u.pm * BM + t) * SSW + u.pn] = (q[0] + q[1]) + (q[2] + q[3]); } }
    }
};
typedef EpiResidBT<false> EpiResidB; typedef EpiResidBT<true> EpiResidB8;
struct EpiMoeDown {
    static constexpr bool PERM = true, AFTER_DRAIN = false;
    bf16_t* O; int ldc; const float* gate; float cin;
    __device__ __forceinline__ int pre_desc(const Unit& u, const char*& src) const { src = (const char*)(gate + (size_t)u.pm * BM); return 2; }
    __device__ __forceinline__ void operator()(const f32x4 (&acc)[2][2][4][2], const Unit& u, int wr, int wc, int fr, int fq, const PG8_LAS float* pre) const {
        const int row0 = u.pm * BM + wr * 64 + fr, col0 = u.pn * BM + wc * 32 + 8 * fq;
#pragma unroll
        for (int ai = 0; ai < 2; ++ai)
#pragma unroll
            for (int m = 0; m < 4; ++m) { const int row = row0 + ai * HALF + m * 16; const float gt = pre[wr * 64 + fr + ai * HALF + m * 16] * cin; bf16_t* rowp = O + (size_t)row * ldc + col0;
#pragma unroll
                for (int bj = 0; bj < 2; ++bj) { const f32x4 v0 = acc[ai][bj][m][0] * gt, v1 = acc[ai][bj][m][1] * gt;
                    u32x4 w; w.x = cvt_pk_bf16(v0[0], v0[1]); w.y = cvt_pk_bf16(v0[2], v0[3]); w.z = cvt_pk_bf16(v1[0], v1[1]); w.w = cvt_pk_bf16(v1[2], v1[3]);
                    *(u32x4*)(rowp + bj * HALF) = w; } }
    }
};
struct EpiRope {
    static constexpr bool PERM = true, AFTER_DRAIN = false;
    bf16_t* O; int ldc; const float* tab; int rope_pn0, seq;
    __device__ __forceinline__ void operator()(const f32x4 (&acc)[2][2][4][2], const Unit& u, int wr, int wc, int fr, int fq) const {
        const int row0 = u.pm * BM + wr * 64 + fr, col0 = u.pn * BM + wc * 32 + 8 * fq;
        if (u.pn < rope_pn0) {
#pragma unroll
            for (int ai = 0; ai < 2; ++ai)
#pragma unroll
                for (int m = 0; m < 4; ++m) { bf16_t* rowp = O + (size_t)(row0 + ai * HALF + m * 16) * ldc + col0;
#pragma unroll
                    for (int bj = 0; bj < 2; ++bj) { const f32x4 v0 = acc[ai][bj][m][0], v1 = acc[ai][bj][m][1];
                        u32x4 w; w.x = cvt_pk_bf16(v0[0], v0[1]); w.y = cvt_pk_bf16(v0[2], v0[3]); w.z = cvt_pk_bf16(v1[0], v1[1]); w.w = cvt_pk_bf16(v1[2], v1[3]);
                        *(u32x4*)(rowp + bj * HALF) = w; } }
        } else {
#pragma unroll
            for (int ai = 0; ai < 2; ++ai)
#pragma unroll
                for (int m = 0; m < 4; ++m) { const int row = row0 + ai * HALF + m * 16; bf16_t* rowp = O + (size_t)row * ldc + col0;
                    const float* t = tab + (size_t)(row % seq) * 32 + 8 * fq; const f32x4 c0 = *(const f32x4*)t, c1 = *(const f32x4*)(t + 4);
#pragma unroll
                    for (int bj = 0; bj < 2; ++bj) { const f32x4 v0 = acc[ai][bj][m][0], v1 = acc[ai][bj][m][1];
                        u32x4 w; w.x = cvt_pk_bf16(v0[0] * c0[0] - v0[1] * c0[1], v0[0] * c0[1] + v0[1] * c0[0]); w.y = cvt_pk_bf16(v0[2] * c0[2] - v0[3] * c0[3], v0[2] * c0[3] + v0[3] * c0[2]);
                        w.z = cvt_pk_bf16(v1[0] * c1[0] - v1[1] * c1[1], v1[0] * c1[1] + v1[1] * c1[0]); w.w = cvt_pk_bf16(v1[2] * c1[2] - v1[3] * c1[3], v1[2] * c1[3] + v1[3] * c1[2]);
                        *(u32x4*)(rowp + bj * HALF) = w; }
                    asm volatile("" ::: "memory"); }
        }
    }
};

typedef int v4i_t __attribute__((ext_vector_type(4)));
typedef int v8i_t __attribute__((ext_vector_type(8)));
template <bool FP8> __device__ __forceinline__ void mma_block(f32x4 (&acc)[4][2], const bf16x8 (&At)[4][2], const bf16x8 (&Bt)[2][2]) {
    __builtin_amdgcn_s_setprio(1);
#pragma unroll
    for (int m = 0; m < 4; ++m)
#pragma unroll
        for (int n = 0; n < 2; ++n) {
            if constexpr (FP8) {
                const v8i_t b = __builtin_shufflevector(__builtin_bit_cast(v4i_t, Bt[n][0]), __builtin_bit_cast(v4i_t, Bt[n][1]), 0, 1, 2, 3, 4, 5, 6, 7);
                const v8i_t a = __builtin_shufflevector(__builtin_bit_cast(v4i_t, At[m][0]), __builtin_bit_cast(v4i_t, At[m][1]), 0, 1, 2, 3, 4, 5, 6, 7);
                asm volatile("v_mfma_f32_16x16x128_f8f6f4 %0, %1, %2, %0" : "+v"(acc[m][n]) : "v"(b), "v"(a));
            } else {
#pragma unroll
                for (int k = 0; k < 2; ++k) acc[m][n] = __builtin_amdgcn_mfma_f32_16x16x32_bf16(Bt[n][k], At[m][k], acc[m][n], 0, 0, 0);
            }
        }
    __builtin_amdgcn_s_setprio(0);
}
typedef double f64x2_t __attribute__((ext_vector_type(2)));
__device__ __forceinline__ f32x4 zero4() { double a, b; asm volatile("v_mov_b64 %0, 0" : "=v"(a)); asm volatile("v_mov_b64 %0, 0" : "=v"(b)); const f64x2_t d = {a, b}; return __builtin_bit_cast(f32x4, d); }
template <class Epi, class Sched, bool ALIGN_EPI = false, bool SP2 = false, bool FP8 = false>
__device__ __forceinline__ void gemm_phase(PG8_LAS unsigned char* lds, const Gemm g, const Sched& S, const Epi& E) {
    const int tid = threadIdx.x, wid = __builtin_amdgcn_readfirstlane(tid >> 6), lane = tid & 63, wr = wid >> 2, wc = wid & 3, fr = lane & 15, fq = lane >> 4;
    const int K = g.K, nt = K / BK, lda = g.lda ? g.lda : K;
    unsigned voffA[2], voffB[2];
#pragma unroll
    for (int i = 0; i < 2; ++i) { int R, C; stage_rc(tid * 16 + i * 8192, R, C); const int Rb = Epi::PERM ? ((R & ~31) + perm32(R & 31)) : R;
        voffA[i] = (unsigned)(R * lda + C) * 2u; voffB[i] = (unsigned)(Rb * K + C) * 2u; }
    const size_t kstep = (size_t)(BK * 2);
    const size_t hstep = (size_t)HALF * K * 2;
    const size_t tstep = 2 * hstep;
    const size_t hstepA = (size_t)HALF * lda * 2, tstepA = 2 * hstepA;
    const unsigned ldsw = (unsigned)wid * 1024u;
    const int aoff = lds_byte(wr * 64 + fr, fq * 8), boff = lds_byte(wc * 32 + fr, fq * 8);
#define PG8_SA(b, h) (((b) * 2 + (h)) * HTB)
#define PG8_SB(b, h) ((4 + (b) * 2 + (h)) * HTB)
#define PG8_STAGE(bufoff, gbase, voff) do { _Pragma("unroll") for (int _i = 0; _i < 2; ++_i) \
        __builtin_amdgcn_global_load_lds((const unsigned*)((const char*)(gbase) + (voff)[_i]), (PG8_LAS unsigned*)(lds + (bufoff) + ldsw + _i * 8192), 16, 0, 0); } while (0)
#define PG8_LDA(dst, b, h) do { _Pragma("unroll") for (int m = 0; m < 4; ++m) _Pragma("unroll") for (int k = 0; k < 2; ++k) dst[m][k] = *(const PG8_LAS bf16x8*)(lds + PG8_SA(b, h) + aoff + m * 2048 + k * 1024); } while (0)
#define PG8_LDB(dst, b, h) do { _Pragma("unroll") for (int n = 0; n < 2; ++n) _Pragma("unroll") for (int k = 0; k < 2; ++k) dst[n][k] = *(const PG8_LAS bf16x8*)(lds + PG8_SB(b, h) + boff + n * 2048 + k * 1024); } while (0)
#define PG8_MMA(ai, bj, At, Bt) mma_block<FP8>(acc[ai][bj], At, Bt)
#define PG8_WAIT_V(n) asm volatile("s_waitcnt vmcnt(" #n ")" ::: "memory")
#define PG8_WAIT_L(n) asm volatile("s_waitcnt lgkmcnt(" #n ")" ::: "memory")
#define PG8_BAR __builtin_amdgcn_s_barrier()
#define PG8_SCHED __builtin_amdgcn_sched_barrier(0)
    Unit cur, nxt; int ui = 0;
    if (!S.next(0, cur)) return;
    f32x4 acc[2][2][4][2];
#pragma unroll
    for (int a = 0; a < 2; ++a)
#pragma unroll
        for (int b = 0; b < 2; ++b)
#pragma unroll
            for (int m = 0; m < 4; ++m)
#pragma unroll
                for (int n = 0; n < 2; ++n) acc[a][b][m][n] = zero4();
    bf16x8 At[4][2], B0[2][2], B1[2][2];
    const char* cA = (const char*)g.A + (size_t)cur.pm * tstepA; const char* cB = (const char*)g.Bt + (size_t)cur.e * g.estride + (size_t)cur.pn * tstep;
    S.a_ready(cur);
#define PG8_PRE(unit_, slot_) do { const char* src_; const int md_ = E.pre_desc(unit_, src_); \
        if (md_ == 1) { if (wid < 4) __builtin_amdgcn_global_load_lds((const unsigned*)(src_ + (size_t)(wid * 64 + lane) * 16), (PG8_LAS unsigned*)(lds + PRE_OFF + (slot_) * PRE_SLOT + wid * 1024), 16, 0, 0); } \
        else if (md_ == 2) { if (wid == 0) __builtin_amdgcn_global_load_lds((const unsigned*)(src_ + (size_t)lane * 16), (PG8_LAS unsigned*)(lds + PRE_OFF + (slot_) * PRE_SLOT), 16, 0, 0); } } while (0)
    PG8_PRE(cur, 0);
    if constexpr (SP2) {
        PG8_STAGE(PG8_SB(0, 0), cB, voffB); PG8_STAGE(PG8_SB(0, 1), cB + hstep, voffB); PG8_STAGE(PG8_SA(0, 0), cA, voffA); PG8_STAGE(PG8_SA(0, 1), cA + hstepA, voffA);
        PG8_STAGE(PG8_SB(1, 0), cB + kstep, voffB); PG8_STAGE(PG8_SA(1, 0), cA + kstep, voffA); PG8_STAGE(PG8_SB(1, 1), cB + hstep + kstep, voffB);
        if (wr == 1) PG8_BAR;
        PG8_WAIT_V(8); PG8_BAR;
        PG8_WAIT_V(6); PG8_BAR;
    } else {
        PG8_STAGE(PG8_SB(0, 0), cB, voffB); PG8_STAGE(PG8_SA(0, 0), cA, voffA); PG8_STAGE(PG8_SB(0, 1), cB + hstep, voffB); PG8_STAGE(PG8_SA(0, 1), cA + hstepA, voffA);
        if (wr == 1) PG8_BAR;
        PG8_WAIT_V(4); PG8_BAR;
        PG8_STAGE(PG8_SB(1, 0), cB + kstep, voffB); PG8_STAGE(PG8_SA(1, 0), cA + kstep, voffA); PG8_STAGE(PG8_SB(1, 1), cB + hstep + kstep, voffB);
        PG8_WAIT_V(6); PG8_BAR;
    }
    for (;;) {
        const bool has_next = S.next(ui + 1, nxt);
        const char* nA = has_next ? (const char*)g.A + (size_t)nxt.pm * tstepA : cA; const char* nB = has_next ? (const char*)g.Bt + (size_t)nxt.e * g.estride + (size_t)nxt.pn * tstep : cB;
#pragma nounroll
        for (int t = 0; t < nt; t += 2) {
            const bool last = (t == nt - 2);
            const char* a1 = cA + (size_t)(t + 1) * kstep;
            const char* a2 = last ? nA : cA + (size_t)(t + 2) * kstep; const char* b2 = last ? nB : cB + (size_t)(t + 2) * kstep;
            const char* a3 = a2 + kstep; const char* b3 = b2 + kstep;
            if (last && has_next) S.a_ready(nxt);
            if constexpr (SP2) {
            PG8_LDB(B0, 0, 0); PG8_LDB(B1, 0, 1); PG8_SCHED; PG8_LDA(At, 0, 0); PG8_STAGE(PG8_SA(1, 1), a1 + hstepA, voffA);
            PG8_WAIT_V(8); PG8_WAIT_L(0); PG8_BAR; PG8_MMA(0, 0, At, B0); PG8_MMA(0, 1, At, B1); PG8_BAR; PG8_SCHED;
            PG8_LDA(At, 0, 1); PG8_STAGE(PG8_SB(0, 0), b2, voffB); PG8_STAGE(PG8_SB(0, 1), b2 + hstep, voffB); PG8_STAGE(PG8_SA(0, 0), a2, voffA);
            PG8_WAIT_V(8); PG8_WAIT_L(0); PG8_BAR; PG8_MMA(1, 0, At, B0); PG8_MMA(1, 1, At, B1); PG8_BAR; PG8_SCHED;
            PG8_LDB(B0, 1, 0); PG8_LDB(B1, 1, 1); PG8_SCHED; PG8_LDA(At, 1, 0); PG8_STAGE(PG8_SA(0, 1), a2 + hstepA, voffA);
            PG8_WAIT_V(8); PG8_WAIT_L(0); PG8_BAR; PG8_MMA(0, 0, At, B0); PG8_MMA(0, 1, At, B1); PG8_BAR; PG8_SCHED;
            PG8_LDA(At, 1, 1); PG8_STAGE(PG8_SB(1, 0), b3, voffB); PG8_STAGE(PG8_SB(1, 1), b3 + hstep, voffB); PG8_STAGE(PG8_SA(1, 0), a3, voffA);
            PG8_WAIT_V(8); PG8_WAIT_L(0); PG8_BAR; PG8_MMA(1, 0, At, B0); PG8_MMA(1, 1, At, B1); PG8_BAR; PG8_SCHED;
            } else {
            PG8_LDB(B0, 0, 0); PG8_SCHED; PG8_LDA(At, 0, 0); PG8_STAGE(PG8_SA(1, 1), a1 + hstepA, voffA);
            PG8_WAIT_L(8); PG8_BAR; PG8_WAIT_L(0); PG8_MMA(0, 0, At, B0); PG8_BAR; PG8_SCHED;
            PG8_LDB(B1, 0, 1); PG8_STAGE(PG8_SB(0, 0), b2, voffB);
            PG8_BAR; PG8_WAIT_L(0); PG8_MMA(0, 1, At, B1); PG8_BAR;
            PG8_LDA(At, 0, 1); PG8_STAGE(PG8_SA(0, 0), a2, voffA);
            PG8_BAR; PG8_WAIT_L(0); PG8_MMA(1, 0, At, B0); PG8_BAR; PG8_SCHED;
            PG8_STAGE(PG8_SB(0, 1), b2 + hstep, voffB);
            PG8_WAIT_V(6); PG8_BAR; PG8_MMA(1, 1, At, B1); PG8_BAR;
            PG8_LDB(B0, 1, 0); PG8_SCHED; PG8_LDA(At, 1, 0); PG8_STAGE(PG8_SA(0, 1), a2 + hstepA, voffA);
            PG8_WAIT_L(8); PG8_BAR; PG8_WAIT_L(0); PG8_MMA(0, 0, At, B0); PG8_BAR; PG8_SCHED;
            PG8_LDB(B1, 1, 1); PG8_STAGE(PG8_SB(1, 0), b3, voffB);
            PG8_BAR; PG8_WAIT_L(0); PG8_MMA(0, 1, At, B1); PG8_BAR;
            PG8_LDA(At, 1, 1); PG8_STAGE(PG8_SA(1, 0), a3, voffA);
            PG8_BAR; PG8_WAIT_L(0); PG8_MMA(1, 0, At, B0); PG8_BAR; PG8_SCHED;
            PG8_STAGE(PG8_SB(1, 1), b3 + hstep, voffB);
            PG8_WAIT_V(6); PG8_BAR; PG8_MMA(1, 1, At, B1); PG8_BAR;
            }
        }
        if constexpr (ALIGN_EPI) { if (wr == 0) PG8_BAR; }
        if constexpr (FP8) {
#pragma unroll
            for (int a = 0; a < 2; ++a)
#pragma unroll
                for (int b = 0; b < 2; ++b) asm volatile("s_nop 15\n\ts_nop 15" : "+v"(acc[a][b][0][0]), "+v"(acc[a][b][0][1]), "+v"(acc[a][b][1][0]), "+v"(acc[a][b][1][1]), "+v"(acc[a][b][2][0]), "+v"(acc[a][b][2][1]), "+v"(acc[a][b][3][0]), "+v"(acc[a][b][3][1]));
        }
        if constexpr (!Epi::AFTER_DRAIN) { if (has_next) PG8_PRE(nxt, (ui + 1) & 1);
            E(acc, cur, wr, wc, fr, fq, (const PG8_LAS float*)(lds + PRE_OFF + (ui & 1) * PRE_SLOT)); S.done(cur); }
        if (!has_next) break;
#pragma unroll
        for (int a = 0; a < 2; ++a)
#pragma unroll
            for (int b = 0; b < 2; ++b)
#pragma unroll
                for (int m = 0; m < 4; ++m)
#pragma unroll
                    for (int n = 0; n < 2; ++n) acc[a][b][m][n] = zero4();
        cur = nxt; cA = nA; cB = nB; ++ui;
        if constexpr (ALIGN_EPI) { if (wr == 1) PG8_BAR; }
    }
    PG8_WAIT_V(0);
    if constexpr (!ALIGN_EPI) { if (wr == 0) PG8_BAR; }
    PG8_BAR;
    if constexpr (Epi::AFTER_DRAIN) { E.fused(acc, cur, wr, wc, fr, fq, lds, wid, lane); S.done(cur); }
#undef PG8_PRE
#undef PG8_SA
#undef PG8_SB
#undef PG8_STAGE
#undef PG8_LDA
#undef PG8_LDB
#undef PG8_MMA
#undef PG8_WAIT_V
#undef PG8_WAIT_L
#undef PG8_BAR
#undef PG8_SCHED
}
}
#ifndef PG8_SP2
#define PG8_SP2 true
#endif
#ifndef PG8_ALIGN
#define PG8_ALIGN true
#endif

constexpr int NWAVES = 8;
constexpr int BATCH = 8, SEQ = 4096, DM = 1024, NTOK = BATCH * SEQ;
constexpr int FFD = 2816, FFE = 3584, NEXP = 8;
constexpr int NSLOT = (NTOK * 2 / 256 + NEXP) * 256;
constexpr float NORM_EPS = 1e-6f, SUBLN_EPS = 1e-5f, LOG2E = 1.4426950408889634f;
constexpr int N_IN = 41;
enum { I_X = 0, I_A_NORM, I_A_WQKV, I_A_WO, I_F0_NORM, I_F0_WG, I_F0_WU, I_F0_WD, I_B_NORM, I_B_WQKV, I_B_LQ1, I_B_LK1, I_B_LQ2, I_B_LK2, I_B_SUBLN, I_B_WO,
       I_M1_NORM, I_M1_WR, I_M1_WG, I_M1_WU, I_M1_WD, I_C_NORM, I_C_WIN, I_C_QNORM, I_C_WQUP, I_C_KVNORM, I_C_WKVUP, I_C_WO, I_F2_NORM, I_F2_WG, I_F2_WU, I_F2_WD,
       I_D_NORM, I_D_WQKV, I_D_WO, I_M3_NORM, I_M3_WR, I_M3_WG, I_M3_WU, I_M3_WD, I_FINAL_NORM };

constexpr size_t MiB = 1ull << 20, KiB = 1024;
constexpr size_t WS_CTL = 0, CTL_ZERO_BYTES = 64 * KiB;
constexpr size_t WS_ROPE = 1 * MiB;
constexpr size_t WS_WGCNT = 1 * MiB + 512 * KiB;
constexpr size_t WS_KN = 1 * MiB + 576 * KiB;
constexpr size_t WS_TOKE = 2 * MiB, WS_TOKG = WS_TOKE + 256 * KiB, WS_TOKS = WS_TOKG + 256 * KiB;
constexpr size_t WS_SGATE = 3 * MiB;
constexpr size_t WS_W = 4 * MiB;
constexpr size_t W_QKV_A = WS_W, W_O_A = WS_W + 9 * MiB, W_GU0 = WS_W + 10 * MiB, W_D0 = WS_W + 21 * MiB, W_QKV_B = WS_W + 27 * MiB, W_O_B = WS_W + 33 * MiB,
                 W_IN_C = WS_W + 35 * MiB, W_QUP_C = WS_W + 37 * MiB, W_KVUP_C = WS_W + 39 * MiB, W_O_C = WS_W + 40 * MiB, W_GU2 = WS_W + 42 * MiB, W_D2 = WS_W + 53 * MiB,
                 W_QKV_D = WS_W + 59 * MiB, W_O_D = WS_W + 65 * MiB;
constexpr size_t W_MOE_GU = 72 * MiB, W_MOE_D = 128 * MiB, W_MOE_L2 = 84 * MiB;
constexpr size_t WS_H = 240 * MiB;
constexpr size_t WS_XB = 304 * MiB;
constexpr size_t WS_BIG = 436 * MiB;
constexpr size_t WS_END = 898 * MiB;
constexpr size_t WS_XR = WS_BIG + 288 * MiB;
constexpr size_t WS_SS = WS_END, SS_BYTES = 16 * MiB;
constexpr size_t WS_SSS = WS_END + 16 * MiB;
constexpr size_t WS_GWR = 1 * MiB + 640 * KiB;
static_assert(WS_BIG + (size_t)NSLOT * FFE * 2 <= WS_END && WS_XB + (size_t)NSLOT * DM * 2 <= WS_BIG && WS_H + (size_t)NTOK * DM * 2 <= WS_XB && W_MOE_D + W_MOE_L2 + 8ull * 1024 * 3584 <= WS_H, "d_ws map");
constexpr size_t C_LAT = WS_BIG, C_Q = WS_BIG + 48 * MiB, C_KV = WS_BIG + 144 * MiB;
constexpr size_t C_QN = WS_XB, C_KVN = WS_XB + 24 * MiB, C_KPE = WS_XB + 40 * MiB;
constexpr int CW_TMO = 0, CW_QB = 64, CW_BAR = 4096;

constexpr int RING_OFF = 0, RING_BYTES = 131072;
constexpr int MISC_OFF = RING_BYTES + 320;
constexpr int RESTAB_OFF = RING_BYTES + 1024;
constexpr int LDS_BYTES = 149504;
static_assert(RESTAB_OFF + 8192 <= pg8::PRE_OFF && pg8::PRE_OFF + 2 * pg8::PRE_SLOT <= LDS_BYTES, "LDS map");
#define GAS __attribute__((address_space(1)))
#define LAS __attribute__((address_space(3)))
typedef unsigned short bf16;
typedef unsigned v4u __attribute__((ext_vector_type(4)));
typedef float f32x4 __attribute__((ext_vector_type(4)));
typedef short bf16x8 __attribute__((ext_vector_type(8)));
typedef GAS unsigned gu32;
typedef GAS unsigned long long gu64;
#define RLX_AGENT __ATOMIC_RELAXED, __HIP_MEMORY_SCOPE_AGENT
#define LDS_WAIT() asm volatile("s_waitcnt lgkmcnt(0)" ::: "memory")
#define VM_WAIT() asm volatile("s_waitcnt vmcnt(0)" ::: "memory")
__device__ __forceinline__ unsigned long long rt() { return __builtin_amdgcn_s_memrealtime(); }
__device__ __forceinline__ unsigned f2bf(float f) { unsigned u = __builtin_bit_cast(unsigned, f); return (u + 0x7fffu + ((u >> 16) & 1u)) >> 16; }
__device__ __forceinline__ unsigned pk2(float lo, float hi) { return f2bf(lo) | (f2bf(hi) << 16); }

#define XB_TMO      128
#define XB_XCNT(j)  (256  + 64 * (j))
#define XB_XSUB(j)  (1280 + 64 * (j))
#define XB_XGEN(j)  (2304 + 64 * (j))
#define XB_TOP      3328
#define XB_TOPGEN   3392
#define XCD_BAR_WORDS 3456
#define XB_SPIN_CAP (1u << 18)

__device__ __forceinline__ unsigned xb_ld(unsigned* p)              { return __hip_atomic_load(p, __ATOMIC_RELAXED, __HIP_MEMORY_SCOPE_AGENT); }
__device__ __forceinline__ unsigned xb_add(unsigned* p, unsigned v) { return __hip_atomic_fetch_add(p, v, __ATOMIC_RELAXED, __HIP_MEMORY_SCOPE_AGENT); }
__device__ __forceinline__ unsigned xb_xcc_id() { return (unsigned)__builtin_amdgcn_s_getreg((3 << 11) | 20) & 0xFu; }
#define XB_SPIN(cond, bar) do { unsigned _sp = 0; while (cond) { __builtin_amdgcn_s_sleep(1); \
    if ((++_sp & 255u) == 0u) { if (xb_ld(&(bar)[XB_TMO])) break; if (_sp > XB_SPIN_CAP) { atomicAdd(&(bar)[XB_TMO], 1u); break; } } } } while (0)

struct XcdBarrier {
    unsigned* bar; unsigned x;
    volatile LAS unsigned* st;
};

__device__ __forceinline__ XcdBarrier xcd_barrier_post(unsigned* bar, volatile LAS unsigned* st) {
    XcdBarrier b; b.bar = bar; b.x = xb_xcc_id(); b.st = st;
    if (threadIdx.x == 0) (void)xb_add(&bar[XB_XCNT(b.x)], 1u);
    return b;
}
__device__ __forceinline__ void xcd_barrier_complete(unsigned* bar, unsigned x, unsigned& nloc, unsigned& nx) {
    const unsigned G = gridDim.x * gridDim.y * gridDim.z;
    unsigned sum, cnt, mine, sp = 0u;
    for (;;) {
        sum = 0u; cnt = 0u; mine = 0u;
#pragma unroll
        for (unsigned j = 0; j < 16; ++j) { const unsigned c = xb_ld(&bar[XB_XCNT(j)]); sum += c; cnt += (c > 0u) ? 1u : 0u; mine = (j == x) ? c : mine; }
        if (sum == G) break;
        __builtin_amdgcn_s_sleep(1);
        if ((++sp & 255u) == 0u) { if (xb_ld(&bar[XB_TMO])) break; if (sp > XB_SPIN_CAP) { atomicAdd(&bar[XB_TMO], 1u); break; } }
    }
    nloc = mine > 0u ? mine : 1u; nx = cnt > 0u ? cnt : 1u;
}

__device__ __forceinline__ void xcd_barrier(const XcdBarrier& b) {
    asm volatile("s_waitcnt vmcnt(0)" ::: "memory");
    __syncthreads();
    if (threadIdx.x == 0) {
        unsigned* bar = b.bar;
        __builtin_amdgcn_s_waitcnt(0);
        unsigned nloc = b.st[0], nx = b.st[1];
        if (nloc == 0u) { xcd_barrier_complete(bar, b.x, nloc, nx); b.st[0] = nloc; b.st[1] = nx; }
        const unsigned old = xb_add(&bar[XB_XSUB(b.x)], 1u);
        const unsigned gen = old / nloc;
        if (old + 1u == (gen + 1u) * nloc) {
            __builtin_amdgcn_fence(__ATOMIC_RELEASE, "agent");
            asm volatile("s_waitcnt vmcnt(0)" ::: "memory");
            const unsigned og = xb_add(&bar[XB_TOP], 1u);
            const unsigned tg = og / nx;
            if (og + 1u == (tg + 1u) * nx) xb_add(&bar[XB_TOPGEN], 1u);
            else XB_SPIN(xb_ld(&bar[XB_TOPGEN]) == tg, bar);
            __builtin_amdgcn_fence(__ATOMIC_ACQUIRE, "agent");
            xb_add(&bar[XB_XGEN(b.x)], 1u);
            asm volatile("s_waitcnt vmcnt(0)" ::: "memory");
        } else {
            XB_SPIN(xb_ld(&bar[XB_XGEN(b.x)]) == gen, bar);
            __builtin_amdgcn_fence(__ATOMIC_ACQUIRE, "agent");
            asm volatile("s_waitcnt vmcnt(0)" ::: "memory");
        }
    }
    __syncthreads();
}

__device__ __forceinline__ float wave_sum(float v) {
#pragma unroll
    for (int o = 1; o < 64; o <<= 1) v += __shfl_xor(v, o);
    return v;
}
__device__ __forceinline__ float bf_lo(unsigned w) { return __builtin_bit_cast(float, w << 16); }
__device__ __forceinline__ float bf_hi(unsigned w) { return __builtin_bit_cast(float, w & 0xffff0000u); }
__device__ __forceinline__ void ld8(const bf16* p, float* f) {
    const v4u w = *(const GAS v4u*)p;
    f[0] = bf_lo(w.x); f[1] = bf_hi(w.x); f[2] = bf_lo(w.y); f[3] = bf_hi(w.y); f[4] = bf_lo(w.z); f[5] = bf_hi(w.z); f[6] = bf_lo(w.w); f[7] = bf_hi(w.w);
}
__device__ __forceinline__ float ex2(float x) { return __builtin_amdgcn_exp2f(x); }

struct Frame {
    LAS unsigned char* lds;
    volatile LAS unsigned* MISC;
    gu32* ctl;
    int tid, lane, wave, G, bid;
    const float* const* in;
};

enum { MAP_ID = 0, MAP_GATE, MAP_UP, MAP_CIN, MAP_CQUP, MAP_CKVUP };
__device__ __forceinline__ int map_row(int map, int n) {
    if (map == MAP_GATE) return ((n >> 7) << 8) + (n & 127);
    if (map == MAP_UP) return ((n >> 7) << 8) + 128 + (n & 127);
    if (map == MAP_CIN) { if (n < 640) return n; const int i = n - 640; return 640 + ((i & 15) << 1) + (i >> 4); }
    if (map == MAP_CQUP) { const int h = n / 96, j = n - 96 * h; if (j < 64) return 64 * h + j; const int i = j - 64; return 1024 + 32 * h + ((i & 15) << 1) + (i >> 4); }
    if (map == MAP_CKVUP) { const int h = n >> 7, j = n & 127; return j < 64 ? 64 * h + j : 1024 + 64 * h + (j - 64); }
    return n;
}
__device__ __forceinline__ void conv_item(const float* W, int K, int N, bf16* WT, int map, int nscale, float scale, const float* gain, LAS float* scr, int item, int lane) {
    const int nblk = N / 32, kb = item / nblk, nb = item - kb * nblk, k0 = 64 * kb, n0 = 32 * nb;
#pragma unroll
    for (int i = 0; i < 8; ++i) { const int kk = 8 * i + (lane >> 3); const f32x4 w = *(const GAS f32x4*)(W + (size_t)(k0 + kk) * N + n0 + 4 * (lane & 7));
        const float gk = gain ? gain[k0 + kk] : 1.0f;
        LAS float* dd = scr + kk * 33 + 4 * (lane & 7); dd[0] = w.x * gk; dd[1] = w.y * gk; dd[2] = w.z * gk; dd[3] = w.w * gk; }
    LDS_WAIT(); asm volatile("" ::: "memory");
    const int c = lane & 7;
#pragma unroll
    for (int j = 0; j < 4; ++j) { const int n = (lane >> 3) + 8 * j; const LAS float* s = scr + (8 * c) * 33 + n; const int nn = n0 + n; const float sc = nn < nscale ? scale : 1.0f;
        v4u o; o.x = pk2(s[0 * 33] * sc, s[1 * 33] * sc); o.y = pk2(s[2 * 33] * sc, s[3 * 33] * sc); o.z = pk2(s[4 * 33] * sc, s[5 * 33] * sc); o.w = pk2(s[6 * 33] * sc, s[7 * 33] * sc);
        *(GAS v4u*)(WT + (size_t)map_row(map, nn) * K + k0 + 8 * c) = o; }
    LDS_WAIT(); asm volatile("" ::: "memory");
}
__device__ __forceinline__ void conv_matrix(const float* W, int K, int N, bf16* WT, int map, int nscale, float scale, const float* gain, LAS float* scr, int gw, int NGW, int& base, int lane) {
    const int nit = (K / 64) * (N / 32);
    int first = gw - base; if (first < 0) first += NGW;
    for (int it = first; it < nit; it += NGW) conv_item(W, K, N, WT, map, nscale, scale, gain, scr, it, lane);
    base = (base + nit) % NGW;
}
__device__ __forceinline__ void conv_item_f8(const float* W, int K, int N, unsigned char* WT, int map, float scale, const float* gain, LAS float* scr, int item, int lane) {
    const int nblk = N / 32, kb = item / nblk, nb = item - kb * nblk, k0 = 64 * kb, n0 = 32 * nb;
#pragma unroll
    for (int i = 0; i < 8; ++i) { const int kk = 8 * i + (lane >> 3); const f32x4 w = *(const GAS f32x4*)(W + (size_t)(k0 + kk) * N + n0 + 4 * (lane & 7));
        const float gk = gain ? gain[k0 + kk] : 1.0f;
        LAS float* dd = scr + kk * 33 + 4 * (lane & 7); dd[0] = w.x * gk; dd[1] = w.y * gk; dd[2] = w.z * gk; dd[3] = w.w * gk; }
    LDS_WAIT(); asm volatile("" ::: "memory");
    const int c = lane & 3;
#pragma unroll
    for (int j = 0; j < 2; ++j) { const int n = (lane >> 2) + 16 * j; const LAS float* s = scr + (16 * c) * 33 + n;
        v4u o; o.x = pg8::pk4_fp8(s[0 * 33] * scale, s[1 * 33] * scale, s[2 * 33] * scale, s[3 * 33] * scale); o.y = pg8::pk4_fp8(s[4 * 33] * scale, s[5 * 33] * scale, s[6 * 33] * scale, s[7 * 33] * scale);
        o.z = pg8::pk4_fp8(s[8 * 33] * scale, s[9 * 33] * scale, s[10 * 33] * scale, s[11 * 33] * scale); o.w = pg8::pk4_fp8(s[12 * 33] * scale, s[13 * 33] * scale, s[14 * 33] * scale, s[15 * 33] * scale);
        *(GAS v4u*)(WT + (size_t)map_row(map, n0 + n) * K + k0 + 16 * c) = o; }
    LDS_WAIT(); asm volatile("" ::: "memory");
}
__device__ __forceinline__ void conv_item_f8q(const float* W, int K, int N, unsigned char* WT, int map, float scale, int nscale, float qscale, const float* gain, LAS float* scr, int item, int lane) {
    const int nblk = N / 32, kb = item / nblk, nb = item - kb * nblk, k0 = 64 * kb, n0 = 32 * nb;
#pragma unroll
    for (int i = 0; i < 8; ++i) { const int kk = 8 * i + (lane >> 3); const f32x4 w = *(const GAS f32x4*)(W + (size_t)(k0 + kk) * N + n0 + 4 * (lane & 7));
        const float gk = (gain ? gain[k0 + kk] : 1.0f) * scale * ((n0 < nscale) ? qscale : 1.0f);
        LAS float* dd = scr + kk * 33 + 4 * (lane & 7); dd[0] = w.x * gk; dd[1] = w.y * gk; dd[2] = w.z * gk; dd[3] = w.w * gk; }
    LDS_WAIT(); asm volatile("" ::: "memory");
    const int c = lane & 3;
#pragma unroll
    for (int j = 0; j < 2; ++j) { const int n = (lane >> 2) + 16 * j; const LAS float* s = scr + (16 * c) * 33 + n;
        v4u o; o.x = pg8::pk4_fp8(s[0 * 33], s[1 * 33], s[2 * 33], s[3 * 33]); o.y = pg8::pk4_fp8(s[4 * 33], s[5 * 33], s[6 * 33], s[7 * 33]);
        o.z = pg8::pk4_fp8(s[8 * 33], s[9 * 33], s[10 * 33], s[11 * 33]); o.w = pg8::pk4_fp8(s[12 * 33], s[13 * 33], s[14 * 33], s[15 * 33]);
        *(GAS v4u*)(WT + (size_t)map_row(map, n0 + n) * K + k0 + 16 * c) = o; }
    LDS_WAIT(); asm volatile("" ::: "memory");
}
__device__ __forceinline__ void conv_matrix_f8q(const float* W, int K, int N, unsigned char* WT, int map, float scale, int nscale, float qscale, const float* gain, LAS float* scr, int gw, int NGW, int& base, int lane) {
    const int nit = (K / 64) * (N / 32);
    int first = gw - base; if (first < 0) first += NGW;
    for (int it = first; it < nit; it += NGW) conv_item_f8q(W, K, N, WT, map, scale, nscale, qscale, gain, scr, it, lane);
    base = (base + nit) % NGW;
}
__device__ __forceinline__ void conv_matrix_f8(const float* W, int K, int N, unsigned char* WT, int map, float scale, const float* gain, LAS float* scr, int gw, int NGW, int& base, int lane) {
    const int nit = (K / 64) * (N / 32);
    int first = gw - base; if (first < 0) first += NGW;
    for (int it = first; it < nit; it += NGW) conv_item_f8(W, K, N, WT, map, scale, gain, scr, it, lane);
    base = (base + nit) % NGW;
}
constexpr float F8_SA = 16.0f, F8_SW1 = 512.0f, F8_SACT = 8.0f, F8_SW2 = 1024.0f;
__device__ __forceinline__ void conv_moe(const float* Wg, const float* Wu, const float* Wd, const float* gain, unsigned char* wgu, unsigned char* wd, LAS float* scr, int gw, int NGW, int lane, int e_lo = 0, int e_hi = NEXP) {
    int base = 0;
    for (int e = e_lo; e < e_hi; ++e) {
        unsigned char* gu = wgu + (size_t)e * 2 * FFE * DM;
        conv_matrix_f8(Wg + (size_t)e * DM * FFE, DM, FFE, gu, MAP_GATE, F8_SW1, gain, scr, gw, NGW, base, lane);
        conv_matrix_f8(Wu + (size_t)e * DM * FFE, DM, FFE, gu, MAP_UP, F8_SW1, gain, scr, gw, NGW, base, lane);
        conv_matrix_f8(Wd + (size_t)e * FFE * DM, FFE, DM, wd + (size_t)e * DM * FFE, MAP_ID, F8_SW2, nullptr, scr, gw, NGW, base, lane);
    }
}

__device__ __forceinline__ void rowb_load(const bf16* xrow, int lane, float (&v)[16]) { ld8(xrow + 8 * lane, v); ld8(xrow + 512 + 8 * lane, v + 8); }
__device__ __forceinline__ void rowb_add(const bf16* yrow, int lane, float (&v)[16]) { float t[16]; ld8(yrow + 8 * lane, t); ld8(yrow + 512 + 8 * lane, t + 8);
#pragma unroll
    for (int i = 0; i < 16; ++i) v[i] += t[i]; }
__device__ __forceinline__ float rowb_store_ss(bf16* xrow, int lane, const float (&v)[16]) {
    unsigned w[8]; float s = 0.f;
#pragma unroll
    for (int i = 0; i < 8; ++i) { w[i] = pk2(v[2 * i], v[2 * i + 1]); const float a = bf_lo(w[i]), b = bf_hi(w[i]); s += a * a + b * b; }
    v4u o0 = {w[0], w[1], w[2], w[3]}, o1 = {w[4], w[5], w[6], w[7]};
    *(GAS v4u*)(xrow + 8 * lane) = o0; *(GAS v4u*)(xrow + 512 + 8 * lane) = o1;
    return wave_sum(s);
}
__device__ __forceinline__ float ss_total(const float* ss, int row) { const f32x4 a = *(const GAS f32x4*)(ss + (size_t)row * pg8::SSW); return (a[0] + a[1]) + (a[2] + a[3]); }
__device__ __forceinline__ void ss_store(float* ss, int row, float s, int lane) { if (lane == 0) *(GAS f32x4*)(ss + (size_t)row * pg8::SSW) = (f32x4){s, 0.f, 0.f, 0.f}; }
template <int MODE>
__device__ __forceinline__ void row_phase(Frame& F, const float* xin, bf16* XR, float* ss, const float* g, float* out, const bf16* Y, const int* toks,
                                          const float* gWr, int* toke, float* tokg, int* wgcnt) {
    const int RPW = (NTOK + F.G - 1) / F.G; const int r0 = F.bid * RPW, r1 = (r0 + RPW < NTOK) ? r0 + RPW : NTOK;
    LAS int* cnt = (LAS int*)(F.lds + RING_OFF);
    if (MODE == 1) { if (F.tid < 8) cnt[F.tid] = 0; __syncthreads(); }
    f32x4 wr[16][2];
    if (MODE == 1) {
#pragma unroll
        for (int i = 0; i < 16; ++i) { const int k = (i < 8) ? 8 * F.lane + i : 512 + 8 * F.lane + (i - 8); wr[i][0] = *(const GAS f32x4*)(gWr + (size_t)k * 8); wr[i][1] = *(const GAS f32x4*)(gWr + (size_t)k * 8 + 4); } }
    if (MODE == 0) {
        for (int rA = r0 + F.wave; rA < r1; rA += 2 * NWAVES) {
            const bool hasB = rA + NWAVES < r1; const int rB = hasB ? rA + NWAVES : rA;
            const GAS f32x4* xa = (const GAS f32x4*)(xin + (size_t)rA * DM); const GAS f32x4* xb = (const GAS f32x4*)(xin + (size_t)rB * DM);
            const f32x4 a0 = xa[2 * F.lane], a1 = xa[2 * F.lane + 1], a2 = xa[128 + 2 * F.lane], a3 = xa[128 + 2 * F.lane + 1];
            const f32x4 c0 = xb[2 * F.lane], c1 = xb[2 * F.lane + 1], c2 = xb[128 + 2 * F.lane], c3 = xb[128 + 2 * F.lane + 1];
            { float v[16] = {a0.x, a0.y, a0.z, a0.w, a1.x, a1.y, a1.z, a1.w, a2.x, a2.y, a2.z, a2.w, a3.x, a3.y, a3.z, a3.w};
              const float s = rowb_store_ss(XR + (size_t)rA * DM, F.lane, v); ss_store(ss, rA, s, F.lane); }
            if (hasB) { float v[16] = {c0.x, c0.y, c0.z, c0.w, c1.x, c1.y, c1.z, c1.w, c2.x, c2.y, c2.z, c2.w, c3.x, c3.y, c3.z, c3.w};
              const float s = rowb_store_ss(XR + (size_t)rB * DM, F.lane, v); ss_store(ss, rB, s, F.lane); } }
    } else {
        for (int rA = r0 + F.wave; rA < r1; rA += 2 * NWAVES) {
            const bool hasB = rA + NWAVES < r1; const int rB = hasB ? rA + NWAVES : rA;
            float vA[16], vB[16]; int sA0 = 0, sA1 = 0, sB0 = 0, sB1 = 0; float tA = 0.f, tB = 0.f;
            if (MODE == 2 || MODE == 3) { sA0 = toks[2 * rA]; sA1 = toks[2 * rA + 1]; sB0 = toks[2 * rB]; sB1 = toks[2 * rB + 1]; }
            rowb_load(XR + (size_t)rA * DM, F.lane, vA); rowb_load(XR + (size_t)rB * DM, F.lane, vB);
            if (MODE == 1) { tA = ss_total(ss, rA); tB = ss_total(ss, rB); }
            if (MODE == 2 || MODE == 3) { float yA0[16], yA1[16], yB0[16], yB1[16];
                rowb_load(Y + (size_t)sA0 * DM, F.lane, yA0); rowb_load(Y + (size_t)sA1 * DM, F.lane, yA1); rowb_load(Y + (size_t)sB0 * DM, F.lane, yB0); rowb_load(Y + (size_t)sB1 * DM, F.lane, yB1);
#pragma unroll
                for (int i = 0; i < 16; ++i) { vA[i] = (vA[i] + yA0[i]) + yA1[i]; vB[i] = (vB[i] + yB0[i]) + yB1[i]; } }
#pragma unroll
            for (int half = 0; half < 2; ++half) {
                if (half == 1 && !hasB) break;
                const int r = half ? rB : rA; float (&v)[16] = half ? vB : vA;
                if (MODE == 2) { const float s = rowb_store_ss(XR + (size_t)r * DM, F.lane, v); ss_store(ss, r, s, F.lane); }
                if (MODE == 3) { float s = 0.f;
#pragma unroll
                    for (int i = 0; i < 16; ++i) s += v[i] * v[i];
                    const float rstd = 1.0f / sqrtf(wave_sum(s) * (1.0f / DM) + NORM_EPS);
                    const GAS f32x4* gr = (const GAS f32x4*)g; const f32x4 g0 = gr[2 * F.lane], g1 = gr[2 * F.lane + 1], g2 = gr[128 + 2 * F.lane], g3 = gr[128 + 2 * F.lane + 1];
                    GAS f32x4* orow = (GAS f32x4*)(out + (size_t)r * DM);
                    orow[2 * F.lane] = (f32x4){v[0], v[1], v[2], v[3]} * rstd * g0; orow[2 * F.lane + 1] = (f32x4){v[4], v[5], v[6], v[7]} * rstd * g1;
                    orow[128 + 2 * F.lane] = (f32x4){v[8], v[9], v[10], v[11]} * rstd * g2; orow[128 + 2 * F.lane + 1] = (f32x4){v[12], v[13], v[14], v[15]} * rstd * g3; }
                if (MODE == 1) {
                    const float rstd = 1.0f / sqrtf((half ? tB : tA) * (1.0f / DM) + NORM_EPS);
                    float lg[8];
#pragma unroll
                    for (int e = 0; e < 8; ++e) lg[e] = 0.f;
#pragma unroll
                    for (int i = 0; i < 16; ++i) { const f32x4 w0 = wr[i][0], w1 = wr[i][1]; const float hv = v[i];
                        lg[0] += hv * w0.x; lg[1] += hv * w0.y; lg[2] += hv * w0.z; lg[3] += hv * w0.w; lg[4] += hv * w1.x; lg[5] += hv * w1.y; lg[6] += hv * w1.z; lg[7] += hv * w1.w; }
                    {
                        const bool b5 = (F.lane & 32) != 0, b4 = (F.lane & 16) != 0, b3 = (F.lane & 8) != 0;
                        float a4[4], a2[2];
#pragma unroll
                        for (int i = 0; i < 4; ++i) { const float keep = b5 ? lg[4 + i] : lg[i], send = b5 ? lg[i] : lg[4 + i]; a4[i] = keep + __shfl_xor(send, 32); }
#pragma unroll
                        for (int i = 0; i < 2; ++i) { const float keep = b4 ? a4[2 + i] : a4[i], send = b4 ? a4[i] : a4[2 + i]; a2[i] = keep + __shfl_xor(send, 16); }
                        float c = (b3 ? a2[1] : a2[0]) + __shfl_xor(b3 ? a2[0] : a2[1], 8);
                        c += __shfl_xor(c, 4); c += __shfl_xor(c, 2); c += __shfl_xor(c, 1);
                        c *= rstd;
#pragma unroll
                        for (int e = 0; e < 8; ++e) lg[e] = __builtin_bit_cast(float, __builtin_amdgcn_readlane(__builtin_bit_cast(int, c), 8 * e));
                    }
                    int e0 = 0; float l0 = lg[0];
#pragma unroll
                    for (int e = 1; e < 8; ++e) if (lg[e] > l0) { l0 = lg[e]; e0 = e; }
                    int e1 = -1; float l1 = -INFINITY;
#pragma unroll
                    for (int e = 0; e < 8; ++e) if (e != e0 && lg[e] > l1) { l1 = lg[e]; e1 = e; }
                    const float g0 = 1.0f / (1.0f + __expf(l1 - l0)), g1 = 1.0f - g0;
                    if (F.lane == 0) { toke[2 * r] = e0; toke[2 * r + 1] = e1; tokg[2 * r] = g0; tokg[2 * r + 1] = g1; __hip_atomic_fetch_add(&cnt[e0], 1, __ATOMIC_RELAXED, __HIP_MEMORY_SCOPE_WORKGROUP); __hip_atomic_fetch_add(&cnt[e1], 1, __ATOMIC_RELAXED, __HIP_MEMORY_SCOPE_WORKGROUP); }
                }
            }
        }
    }
    if (MODE == 1) { __syncthreads(); if (F.tid < 8) wgcnt[F.bid * 8 + F.tid] = cnt[F.tid]; __syncthreads(); }
}

__device__ __forceinline__ void slot_phase(Frame& F, LAS int* tot, const int* toke, const float* tokg, int* toks, float* sgate, float* sss, const float* ss, const bf16* XR, unsigned char* XB) {
    const int RPW = (NTOK + F.G - 1) / F.G; const int r0 = F.bid * RPW, r1 = (r0 + RPW < NTOK) ? r0 + RPW : NTOK;
    LAS int* slotof = tot + 64;
    const int np = 2 * (r1 - r0);
    for (int p = F.tid; p < np; p += NWAVES * 64) { const int idx = 2 * r0 + p; const int e = toke[idx]; const int slot = __hip_atomic_fetch_add(&tot[16 + e], 1, __ATOMIC_RELAXED, __HIP_MEMORY_SCOPE_WORKGROUP);
        toks[idx] = slot; sgate[slot] = tokg[idx]; slotof[p] = slot; }
    __syncthreads();
    for (int p = F.wave; p < np; p += NWAVES) { const int tok = r0 + (p >> 1); const int slot = slotof[p];
        float v[16]; rowb_load(XR + (size_t)tok * DM, F.lane, v);
        if (F.lane == 0) sss[slot] = __builtin_amdgcn_rsqf(ss_total(ss, tok) * (1.0f / DM) + NORM_EPS);
        GAS unsigned long long* d = (GAS unsigned long long*)(XB + (size_t)slot * DM);
        d[F.lane] = (unsigned long long)pg8::pk4_fp8(v[0] * F8_SA, v[1] * F8_SA, v[2] * F8_SA, v[3] * F8_SA) | ((unsigned long long)pg8::pk4_fp8(v[4] * F8_SA, v[5] * F8_SA, v[6] * F8_SA, v[7] * F8_SA) << 32);
        d[64 + F.lane] = (unsigned long long)pg8::pk4_fp8(v[8] * F8_SA, v[9] * F8_SA, v[10] * F8_SA, v[11] * F8_SA) | ((unsigned long long)pg8::pk4_fp8(v[12] * F8_SA, v[13] * F8_SA, v[14] * F8_SA, v[15] * F8_SA) << 32); }
    __syncthreads();
}

__device__ __forceinline__ void kpe_phase(Frame& F, const bf16* LAT, const float* tab, bf16* KPE) {
    for (int i = F.bid * NWAVES * 64 + F.tid; i < NTOK * 16; i += F.G * NWAVES * 64) { const int r = i >> 4, p = i & 15;
        const unsigned w = *(const GAS unsigned*)(LAT + (size_t)r * 768 + 640 + 2 * p); const float x1 = bf_lo(w), x2 = bf_hi(w);
        const float c = tab[(size_t)(r % SEQ) * 32 + 2 * p], sn = tab[(size_t)(r % SEQ) * 32 + 2 * p + 1];
        *(GAS unsigned*)(KPE + (size_t)r * 32 + 2 * p) = pk2(x1 * c - x2 * sn, x1 * sn + x2 * c); }
}
__device__ __forceinline__ void latpost_phase(Frame& F, const bf16* LAT, const float* qg, const float* kvg, const float* tab, bf16* QN, bf16* KVN, bf16* KPE) {
    const int gw = F.bid * NWAVES + F.wave, NGW = F.G * NWAVES;
    for (int r = gw; r < NTOK; r += NGW) {
        const bf16* row = LAT + (size_t)r * 768;
        float q[6]; float s = 0.f;
#pragma unroll
        for (int i = 0; i < 6; ++i) { q[i] = bf_lo((unsigned)row[F.lane + 64 * i]); s += q[i] * q[i]; }
        const float rq = 1.0f / sqrtf(wave_sum(s) * (1.0f / 384.0f) + NORM_EPS);
#pragma unroll
        for (int i = 0; i < 6; ++i) QN[(size_t)r * 384 + F.lane + 64 * i] = (bf16)f2bf(q[i] * rq * qg[F.lane + 64 * i]);
        float k[4]; s = 0.f;
#pragma unroll
        for (int i = 0; i < 4; ++i) { k[i] = bf_lo((unsigned)row[384 + F.lane + 64 * i]); s += k[i] * k[i]; }
        const float rk = 1.0f / sqrtf(wave_sum(s) * (1.0f / 256.0f) + NORM_EPS);
#pragma unroll
        for (int i = 0; i < 4; ++i) KVN[(size_t)r * 256 + F.lane + 64 * i] = (bf16)f2bf(k[i] * rk * kvg[F.lane + 64 * i]);
        if (F.lane < 16) { const float x1 = bf_lo((unsigned)row[640 + 2 * F.lane]), x2 = bf_lo((unsigned)row[640 + 2 * F.lane + 1]);
            const float c = tab[(size_t)(r % SEQ) * 32 + 2 * F.lane], sn = tab[(size_t)(r % SEQ) * 32 + 2 * F.lane + 1];
            *(GAS unsigned*)(KPE + (size_t)r * 32 + 2 * F.lane) = pk2(x1 * c - x2 * sn, x1 * sn + x2 * c); }
    }
}

namespace fa {
typedef float f32x16 __attribute__((ext_vector_type(16)));
typedef short s16x4 __attribute__((ext_vector_type(4)));
typedef short v4i16_t __attribute__((ext_vector_type(4)));
typedef float f32x2_t __attribute__((ext_vector_type(2)));
typedef __bf16 bf16x2_t __attribute__((ext_vector_type(2)));
__device__ __forceinline__ unsigned cvtpk(float lo, float hi) { f32x2_t v = {lo, hi}; bf16x2_t b = __builtin_convertvector(v, bf16x2_t); return __builtin_bit_cast(unsigned, b); }
__device__ __forceinline__ float fsub1(float a, float b) { float r; asm("v_sub_f32_e32 %0, %1, %2" : "=v"(r) : "v"(a), "v"(b)); return r; }
__device__ __forceinline__ float fadd1(float a, float b) { float r; asm("v_add_f32_e32 %0, %1, %2" : "=v"(r) : "v"(a), "v"(b)); return r; }
__device__ __forceinline__ bf16x8 pack8(const f32x16& x, int s) {
    v4u p; p.x = cvtpk(x[8 * s], x[8 * s + 1]); p.y = cvtpk(x[8 * s + 2], x[8 * s + 3]); p.z = cvtpk(x[8 * s + 4], x[8 * s + 5]); p.w = cvtpk(x[8 * s + 6], x[8 * s + 7]);
    return __builtin_bit_cast(bf16x8, p);
}
__device__ __forceinline__ s16x4 vtr(const LAS unsigned char* p) { return __builtin_bit_cast(s16x4, __builtin_amdgcn_ds_read_tr16_b64_v4i16((LAS v4i16_t*)p)); }
#define FA_MFMA(a, b, c) __builtin_amdgcn_mfma_f32_32x32x16_bf16((a), (b), (c), 0, 0, 0)
#define FA_CI(i) (((i) & 3) + 8 * ((i) >> 2))

struct Desc {
    const bf16* q0; const bf16* q1; int qstride;
    const bf16* k0; int kstride; const bf16* k1; int k1stride;
    const bf16* v; int vstride;
    int qpos0;
    int t_lo, t_hi;
    int W;
    float sl2;
    const LAS float* pm; LAS unsigned* ecnt;
    const float* ropetab;
};
template <int DQK0, int DQK1, int DV> struct Geo {
    static constexpr int DQK = DQK0 + DQK1, RSK = DQK * 2 + 16, RSV = DV * 2 + 64, KBYTES = 64 * RSK, VBYTES = 64 * RSV, BUF = KBYTES + VBYTES;
    static constexpr int C0 = DQK0 / 8, C1 = DQK1 / 8, CV = DV / 8, NV = DV / 64;
};
#define FA_OFFSETS() unsigned koff, k1off = 0u, voff[G::NV], klds, k1lds = 0u, vlds[G::NV]; \
        { const int row_ = tid / G::C0, ch_ = tid % G::C0; koff = (unsigned)(row_ * d.kstride + ch_ * 8) * 2u; klds = (unsigned)(row_ * G::RSK + ch_ * 16); } \
        if (G::C1 > 0) { const int row_ = tid / (G::C1 > 0 ? G::C1 : 1), ch_ = tid % (G::C1 > 0 ? G::C1 : 1); k1off = (unsigned)(row_ * d.k1stride + ch_ * 8) * 2u; k1lds = (unsigned)(row_ * G::RSK + DQK0 * 2 + ch_ * 16); } \
        _Pragma("unroll") for (int i_ = 0; i_ < G::NV; ++i_) { const int c_ = tid + 512 * i_, row_ = c_ / G::CV, ch_ = c_ % G::CV; voff[i_] = (unsigned)(row_ * d.vstride + ch_ * 8) * 2u; vlds[i_] = (unsigned)(G::KBYTES + row_ * G::RSV + ch_ * 16); }
#define FA_RSRC() const __amdgpu_buffer_rsrc_t rk0 = __builtin_amdgcn_make_buffer_rsrc((void*)d.k0, 0, 0x7fffffff, 0x00020000), rv = __builtin_amdgcn_make_buffer_rsrc((void*)d.v, 0, 0x7fffffff, 0x00020000), \
        rk1 = __builtin_amdgcn_make_buffer_rsrc((void*)(G::C1 > 0 ? d.k1 : d.k0), 0, 0x7fffffff, 0x00020000)
#define FA_GLOAD(t_) do { const int key0_ = (t_) * 64;     \
        sk0 = __builtin_bit_cast(v4u, __builtin_amdgcn_raw_buffer_load_b128(rk0, (int)koff, key0_ * d.kstride * 2, 0)); \
        if (G::C1 > 0) { if (tid < 64 * G::C1) sk1 = __builtin_bit_cast(v4u, __builtin_amdgcn_raw_buffer_load_b128(rk1, (int)k1off, key0_ * d.k1stride * 2, 0)); } \
        _Pragma("unroll") for (int i_ = 0; i_ < G::NV; ++i_) sv[i_] = __builtin_bit_cast(v4u, __builtin_amdgcn_raw_buffer_load_b128(rv, (int)voff[i_], key0_ * d.vstride * 2, 0)); } while (0)
#define FA_LSTORE(buf_) do { LAS unsigned char* kb_ = lds + (buf_) * G::BUF; \
        *(LAS v4u*)(kb_ + klds) = sk0; \
        if (G::C1 > 0) { if (tid < 64 * G::C1) *(LAS v4u*)(kb_ + k1lds) = sk1; } \
        _Pragma("unroll") for (int i_ = 0; i_ < G::NV; ++i_) *(LAS v4u*)(kb_ + vlds[i_]) = sv[i_]; } while (0)
#define FA_QK1(kbuf_, kb_, P_) do { const LAS unsigned char* kp_ = (kbuf_) + (32 * (kb_) + r) * G::RSK + h * 16; \
        _Pragma("unroll") for (int s_ = 0; s_ < G::DQK / 16; ++s_) { bf16x8 qv_; if (QLDS) qv_ = *(const LAS bf16x8*)(qs + s_ * 1024); else qv_ = qf[s_]; \
            const bf16x8 kf_ = *(const LAS bf16x8*)(kp_ + s_ * 32); P_ = FA_MFMA(kf_, qv_, s_ == 0 ? zero : P_); } } while (0)
#define FA_PV(vbuf_) do { const LAS unsigned char* vp_ = (vbuf_) + (4 * h + ((lane & 15) >> 2)) * G::RSV + ((lane >> 4) & 1) * 32 + (lane & 3) * 8; \
        _Pragma("unroll") for (int ks_ = 0; ks_ < 4; ++ks_) _Pragma("unroll") for (int c_ = 0; c_ < DV / 32; ++c_) { \
            const s16x4 lo_ = vtr(vp_ + (16 * ks_) * G::RSV + c_ * 64), hi_ = vtr(vp_ + (16 * ks_ + 8) * G::RSV + c_ * 64); \
            const bf16x8 vf_ = {lo_[0], lo_[1], lo_[2], lo_[3], hi_[0], hi_[1], hi_[2], hi_[3]}; o[c_] = FA_MFMA(vf_, pf[ks_], o[c_]); } } while (0)

template <int DQK0, int DQK1, int DV, bool BIAS, bool QLDS, bool EXIT = false>
__device__ __forceinline__ void flash_unit(LAS unsigned char* lds, const Desc& d, int tid, f32x16 (&o)[DV / 32], float& m_out, float& l_out) {
    typedef Geo<DQK0, DQK1, DV> G;
    const int lane = tid & 63, wave = __builtin_amdgcn_readfirstlane(tid >> 6), r = lane & 31, h = lane >> 5;
    bf16x8 qf[G::DQK / 16];
    LAS unsigned char* qs = lds + 2 * G::BUF + wave * (G::DQK / 16) * 1024 + lane * 16;
    { const unsigned qoff = (unsigned)((wave * 32 + r) * d.qstride);
#pragma unroll
      for (int s = 0; s < DQK0 / 16; ++s) qf[s] = *(const GAS bf16x8*)(d.q0 + qoff + s * 16 + h * 8);
#pragma unroll
      for (int s = 0; s < DQK1 / 16; ++s) qf[DQK0 / 16 + s] = *(const GAS bf16x8*)(d.q1 + qoff + s * 16 + h * 8);
      if (DQK1 > 0) { if (d.ropetab) {
#pragma unroll
          for (int s = 0; s < DQK1 / 16; ++s) { const float* t = d.ropetab + (size_t)(d.qpos0 + wave * 32 + r) * 32 + 16 * s + 8 * h; const f32x4 c0 = *(const GAS f32x4*)t, c1 = *(const GAS f32x4*)(t + 4);
              const v4u w = __builtin_bit_cast(v4u, qf[DQK0 / 16 + s]); v4u o_; float a, b;
              a = bf_lo(w.x); b = bf_hi(w.x); o_.x = pk2(a * c0[0] - b * c0[1], a * c0[1] + b * c0[0]);
              a = bf_lo(w.y); b = bf_hi(w.y); o_.y = pk2(a * c0[2] - b * c0[3], a * c0[3] + b * c0[2]);
              a = bf_lo(w.z); b = bf_hi(w.z); o_.z = pk2(a * c1[0] - b * c1[1], a * c1[1] + b * c1[0]);
              a = bf_lo(w.w); b = bf_hi(w.w); o_.w = pk2(a * c1[2] - b * c1[3], a * c1[3] + b * c1[2]);
              qf[DQK0 / 16 + s] = __builtin_bit_cast(bf16x8, o_); } } }
      if (QLDS) {
#pragma unroll
          for (int s = 0; s < G::DQK / 16; ++s) *(LAS bf16x8*)(qs + s * 1024) = qf[s]; } }
    float qn = 0.f;
    if (EXIT) {
#pragma unroll
        for (int s = 0; s < G::DQK / 16; ++s)
#pragma unroll
            for (int j = 0; j < 8; ++j) { const float f = bf_lo((unsigned)(unsigned short)qf[s][j]); qn += f * f; }
        qn += __shfl_xor(qn, 32); qn = sqrtf(qn) * 1.01f;
    }
    f32x16 zero;
#pragma unroll
    for (int i = 0; i < 16; ++i) zero[i] = 0.f;
#pragma unroll
    for (int c = 0; c < DV / 32; ++c)
#pragma unroll
        for (int i = 0; i < 16; ++i) o[c][i] = 0.f;
    float m = -1e30f, l = 0.f;
    const int qmin = d.qpos0 + wave * 32, qpos = qmin + r;
    if (__builtin_amdgcn_readfirstlane(tid) >= 256) __builtin_amdgcn_s_setprio(1);
    v4u sk0, sk1, sv[G::NV];
    FA_OFFSETS();
    FA_RSRC();
    FA_GLOAD(d.t_hi); FA_LSTORE(0); __syncthreads();
    int buf = 0; unsigned prev0 = 0u, prev1 = 0u; bool done_w = false;
    for (int t = d.t_hi; t >= d.t_lo; --t) {
        if (QLDS) { int tl = tid; asm volatile("" : "+v"(tl));
            { const int row_ = tl / G::C0, ch_ = tl % G::C0; koff = (unsigned)(row_ * d.kstride + ch_ * 8) * 2u; klds = (unsigned)(row_ * G::RSK + ch_ * 16); }
#pragma unroll
            for (int i_ = 0; i_ < G::NV; ++i_) { const int c_ = tl + 512 * i_, row_ = c_ / G::CV, ch_ = c_ % G::CV; voff[i_] = (unsigned)(row_ * d.vstride + ch_ * 8) * 2u; vlds[i_] = (unsigned)(G::KBYTES + row_ * G::RSV + ch_ * 16); } }
        if (t > d.t_lo) FA_GLOAD(t - 1);
        const int k0 = t * 64;
        const bool act = (k0 <= qmin + 31 && k0 + 63 >= qmin - d.W) && !done_w;
        const LAS unsigned char* kbuf = lds + buf * G::BUF; const LAS unsigned char* vbuf = kbuf + G::KBYTES;
        bf16x8 pf[4];
        if (act) {
            f32x16 p[2];
            FA_QK1(kbuf, 0, p[0]); FA_QK1(kbuf, 1, p[1]);
            if (BIAS) {
#pragma unroll
                for (int i = 0; i < 16; ++i) { p[0][i] = __builtin_fmaf(d.sl2, (float)FA_CI(i), p[0][i]); p[1][i] = __builtin_fmaf(d.sl2, (float)FA_CI(i), p[1][i]); } }
            const int dq0 = qpos - k0 - 4 * h;
            const float off0 = BIAS ? d.sl2 * (float)dq0 : 0.f, off1 = BIAS ? d.sl2 * (float)(dq0 - 32) : 0.f;
            if (k0 + 63 > qmin || k0 < qmin + 31 - d.W) {
#pragma unroll
                for (int kb = 0; kb < 2; ++kb) { const int dq = dq0 - 32 * kb;
#pragma unroll
                    for (int i = 0; i < 16; ++i) { const bool ok = (FA_CI(i) <= dq) && (FA_CI(i) >= dq - d.W); p[kb][i] = ok ? p[kb][i] : -INFINITY; } }
            }
            float mx0 = p[0][0], mx1 = p[1][0];
#pragma unroll
            for (int i = 1; i < 16; ++i) { mx0 = fmaxf(mx0, p[0][i]); mx1 = fmaxf(mx1, p[1][i]); }
            float tm = fmaxf(mx0 - off0, mx1 - off1);
            tm = fmaxf(tm, __shfl_xor(tm, 32));
            if (__any(tm > m + 8.0f)) {
                const float mn = fmaxf(m, tm), al = ex2(m - mn); m = mn; l *= al;
#pragma unroll
                for (int c = 0; c < DV / 32; ++c)
#pragma unroll
                    for (int i = 0; i < 16; ++i) o[c][i] *= al;
            }
            const float mk0 = m + off0, mk1 = m + off1; float ps = 0.f;
#pragma unroll
            for (int i = 0; i < 16; ++i) { p[0][i] = ex2(p[0][i] - mk0); p[1][i] = ex2(p[1][i] - mk1); ps += p[0][i] + p[1][i]; }
            l += ps;
            pf[0] = pack8(p[0], 0); pf[1] = pack8(p[0], 1); pf[2] = pack8(p[1], 0); pf[3] = pack8(p[1], 1);
        }
        if (EXIT) {
            if (!done_w && t > d.t_lo) { const float bound = qn * d.pm[t - 1] + d.sl2 * (float)(k0 - 1 - qpos); done_w = __all(bound - m < -40.0f); }
            if (!done_w && lane == 0) __hip_atomic_fetch_add(&d.ecnt[t & 1], 1u, __ATOMIC_RELAXED, __HIP_MEMORY_SCOPE_WORKGROUP);
        }
        if (t > d.t_lo) FA_LSTORE(buf ^ 1);
        if (act) { FA_PV(vbuf); }
        __syncthreads();
        buf ^= 1;
        if (EXIT) { const unsigned c = d.ecnt[t & 1]; if (t & 1) { if (c == prev1) break; prev1 = c; } else { if (c == prev0) break; prev0 = c; } }
    }
    if (EXIT) __syncthreads();
    __builtin_amdgcn_s_setprio(0);
    m_out = m; l_out = l;
}
__device__ __forceinline__ void sb_unit(LAS unsigned char* lds, const Desc& d, int tid, f32x16 (&o)[2], LAS unsigned* ecnt) {
    typedef Geo<64, 0, 64> G; constexpr int DQK0 = 64, DV = 64; constexpr bool QLDS = false; LAS unsigned char* qs = nullptr;
    const int lane = tid & 63, wave = __builtin_amdgcn_readfirstlane(tid >> 6), r = lane & 31, h = lane >> 5;
    bf16x8 qf[4];
    { const unsigned qoff = (unsigned)((wave * 32 + r) * d.qstride);
#pragma unroll
      for (int s = 0; s < 4; ++s) qf[s] = *(const GAS bf16x8*)(d.q0 + qoff + s * 16 + h * 8); }
    f32x16 zero;
#pragma unroll
    for (int i = 0; i < 16; ++i) { zero[i] = 0.f; o[0][i] = 0.f; o[1][i] = 0.f; }
    float carry = 1.0f;
    const int qmin = d.qpos0 + wave * 32, qpos = qmin + r;
    v4u sk0, sk1, sv[G::NV];
    FA_OFFSETS();
    FA_RSRC();
    if (tid < 2) ecnt[tid] = 0u;
    FA_GLOAD(d.t_hi); FA_LSTORE(0); __syncthreads();
    int buf = 0; unsigned prev0 = 0u, prev1 = 0u; bool done_w = false;
    for (int t = d.t_hi; t >= d.t_lo; --t) {
        if (t > d.t_lo) FA_GLOAD(t - 1);
        const int k0 = t * 64;
        if (k0 < qmin + 31 && !done_w) {
            const LAS unsigned char* kbuf = lds + buf * G::BUF; const LAS unsigned char* vbuf = kbuf + G::KBYTES;
            f32x16 p[2];
            FA_QK1(kbuf, 0, p[0]); FA_QK1(kbuf, 1, p[1]);
            const int dq0 = qpos - k0 - 4 * h;
            if (k0 + 63 >= qmin) {
#pragma unroll
                for (int kb = 0; kb < 2; ++kb) { const int dq = dq0 - 32 * kb;
#pragma unroll
                    for (int i = 0; i < 16; ++i) p[kb][i] = (FA_CI(i) < dq) ? p[kb][i] : -INFINITY; }
            }
#pragma unroll
            for (int kk = 0; kk < 2; ++kk) { const int kb = 1 - kk;
                float T[4];
#pragma unroll
                for (int g = 0; g < 4; ++g) {
                    float kp[4], bt[4];
#pragma unroll
                    for (int j = 0; j < 4; ++j) { const float ez = ex2(p[kb][4 * g + j]); kp[j] = __builtin_amdgcn_rcpf(1.0f + ez); bt[j] = ez * kp[j]; }
                    const float e2 = kp[3], e1 = e2 * kp[2], e0 = e1 * kp[1]; T[g] = e0 * kp[0];
                    p[kb][4 * g + 3] = bt[3]; p[kb][4 * g + 2] = bt[2] * e2; p[kb][4 * g + 1] = bt[1] * e1; p[kb][4 * g] = bt[0] * e0;
                }
                float PT[4];
#pragma unroll
                for (int g = 0; g < 4; ++g) PT[g] = __shfl_xor(T[g], 32);
                const float S3 = carry * (h ? 1.0f : PT[3]);
                const float S2 = S3 * T[3] * (h ? PT[3] : PT[2]);
                const float S1 = S2 * T[2] * (h ? PT[2] : PT[1]);
                const float S0 = S1 * T[1] * (h ? PT[1] : PT[0]);
                carry = S0 * T[0] * (h ? PT[0] : 1.0f);
#pragma unroll
                for (int j = 0; j < 4; ++j) { p[kb][12 + j] *= S3; p[kb][8 + j] *= S2; p[kb][4 + j] *= S1; p[kb][j] *= S0; }
            }
            bf16x8 pf[4]; pf[0] = pack8(p[0], 0); pf[1] = pack8(p[0], 1); pf[2] = pack8(p[1], 0); pf[3] = pack8(p[1], 1);
            FA_PV(vbuf);
            done_w = __all(carry <= 1e-30f);
        }
        if (!done_w && lane == 0) __hip_atomic_fetch_add(&ecnt[t & 1], 1u, __ATOMIC_RELAXED, __HIP_MEMORY_SCOPE_WORKGROUP);
        if (t > d.t_lo) FA_LSTORE(buf ^ 1);
        __syncthreads();
        buf ^= 1;
        const unsigned c = ecnt[t & 1];
        if (t & 1) { if (c == prev1) break; prev1 = c; } else { if (c == prev0) break; prev0 = c; }
    }
    __syncthreads();
}
#define SB_HEAD(QF_, CARRY_, OO_, KBUF_) do { const bf16x8 (&qf)[4] = QF_; f32x16 (&o)[2] = OO_; const LAS unsigned char* kbuf = (KBUF_); const LAS unsigned char* vbuf = kbuf + G::KBYTES; \
        f32x16 p[2]; FA_QK1(kbuf, 0, p[0]); FA_QK1(kbuf, 1, p[1]); \
        if (k0 + 63 >= qmin) { _Pragma("unroll") for (int kb = 0; kb < 2; ++kb) { const int dq = dq0 - 32 * kb; _Pragma("unroll") for (int i = 0; i < 16; ++i) p[kb][i] = (FA_CI(i) < dq) ? p[kb][i] : -INFINITY; } } \
        _Pragma("unroll") for (int kk = 0; kk < 2; ++kk) { const int kb = 1 - kk; float T[4]; \
            _Pragma("unroll") for (int g = 0; g < 4; ++g) { float kp[4], bt[4]; \
                _Pragma("unroll") for (int j = 0; j < 4; ++j) { const float ez = ex2(p[kb][4 * g + j]); kp[j] = __builtin_amdgcn_rcpf(1.0f + ez); bt[j] = ez * kp[j]; } \
                const float e2 = kp[3], e1 = e2 * kp[2], e0 = e1 * kp[1]; T[g] = e0 * kp[0]; \
                p[kb][4 * g + 3] = bt[3]; p[kb][4 * g + 2] = bt[2] * e2; p[kb][4 * g + 1] = bt[1] * e1; p[kb][4 * g] = bt[0] * e0; } \
            float PT[4]; _Pragma("unroll") for (int g = 0; g < 4; ++g) PT[g] = __shfl_xor(T[g], 32); \
            const float S3 = CARRY_ * (h ? 1.0f : PT[3]); const float S2 = S3 * T[3] * (h ? PT[3] : PT[2]); const float S1 = S2 * T[2] * (h ? PT[2] : PT[1]); const float S0 = S1 * T[1] * (h ? PT[1] : PT[0]); \
            CARRY_ = S0 * T[0] * (h ? PT[0] : 1.0f); \
            _Pragma("unroll") for (int j = 0; j < 4; ++j) { p[kb][12 + j] *= S3; p[kb][8 + j] *= S2; p[kb][4 + j] *= S1; p[kb][j] *= S0; } } \
        bf16x8 pf[4]; pf[0] = pack8(p[0], 0); pf[1] = pack8(p[0], 1); pf[2] = pack8(p[1], 0); pf[3] = pack8(p[1], 1); \
        FA_PV(vbuf); } while (0)
__device__ __forceinline__ void sb_unit2(LAS unsigned char* lds, const Desc& d, int tid, f32x16 (&oa)[2], f32x16 (&ob)[2], LAS unsigned* ecnt) {
    typedef Geo<64, 0, 64> G; constexpr int DV = 64; constexpr bool QLDS = false; LAS unsigned char* qs = nullptr; constexpr int HB = G::BUF;
    const int lane = tid & 63, wave = __builtin_amdgcn_readfirstlane(tid >> 6), r = lane & 31, h = lane >> 5;
    bf16x8 qfa[4], qfb[4];
    { const unsigned qoff = (unsigned)((wave * 32 + r) * d.qstride);
#pragma unroll
      for (int s = 0; s < 4; ++s) { qfa[s] = *(const GAS bf16x8*)(d.q0 + qoff + s * 16 + h * 8); qfb[s] = *(const GAS bf16x8*)(d.q0 + 64 + qoff + s * 16 + h * 8); } }
    f32x16 zero;
#pragma unroll
    for (int i = 0; i < 16; ++i) { zero[i] = 0.f; oa[0][i] = 0.f; oa[1][i] = 0.f; ob[0][i] = 0.f; ob[1][i] = 0.f; }
    float carrya = 1.0f, carryb = 1.0f;
    const int qmin = d.qpos0 + wave * 32, qpos = qmin + r;
    const unsigned goff = (unsigned)((tid >> 3) * d.kstride + (tid & 7) * 8) * 2u, klds = (unsigned)((tid >> 3) * G::RSK + (tid & 7) * 16), vlds = (unsigned)(G::KBYTES + (tid >> 3) * G::RSV + (tid & 7) * 16);
    const __amdgpu_buffer_rsrc_t rk = __builtin_amdgcn_make_buffer_rsrc((void*)d.k0, 0, 0x7fffffff, 0x00020000), rv = __builtin_amdgcn_make_buffer_rsrc((void*)d.v, 0, 0x7fffffff, 0x00020000);
    v4u ka, kb2, va, vb2;
#define SB2_GLOAD(t_) do { const int so_ = (t_) * 64 * d.kstride * 2; ka = __builtin_bit_cast(v4u, __builtin_amdgcn_raw_buffer_load_b128(rk, (int)goff, so_, 0)); kb2 = __builtin_bit_cast(v4u, __builtin_amdgcn_raw_buffer_load_b128(rk, (int)goff + 128, so_, 0)); \
        va = __builtin_bit_cast(v4u, __builtin_amdgcn_raw_buffer_load_b128(rv, (int)goff, so_, 0)); vb2 = __builtin_bit_cast(v4u, __builtin_amdgcn_raw_buffer_load_b128(rv, (int)goff + 128, so_, 0)); } while (0)
#define SB2_LSTORE(buf_) do { LAS unsigned char* b_ = lds + (buf_) * 2 * HB; *(LAS v4u*)(b_ + klds) = ka; *(LAS v4u*)(b_ + HB + klds) = kb2; *(LAS v4u*)(b_ + vlds) = va; *(LAS v4u*)(b_ + HB + vlds) = vb2; } while (0)
    if (tid < 2) ecnt[tid] = 0u;
    SB2_GLOAD(d.t_hi); SB2_LSTORE(0); __syncthreads();
    int buf = 0; unsigned prev0 = 0u, prev1 = 0u; bool done_w = false;
    for (int t = d.t_hi; t >= d.t_lo; --t) {
        if (t > d.t_lo) SB2_GLOAD(t - 1);
        const int k0 = t * 64;
        if (k0 < qmin + 31 && !done_w) {
            const int dq0 = qpos - k0 - 4 * h;
            SB_HEAD(qfa, carrya, oa, lds + buf * 2 * HB);
            SB_HEAD(qfb, carryb, ob, lds + buf * 2 * HB + HB);
            done_w = __all(carrya <= 1e-30f && carryb <= 1e-30f);
        }
        if (!done_w && lane == 0) __hip_atomic_fetch_add(&ecnt[t & 1], 1u, __ATOMIC_RELAXED, __HIP_MEMORY_SCOPE_WORKGROUP);
        if (t > d.t_lo) SB2_LSTORE(buf ^ 1);
        __syncthreads();
        buf ^= 1;
        const unsigned c = ecnt[t & 1];
        if (t & 1) { if (c == prev1) break; prev1 = c; } else { if (c == prev0) break; prev0 = c; }
    }
    __syncthreads();
#undef SB2_GLOAD
#undef SB2_LSTORE
}
}
#ifndef B_EXIT
#define B_EXIT 1
#endif
__device__ __forceinline__ int vcu_of(const Frame& F) { return (F.G % 8 == 0) ? (F.bid % 8) * (F.G / 8) + F.bid / 8 : F.bid; }
template <int NV> __device__ __forceinline__ void store_rows_own(bf16* out, int rstride, int wave, int lane, const fa::f32x16 (&o)[NV], float scale) {
    const int r = lane & 31, h = lane >> 5; bf16* rowp = out + (unsigned)((wave * 32 + r) * rstride + 4 * h);
#pragma unroll
    for (int c = 0; c < NV; ++c)
#pragma unroll
        for (int g = 0; g < 4; ++g) { const unsigned lo = fa::cvtpk(o[c][4 * g] * scale, o[c][4 * g + 1] * scale), hi = fa::cvtpk(o[c][4 * g + 2] * scale, o[c][4 * g + 3] * scale);
            *(GAS unsigned long long*)(rowp + 32 * c + 8 * g) = (unsigned long long)lo | ((unsigned long long)hi << 32); }
}
template <int NV> __device__ __forceinline__ void store_rows(bf16* out, int rstride, int wave, int lane, const fa::f32x16 (&o)[NV], float scale) {
    const int r = lane & 31, h = lane >> 5; bf16* rowp = out + (unsigned)((wave * 32 + r) * rstride + 8 * h);
#pragma unroll
    for (int c = 0; c < NV; ++c)
#pragma unroll
        for (int k = 0; k < 4; k += 2) {
            unsigned ax = fa::cvtpk(o[c][4 * k] * scale, o[c][4 * k + 1] * scale), ay = fa::cvtpk(o[c][4 * k + 2] * scale, o[c][4 * k + 3] * scale);
            unsigned bx = fa::cvtpk(o[c][4 * k + 4] * scale, o[c][4 * k + 5] * scale), by = fa::cvtpk(o[c][4 * k + 6] * scale, o[c][4 * k + 7] * scale);
            const auto r0 = __builtin_amdgcn_permlane32_swap(ax, bx, false, false); const auto r1 = __builtin_amdgcn_permlane32_swap(ay, by, false, false);
            const v4u w = {r0[0], r1[0], r0[1], r1[1]};
            *(GAS v4u*)(rowp + 32 * c + 8 * k) = w; }
}
__device__ __forceinline__ void fast_attn_c(Frame& F, const bf16* Q, const bf16* KV, const bf16* KPE, const float* ropetab, bf16* OUT) {
    const int v = vcu_of(F);
    for (int P = v; P < BATCH * 16 * 8; P += F.G) {
        const int bh = P >> 3, pi = P & 7, b = bh >> 4, hd = bh & 15;
        for (int half = 0; half < 2; ++half) { const int qb = half ? pi : 15 - pi; const long row0 = (long)b * SEQ + qb * 256;
            fa::Desc d; d.q0 = Q + row0 * 1536 + 64 * hd; d.q1 = Q + row0 * 1536 + 1024 + 32 * hd; d.qstride = 1536;
            d.k0 = KV + (long)b * SEQ * 2048 + 64 * hd; d.kstride = 2048; d.k1 = KPE + (long)b * SEQ * 32; d.k1stride = 32;
            d.v = KV + (long)b * SEQ * 2048 + 1024 + 64 * hd; d.vstride = 2048; d.qpos0 = qb * 256; d.t_lo = 0; d.t_hi = 4 * qb + 3; d.W = 1 << 29; d.sl2 = 0.f; d.pm = nullptr; d.ecnt = nullptr; d.ropetab = ropetab;
            fa::f32x16 o[2]; float m, l;
            fa::flash_unit<64, 32, 64, false, false>(F.lds + RING_OFF, d, F.tid, o, m, l);
            const float lt = l + __shfl_xor(l, 32);
            store_rows<2>(OUT + row0 * 1024 + 64 * hd, 1024, F.wave, F.lane, o, 1.0f / lt);
        }
    }
}
__device__ __forceinline__ void fast_attn_d(Frame& F, const bf16* QKV, bf16* OUT) {
    const int v = vcu_of(F);
    LAS unsigned* ecnt = (LAS unsigned*)(F.lds + RING_OFF + 2 * fa::Geo<64, 0, 64>::BUF);
    for (int P = v; P < BATCH * 16 * 8; P += F.G) {
        const int bh = P >> 3, pi = P & 7, b = bh >> 4, hd = bh & 15;
        for (int half = 0; half < 2; ++half) { const int qb = half ? pi : 15 - pi; const long row0 = (long)b * SEQ + qb * 256;
            fa::Desc d; d.q0 = QKV + row0 * 3072 + 64 * hd; d.q1 = nullptr; d.qstride = 3072;
            d.k0 = QKV + (long)b * SEQ * 3072 + 1024 + 64 * hd; d.kstride = 3072; d.k1 = nullptr; d.k1stride = 0;
            d.v = QKV + (long)b * SEQ * 3072 + 2048 + 64 * hd; d.vstride = 3072; d.qpos0 = qb * 256; d.t_lo = 0; d.t_hi = 4 * qb + 3; d.W = 1 << 29; d.sl2 = 0.f; d.pm = nullptr; d.ecnt = nullptr; d.ropetab = nullptr;
            fa::f32x16 o[2];
            fa::sb_unit(F.lds + RING_OFF, d, F.tid, o, ecnt);
            store_rows<2>(OUT + row0 * 1024 + 64 * hd, 1024, F.wave, F.lane, o, 1.0f);
        }
    }
}
__device__ __forceinline__ void fast_attn_d2(Frame& F, const bf16* QKV, bf16* OUT) {
    const int v = vcu_of(F);
    LAS unsigned* ecnt = (LAS unsigned*)(F.lds + RING_OFF + 4 * fa::Geo<64, 0, 64>::BUF);
    for (int P = v; P < BATCH * 8 * 8; P += F.G) {
        const int bh = P >> 3, pi = P & 7, b = bh >> 3, hd = 2 * (bh & 7);
        for (int half = 0; half < 2; ++half) { const int qb = half ? pi : 15 - pi; const long row0 = (long)b * SEQ + qb * 256;
            fa::Desc d; d.q0 = QKV + row0 * 3072 + 64 * hd; d.q1 = nullptr; d.qstride = 3072;
            d.k0 = QKV + (long)b * SEQ * 3072 + 1024 + 64 * hd; d.kstride = 3072; d.k1 = nullptr; d.k1stride = 0;
            d.v = QKV + (long)b * SEQ * 3072 + 2048 + 64 * hd; d.vstride = 3072; d.qpos0 = qb * 256; d.t_lo = 0; d.t_hi = 4 * qb + 3; d.W = 1 << 29; d.sl2 = 0.f; d.pm = nullptr; d.ecnt = nullptr; d.ropetab = nullptr;
            fa::f32x16 oa[2], ob[2];
            fa::sb_unit2(F.lds + RING_OFF, d, F.tid, oa, ob, ecnt);
            store_rows<2>(OUT + row0 * 1024 + 64 * hd, 1024, F.wave, F.lane, oa, 1.0f);
            store_rows<2>(OUT + row0 * 1024 + 64 * hd + 64, 1024, F.wave, F.lane, ob, 1.0f);
        }
    }
}
__device__ __forceinline__ void fast_attn_b(Frame& F, const bf16* QKV, const float* KN, unsigned* queue, bf16* OUT, const float* lq1, const float* lk1, const float* lq2, const float* lk2, const float* subln) {
    float d1 = 0.f, d2 = 0.f;
    for (int i = 0; i < 64; ++i) { d1 += lq1[i] * lk1[i]; d2 += lq2[i] * lk2[i]; }
    const float lam_init = 0.8f - 0.6f * expf(-0.3f * 1.0f), lam = __builtin_bit_cast(float, __builtin_amdgcn_readfirstlane(__builtin_bit_cast(int, expf(d1) - expf(d2) + lam_init)));
    LAS int* qslot = (LAS int*)(F.lds + RING_OFF + 2 * fa::Geo<64, 0, 128>::BUF + NWAVES * 4096 + 512);
    for (;;) {
        if (F.tid == 0) *qslot = (int)__hip_atomic_fetch_add(queue, 1u, __ATOMIC_RELAXED, __HIP_MEMORY_SCOPE_AGENT);
        __syncthreads();
        const int P = *qslot;
        __syncthreads();
        if (P >= BATCH * 8 * 8) break;
        const int hd = 7 - (P >> 6), b = (P >> 3) & 7, pi = P & 7;
        for (int half = 0; half < 2; ++half) { const int qb = half ? pi : 15 - pi; const long row0 = (long)b * SEQ + qb * 256;
            fa::f32x16 o[4]; float m, l;
            bf16* orow = OUT + row0 * 1024 + 128 * hd;
            for (int mm = 0; mm < 2; ++mm) {
                fa::Desc d; d.q0 = QKV + row0 * 3072 + 128 * hd + 64 * mm; d.q1 = nullptr; d.qstride = 3072;
                d.k0 = QKV + (long)b * SEQ * 3072 + 1024 + 128 * hd + 64 * mm; d.kstride = 3072; d.k1 = nullptr; d.k1stride = 0;
                d.v = QKV + (long)b * SEQ * 3072 + 2048 + 128 * hd; d.vstride = 3072; d.qpos0 = qb * 256; d.t_lo = 0; d.t_hi = 4 * qb + 3; d.W = 1 << 29; d.sl2 = exp2f(-(float)(hd + 1)) * LOG2E;
                LAS float* pm = (LAS float*)(F.lds + RING_OFF + 2 * fa::Geo<64, 0, 128>::BUF + NWAVES * 4096); LAS unsigned* ecnt = (LAS unsigned*)(pm + 64);
                if (F.wave == 0) { int ln = F.lane; asm volatile("" : "+v"(ln)); float kv = (ln <= d.t_hi) ? KN[((size_t)b * 16 + 2 * hd + mm) * 64 + ln] * 1.01f : 0.f;
#pragma unroll
                    for (int o_ = 1; o_ < 64; o_ <<= 1) { const float u = __shfl_up(kv, o_); if (F.lane >= o_) kv = fmaxf(kv, u); }
                    pm[F.lane] = kv; if (F.lane < 2) ecnt[F.lane] = 0u; }
                d.pm = pm; d.ecnt = ecnt; d.ropetab = nullptr;
                fa::flash_unit<64, 0, 128, true, true, (B_EXIT != 0)>(F.lds + RING_OFF, d, F.tid, o, m, l);
                const float rl = 1.0f / (l + __shfl_xor(l, 32));
                if (mm == 0) { store_rows_own<4>(orow, 1024, F.wave, F.lane, o, rl); }
                else {
                    int l2 = F.lane; asm volatile("" : "+v"(l2)); const int r = l2 & 31, h = l2 >> 5;
                    float ss = 0.f; const bf16* rowp = orow + (unsigned)((F.wave * 32 + r) * 1024 + 4 * h);
#pragma unroll
                    for (int c = 0; c < 4; ++c) {
#pragma unroll
                        for (int g = 0; g < 4; ++g) { const unsigned long long w = *(const GAS unsigned long long*)(rowp + 32 * c + 8 * g); const unsigned lo = (unsigned)w, hi = (unsigned)(w >> 32);
                            const float a0 = bf_lo(lo) - lam * o[c][4 * g] * rl, a1 = bf_hi(lo) - lam * o[c][4 * g + 1] * rl, a2 = bf_lo(hi) - lam * o[c][4 * g + 2] * rl, a3 = bf_hi(hi) - lam * o[c][4 * g + 3] * rl;
                            o[c][4 * g] = a0; o[c][4 * g + 1] = a1; o[c][4 * g + 2] = a2; o[c][4 * g + 3] = a3; ss += (a0 * a0 + a1 * a1) + (a2 * a2 + a3 * a3); }
                        asm volatile("" ::: "memory"); }
                    ss += __shfl_xor(ss, 32);
                    const float rs = (1.0f - lam_init) / sqrtf(ss * (1.0f / 128.0f) + SUBLN_EPS);
#pragma unroll
                    for (int c = 0; c < 4; ++c) {
#pragma unroll
                        for (int g = 0; g < 4; ++g) { const f32x4 sg = *(const GAS f32x4*)(subln + 32 * c + 8 * g + 4 * h);
                            o[c][4 * g] *= sg[0]; o[c][4 * g + 1] *= sg[1]; o[c][4 * g + 2] *= sg[2]; o[c][4 * g + 3] *= sg[3]; }
                        asm volatile("" ::: "memory"); }
                    store_rows_own<4>(orow, 1024, F.wave, F.lane, o, rs);
                }
            }
        }
    }
}
__device__ __forceinline__ void fast_attn_a(Frame& F, const bf16* QKV, bf16* OG, float* LSE) {
    const int v = vcu_of(F);
    for (int U = v; U < 3 * BATCH * 8 * 16; U += F.G) {
        const int j = U & 15, hd = (U >> 4) & 7, b = (U >> 7) & 7, g = U >> 10; const int dil = 1 << (2 * g), res = j & (dil - 1), qblk = j >> (2 * g);
        const long tok0 = (long)b * SEQ + res;
        fa::Desc d; d.qstride = dil * 4608; d.q0 = QKV + (tok0 + (long)qblk * 256 * dil) * 4608 + g * 512 + hd * 64; d.q1 = nullptr;
        d.k0 = QKV + tok0 * 4608 + 1536 + g * 512 + hd * 64; d.kstride = d.qstride; d.k1 = nullptr; d.k1stride = 0;
        d.v = QKV + tok0 * 4608 + 3072 + g * 512 + hd * 64; d.vstride = d.qstride; d.qpos0 = qblk * 256;
        d.t_lo = (qblk * 256 - 128) < 0 ? 0 : (qblk * 256 - 128) / 64; d.t_hi = 4 * qblk + 3; d.W = 128; d.sl2 = exp2f(-(float)(g * 8 + hd + 1) / 3.0f) * LOG2E * (float)dil; d.pm = nullptr; d.ecnt = nullptr; d.ropetab = nullptr;
        fa::f32x16 o[2]; float m, l;
        fa::flash_unit<64, 0, 64, true, false>(F.lds + RING_OFF, d, F.tid, o, m, l);
        const float lt = l + __shfl_xor(l, 32);
        bf16* og = OG + (size_t)g * NTOK * 512;
        store_rows<2>(og + (tok0 + (long)qblk * 256 * dil) * 512 + hd * 64, dil * 512, F.wave, F.lane, o, 1.0f / lt);
        if (F.lane < 32) LSE[(size_t)g * NTOK * 8 + (tok0 + ((long)qblk * 256 + F.wave * 32 + F.lane) * dil) * 8 + hd] = m + log2f(lt);
    }
}
__device__ __forceinline__ void merge_a(Frame& F, const bf16* OG, const float* LSE, bf16* OUT) {
    const long stride = (long)F.G * NWAVES * 64, NI = (long)NTOK * 64;
    for (long i = (long)F.bid * NWAVES * 64 + F.tid; i < NI; i += 2 * stride) {
        const bool has2 = i + stride < NI; const long i2 = has2 ? i + stride : i;
        const long tokA = i >> 6, tokB = i2 >> 6; const int cA = (int)(i & 63), cB = (int)(i2 & 63), hA = cA >> 3, hB = cB >> 3;
        const float lA0 = LSE[tokA * 8 + hA], lA1 = LSE[(size_t)NTOK * 8 + tokA * 8 + hA], lA2 = LSE[(size_t)2 * NTOK * 8 + tokA * 8 + hA];
        const float lB0 = LSE[tokB * 8 + hB], lB1 = LSE[(size_t)NTOK * 8 + tokB * 8 + hB], lB2 = LSE[(size_t)2 * NTOK * 8 + tokB * 8 + hB];
        float a0[8], a1[8], a2[8], b0[8], b1[8], b2[8];
        ld8(OG + tokA * 512 + cA * 8, a0); ld8(OG + (size_t)NTOK * 512 + tokA * 512 + cA * 8, a1); ld8(OG + (size_t)2 * NTOK * 512 + tokA * 512 + cA * 8, a2);
        ld8(OG + tokB * 512 + cB * 8, b0); ld8(OG + (size_t)NTOK * 512 + tokB * 512 + cB * 8, b1); ld8(OG + (size_t)2 * NTOK * 512 + tokB * 512 + cB * 8, b2);
        { const float mx = fmaxf(lA0, fmaxf(lA1, lA2)); const float w0 = ex2(lA0 - mx), w1 = ex2(lA1 - mx), w2 = ex2(lA2 - mx), rw = 1.0f / (w0 + w1 + w2);
          float y[8];
#pragma unroll
          for (int e = 0; e < 8; ++e) y[e] = (w0 * a0[e] + w1 * a1[e] + w2 * a2[e]) * rw;
          v4u w; w.x = pk2(y[0], y[1]); w.y = pk2(y[2], y[3]); w.z = pk2(y[4], y[5]); w.w = pk2(y[6], y[7]);
          *(GAS v4u*)(OUT + tokA * 512 + cA * 8) = w; }
        if (has2) { const float mx = fmaxf(lB0, fmaxf(lB1, lB2)); const float w0 = ex2(lB0 - mx), w1 = ex2(lB1 - mx), w2 = ex2(lB2 - mx), rw = 1.0f / (w0 + w1 + w2);
          float y[8];
#pragma unroll
          for (int e = 0; e < 8; ++e) y[e] = (w0 * b0[e] + w1 * b1[e] + w2 * b2[e]) * rw;
          v4u w; w.x = pk2(y[0], y[1]); w.y = pk2(y[2], y[3]); w.z = pk2(y[4], y[5]); w.w = pk2(y[6], y[7]);
          *(GAS v4u*)(OUT + tokB * 512 + cB * 8) = w; }
    }
}

__device__ __forceinline__ void knorm_phase(Frame& F, const bf16* QKV, float* KN) {
    const int gw = F.bid * NWAVES + F.wave, NGW = F.G * NWAVES;
    for (int it = gw; it < BATCH * 64 * 16; it += NGW) {
        const int hm = it & 15, tile = (it >> 4) & 63, b = it >> 10;
        const bf16* row = QKV + ((size_t)b * SEQ + tile * 64 + F.lane) * 3072 + 1024 + hm * 64;
        float s = 0.f;
#pragma unroll
        for (int c = 0; c < 8; ++c) { float f[8]; ld8(row + 8 * c, f);
#pragma unroll
            for (int e = 0; e < 8; ++e) s += f[e] * f[e]; }
        float mx = sqrtf(s);
#pragma unroll
        for (int o_ = 1; o_ < 64; o_ <<= 1) mx = fmaxf(mx, __shfl_xor(mx, o_));
        if (F.lane == 0) KN[((size_t)b * 16 + hm) * 64 + tile] = mx;
    }
}

__device__ __forceinline__ int wave_sum_i(int v) {
#pragma unroll
    for (int o = 1; o < 64; o <<= 1) v += __shfl_xor(v, o);
    return v;
}
__device__ __forceinline__ void moe_layout(Frame& F, const int* wgcnt, LAS int* tot) {
    int t = 0, bfr = 0;
    for (int w = F.lane; w < F.G; w += 64) { const int c = wgcnt[w * 8 + F.wave]; t += c; bfr += (w < F.bid) ? c : 0; }
    t = wave_sum_i(t); bfr = wave_sum_i(bfr);
    if (F.lane == 0) { tot[F.wave] = t; tot[8 + F.wave] = bfr; }
    __syncthreads();
    if (F.tid == 0) { int ps = 0; for (int e = 0; e < 8; ++e) { tot[16 + e] = ps + tot[8 + e]; ps += ((tot[e] + 255) >> 8) << 8; F.MISC[16 + e] = (unsigned)(ps >> 8); } F.MISC[24] = (unsigned)(ps >> 8); }
    __syncthreads();
}

__device__ __forceinline__ void ropeq_phase(Frame& F, bf16* Q, const float* tab) {
    const int gw = F.bid * NWAVES + F.wave, NGW = F.G * NWAVES;
    for (int r = gw; r < NTOK; r += NGW) {
        GAS v4u* p = (GAS v4u*)(Q + (size_t)r * 1536 + 1024) + F.lane; v4u w = *p;
        const float* t = tab + (size_t)(r % SEQ) * 32 + 8 * (F.lane & 3); const f32x4 c0 = *(const GAS f32x4*)t, c1 = *(const GAS f32x4*)(t + 4);
        float a, b;
        a = bf_lo(w.x); b = bf_hi(w.x); w.x = pk2(a * c0[0] - b * c0[1], a * c0[1] + b * c0[0]);
        a = bf_lo(w.y); b = bf_hi(w.y); w.y = pk2(a * c0[2] - b * c0[3], a * c0[3] + b * c0[2]);
        a = bf_lo(w.z); b = bf_hi(w.z); w.z = pk2(a * c1[0] - b * c1[1], a * c1[1] + b * c1[0]);
        a = bf_lo(w.w); b = bf_hi(w.w); w.w = pk2(a * c1[2] - b * c1[3], a * c1[3] + b * c1[2]);
        *p = w;
    }
}

#ifndef MK_SPLIT
#define MK_SPLIT 0
#endif
#ifndef NAIVE_A
#define NAIVE_A 0
#endif
#ifndef NAIVE_B
#define NAIVE_B 0
#endif
#ifndef NAIVE_C
#define NAIVE_C 0
#endif
#ifndef NAIVE_D
#define NAIVE_D 0
#endif
#ifndef QKVD_F8
#define QKVD_F8 1
#endif
#ifndef FFN2_F8
#define FFN2_F8 1
#endif
constexpr int N_PHASES = 32;
struct Args { const float* in[N_IN]; float* out; unsigned char* ws; int ph_lo, ph_hi; };
static_assert(sizeof(Args) == N_IN * 8 + 8 + 8 + 8, "Args has no padding holes");

__global__ void __launch_bounds__(NWAVES * 64, 2) fwd_kernel(Args args) {
    extern __shared__ __attribute__((aligned(16))) unsigned char lds[];
    Frame F;
    F.lds = (LAS unsigned char*)lds;
    F.MISC = (volatile LAS unsigned*)(F.lds + MISC_OFF);
    F.tid = threadIdx.x; F.lane = F.tid & 63; F.wave = __builtin_amdgcn_readfirstlane(F.tid >> 6);
    F.G = gridDim.x; F.bid = blockIdx.x;
    unsigned char* ws = args.ws;
    F.ctl = (gu32*)(ws + WS_CTL);
    if (F.tid < 64) F.MISC[F.tid] = 0u;
    __syncthreads();
    XcdBarrier bar; bar.bar = (unsigned*)(F.ctl + CW_BAR); bar.x = 0; bar.st = nullptr;
    if (!MK_SPLIT) bar = xcd_barrier_post((unsigned*)(F.ctl + CW_BAR), F.MISC + 8);
    const int lo = args.ph_lo, hi = args.ph_hi;
#ifndef CT_LO
#define CT_LO 0
#endif
#ifndef CT_HI
#define CT_HI 1000
#endif
#define IN(k) ((k) >= CT_LO && (k) < CT_HI && lo <= (k) && (k) < hi)
#ifndef PROBE_MASK
#define PROBE_MASK 0ull
#endif
#define NREP(k) ((((unsigned long long)(PROBE_MASK) >> (k)) & 1ull) ? 2 : 1)
#define SEAM(k) do { if (!MK_SPLIT && IN(k) && IN((k) + 1)) xcd_barrier(bar); } while (0)
#define WSP(T, off) ((T*)(ws + (off)))
#define GEMM_STATIC(EPI_T, Ap, Bp, M_, N_, K_, ...) do { pg8::Gemm g{(const pg8::bf16_t*)(Ap), (const pg8::bf16_t*)(Bp), M_, N_, K_, 0}; pg8::StaticOrder S; S.init(M_, N_, F.G, F.bid); \
        EPI_T E{__VA_ARGS__}; pg8::gemm_phase<EPI_T, pg8::StaticOrder, PG8_ALIGN, PG8_SP2>(F.lds + RING_OFF, g, S, E); } while (0)
#define GEMM_STATIC_LDA(EPI_T, Ap, lda_, Bp, M_, N_, K_, ...) do { pg8::Gemm g{(const pg8::bf16_t*)(Ap), (const pg8::bf16_t*)(Bp), M_, N_, K_, 0, lda_}; pg8::StaticOrder S; S.init(M_, N_, F.G, F.bid); \
        EPI_T E{__VA_ARGS__}; pg8::gemm_phase<EPI_T, pg8::StaticOrder, PG8_ALIGN, PG8_SP2>(F.lds + RING_OFF, g, S, E); } while (0)
#define GEMM_STATIC_F8(EPI_T, Ap, Bp, M_, N_, K_, ...) do { pg8::Gemm g{(const pg8::bf16_t*)(Ap), (const pg8::bf16_t*)(Bp), M_, N_, K_, 0}; pg8::StaticOrder S; S.init(M_, N_, F.G, F.bid); \
        EPI_T E{__VA_ARGS__}; pg8::gemm_phase<EPI_T, pg8::StaticOrder, PG8_ALIGN, PG8_SP2, true>(F.lds + RING_OFF, g, S, E); } while (0)
#define GEMM_MOE(EPI_T, Ap, Bp, N_, K_, ...) do { if (MK_SPLIT) moe_layout(F, WSP(int, WS_WGCNT), (LAS int*)(F.lds + RING_OFF));     \
        pg8::Gemm g{(const pg8::bf16_t*)(Ap), (const pg8::bf16_t*)(Bp), 0, N_, K_, (size_t)(N_) * (K_) * 2}; pg8::MoeOrder S; const int nblk_ = (int)F.MISC[24]; S.so.init(nblk_ * 256, N_, F.G, F.bid); \
        _Pragma("unroll") for (int j_ = 0; j_ < 8; ++j_) S.pend[j_] = __builtin_amdgcn_readfirstlane((int)F.MISC[16 + j_]); \
        __syncthreads(); EPI_T E{__VA_ARGS__}; pg8::gemm_phase<EPI_T, pg8::MoeOrder, PG8_ALIGN, PG8_SP2, true>(F.lds + RING_OFF, g, S, E); } while (0)
    const float* const* in = args.in;
    const bool M3_SPLIT = (F.G == 256) && !MK_SPLIT && lo == 0 && hi >= N_PHASES;
    bf16* H = WSP(bf16, WS_H); bf16* XB = WSP(bf16, WS_XB); bf16* BIG = WSP(bf16, WS_BIG); bf16* XR = WSP(bf16, WS_XR);
    float* SS = WSP(float, WS_SS);
#define SSQ(s) (SS + (size_t)(s) * NTOK * pg8::SSW)
    const float QS = 0.125f * LOG2E;
    const int gw = F.bid * NWAVES + F.wave, NGW = F.G * NWAVES;
    LAS float* scr = (LAS float*)(F.lds + RING_OFF + F.wave * 16384);
#define PH(k) if (IN(k)) for (int rep_ = 0; rep_ < NREP(k); ++rep_)

    PH(0) {
        int base = 0;
        conv_matrix(in[I_A_WQKV], DM, 4608, WSP(bf16, W_QKV_A), MAP_ID, 1536, QS, in[I_A_NORM], scr, gw, NGW, base, F.lane);
        conv_matrix(in[I_A_WO], 512, DM, WSP(bf16, W_O_A), MAP_ID, 0, 1.f, nullptr, scr, gw, NGW, base, F.lane);
        conv_matrix(in[I_F0_WG], DM, FFD, WSP(bf16, W_GU0), MAP_GATE, 0, 1.f, in[I_F0_NORM], scr, gw, NGW, base, F.lane);
        conv_matrix(in[I_F0_WU], DM, FFD, WSP(bf16, W_GU0), MAP_UP, 0, 1.f, in[I_F0_NORM], scr, gw, NGW, base, F.lane);
        conv_matrix(in[I_F0_WD], FFD, DM, WSP(bf16, W_D0), MAP_ID, 0, 1.f, nullptr, scr, gw, NGW, base, F.lane);
        conv_matrix(in[I_B_WQKV], DM, 3072, WSP(bf16, W_QKV_B), MAP_ID, 1024, QS, in[I_B_NORM], scr, gw, NGW, base, F.lane);
        conv_matrix(in[I_B_WO], DM, DM, WSP(bf16, W_O_B), MAP_ID, 0, 1.f, nullptr, scr, gw, NGW, base, F.lane);
        conv_matrix(in[I_C_WIN], DM, 672, WSP(bf16, W_IN_C), MAP_CIN, 0, 1.f, in[I_C_NORM], scr, gw, NGW, base, F.lane);
        conv_matrix(in[I_C_WQUP], 384, 1536, WSP(bf16, W_QUP_C), MAP_CQUP, 1536, 0.10206207261596575f * LOG2E, in[I_C_QNORM], scr, gw, NGW, base, F.lane);
        conv_matrix(in[I_C_WKVUP], 256, 2048, WSP(bf16, W_KVUP_C), MAP_CKVUP, 0, 1.f, in[I_C_KVNORM], scr, gw, NGW, base, F.lane);
        conv_matrix(in[I_C_WO], DM, DM, WSP(bf16, W_O_C), MAP_ID, 0, 1.f, nullptr, scr, gw, NGW, base, F.lane);
        if (FFN2_F8) { conv_matrix_f8(in[I_F2_WG], DM, FFD, ws + W_GU2, MAP_GATE, F8_SW1, in[I_F2_NORM], scr, gw, NGW, base, F.lane); conv_matrix_f8(in[I_F2_WU], DM, FFD, ws + W_GU2, MAP_UP, F8_SW1, in[I_F2_NORM], scr, gw, NGW, base, F.lane);
                       conv_matrix_f8(in[I_F2_WD], FFD, DM, ws + W_D2, MAP_ID, F8_SW2, nullptr, scr, gw, NGW, base, F.lane); }
        else { conv_matrix(in[I_F2_WG], DM, FFD, WSP(bf16, W_GU2), MAP_GATE, 0, 1.f, in[I_F2_NORM], scr, gw, NGW, base, F.lane); conv_matrix(in[I_F2_WU], DM, FFD, WSP(bf16, W_GU2), MAP_UP, 0, 1.f, in[I_F2_NORM], scr, gw, NGW, base, F.lane);
               conv_matrix(in[I_F2_WD], FFD, DM, WSP(bf16, W_D2), MAP_ID, 0, 1.f, nullptr, scr, gw, NGW, base, F.lane); }
        if (QKVD_F8) conv_matrix_f8q(in[I_D_WQKV], DM, 3072, ws + W_QKV_D, MAP_ID, F8_SW1, 1024, QS, in[I_D_NORM], scr, gw, NGW, base, F.lane);
        else conv_matrix(in[I_D_WQKV], DM, 3072, WSP(bf16, W_QKV_D), MAP_ID, 1024, QS, in[I_D_NORM], scr, gw, NGW, base, F.lane);
        conv_matrix(in[I_D_WO], DM, DM, WSP(bf16, W_O_D), MAP_ID, 0, 1.f, nullptr, scr, gw, NGW, base, F.lane);
        conv_moe(in[I_M1_WG], in[I_M1_WU], in[I_M1_WD], in[I_M1_NORM], ws + W_MOE_GU, ws + W_MOE_D, scr, gw, NGW, F.lane);
        conv_moe(in[I_M3_WG], in[I_M3_WU], in[I_M3_WD], in[I_M3_NORM], ws + W_MOE_GU + W_MOE_L2, ws + W_MOE_D + W_MOE_L2, scr, gw, NGW, F.lane, 0, M3_SPLIT ? 4 : NEXP);
        { GAS v4u* z = (GAS v4u*)(ws + W_IN_C + (size_t)672 * DM * 2); const v4u zz = {0u, 0u, 0u, 0u};
          for (int i = F.bid * NWAVES * 64 + F.tid; i < 96 * DM * 2 / 16; i += F.G * NWAVES * 64) z[i] = zz; }
        { float* tab = WSP(float, WS_ROPE);
          for (int i = F.bid * NWAVES * 64 + F.tid; i < SEQ * 16; i += F.G * NWAVES * 64) { const int pos = i >> 4, fi = i & 15;
              const float inv = exp2f(-(float)fi * (13.287712379549449f / 16.0f)); const float ang = (float)pos * inv;
              const double rev = (double)ang * 0.15915494309189535; const float fr = (float)(rev - floor(rev + 0.5));
              tab[2 * i] = __builtin_amdgcn_cosf(fr); tab[2 * i + 1] = __builtin_amdgcn_sinf(fr); } }
        { float* gwr = WSP(float, WS_GWR);
          for (int i = F.bid * NWAVES * 64 + F.tid; i < 2 * DM * 8; i += F.G * NWAVES * 64) { const int l = i >> 13, j = i & 8191;
              gwr[i] = (l ? in[I_M3_WR] : in[I_M1_WR])[j] * (l ? in[I_M3_NORM] : in[I_M1_NORM])[j >> 3]; } }
        row_phase<0>(F, in[I_X], XR, SSQ(0), nullptr, nullptr, nullptr, nullptr, nullptr, nullptr, nullptr, nullptr);
    }
    SEAM(0);
    PH(1) GEMM_STATIC(pg8::EpiBf16, XR, ws + W_QKV_A, NTOK, 4608, DM, BIG, 4608, SSQ(0), 1.0f);
    SEAM(1);
    PH(2) { fast_attn_a(F, BIG, XB, WSP(float, WS_XB + 96 * MiB)); }
    SEAM(2);
    PH(3) { merge_a(F, XB, WSP(float, WS_XB + 96 * MiB), H); }
    SEAM(3);
    PH(4) GEMM_STATIC(pg8::EpiResidB, H, ws + W_O_A, NTOK, DM, 512, XR, DM, 1.0f, SSQ(1), (PG8_LAS float*)(F.lds + RESTAB_OFF), nullptr, 0.0f);
    SEAM(4);
    PH(5) GEMM_STATIC(pg8::EpiSwiglu, XR, ws + W_GU0, NTOK, 2 * FFD, DM, BIG, FFD, SSQ(1));
    SEAM(5);
    PH(6) GEMM_STATIC(pg8::EpiResidB, BIG, ws + W_D0, NTOK, DM, FFD, XR, DM, 1.0f, SSQ(2), (PG8_LAS float*)(F.lds + RESTAB_OFF), nullptr, 0.0f);
    SEAM(6);
    PH(7) GEMM_STATIC(pg8::EpiBf16, XR, ws + W_QKV_B, NTOK, 3072, DM, BIG, 3072, SSQ(2), 1.0f);
    SEAM(7);
    PH(8) { knorm_phase(F, BIG, WSP(float, WS_KN)); }
    SEAM(8);
    PH(9) { fast_attn_b(F, BIG, WSP(float, WS_KN), (unsigned*)(F.ctl + CW_QB), H, in[I_B_LQ1], in[I_B_LK1], in[I_B_LQ2], in[I_B_LK2], in[I_B_SUBLN]); }
    SEAM(9);
    PH(10) GEMM_STATIC(pg8::EpiResidB, H, ws + W_O_B, NTOK, DM, DM, XR, DM, 1.0f, SSQ(3), (PG8_LAS float*)(F.lds + RESTAB_OFF), nullptr, 0.0f);
    SEAM(10);
    PH(11) row_phase<1>(F, nullptr, XR, SSQ(3), nullptr, nullptr, nullptr, nullptr, WSP(float, WS_GWR), WSP(int, WS_TOKE), WSP(float, WS_TOKG), WSP(int, WS_WGCNT));
    SEAM(11);
    PH(12) { LAS int* tot = (LAS int*)(F.lds + RING_OFF); moe_layout(F, WSP(int, WS_WGCNT), tot); slot_phase(F, tot, WSP(int, WS_TOKE), WSP(float, WS_TOKG), WSP(int, WS_TOKS), WSP(float, WS_SGATE), WSP(float, WS_SSS), SSQ(3), XR, (unsigned char*)XB); }
    SEAM(12);
    PH(13) GEMM_MOE(pg8::EpiSwigluF8, XB, ws + W_MOE_GU, 2 * FFE, DM / 2, (unsigned char*)BIG, FFE, 1.0f / (F8_SA * F8_SW1), F8_SACT, WSP(float, WS_SSS), nullptr);
    SEAM(13);
    PH(14) { GEMM_MOE(pg8::EpiMoeDown, BIG, ws + W_MOE_D, DM, FFE / 2, XB, DM, WSP(float, WS_SGATE), 1.0f / (F8_SACT * F8_SW2));
             if (M3_SPLIT && F.bid >= 32) conv_moe(in[I_M3_WG], in[I_M3_WU], in[I_M3_WD], in[I_M3_NORM], ws + W_MOE_GU + W_MOE_L2, ws + W_MOE_D + W_MOE_L2, scr, (F.bid - 32) * NWAVES + F.wave, (F.G - 32) * NWAVES, F.lane, 5, 8); }
    SEAM(14);
    PH(15) row_phase<2>(F, nullptr, XR, SSQ(4), nullptr, nullptr, XB, WSP(int, WS_TOKS), nullptr, nullptr, nullptr, nullptr);
    SEAM(15);
    PH(16) { GEMM_STATIC(pg8::EpiLat, XR, ws + W_IN_C, NTOK, 768, DM, WSP(bf16, C_LAT), SSQ(4), SSQ(8), SSQ(9), (PG8_LAS float*)(F.lds + RESTAB_OFF));
             if (M3_SPLIT && F.bid >= 128) conv_moe(in[I_M3_WG], in[I_M3_WU], in[I_M3_WD], in[I_M3_NORM], ws + W_MOE_GU + W_MOE_L2, ws + W_MOE_D + W_MOE_L2, scr, (F.bid - 128) * NWAVES + F.wave, (F.G - 128) * NWAVES, F.lane, 4, 5); }
    SEAM(16);
    PH(17) { kpe_phase(F, WSP(bf16, C_LAT), WSP(float, WS_ROPE), WSP(bf16, C_KPE));
             GEMM_STATIC_LDA(pg8::EpiBf16, ws + C_LAT, 768, ws + W_QUP_C, NTOK, 1536, 384, WSP(bf16, C_Q), 1536, SSQ(8), 1.0f);
             GEMM_STATIC_LDA(pg8::EpiBf16, ws + C_LAT + 384 * 2, 768, ws + W_KVUP_C, NTOK, 2048, 256, WSP(bf16, C_KV), 2048, SSQ(9), 1.0f); }
    SEAM(19);
    PH(20) { fast_attn_c(F, WSP(bf16, C_Q), WSP(bf16, C_KV), WSP(bf16, C_KPE), WSP(float, WS_ROPE), H); }
    SEAM(20);
    PH(21) { if (FFN2_F8) GEMM_STATIC(pg8::EpiResidB8, H, ws + W_O_C, NTOK, DM, DM, XR, DM, 1.0f, SSQ(5), (PG8_LAS float*)(F.lds + RESTAB_OFF), (unsigned char*)XB, F8_SA); else GEMM_STATIC(pg8::EpiResidB, H, ws + W_O_C, NTOK, DM, DM, XR, DM, 1.0f, SSQ(5), (PG8_LAS float*)(F.lds + RESTAB_OFF), nullptr, 0.0f); }
    SEAM(21);
    PH(22) { if (FFN2_F8) GEMM_STATIC_F8(pg8::EpiSwigluF8, XB, ws + W_GU2, NTOK, 2 * FFD, DM / 2, (unsigned char*)BIG, FFD, 1.0f / (F8_SA * F8_SW1), F8_SACT, nullptr, SSQ(5)); else GEMM_STATIC(pg8::EpiSwiglu, XR, ws + W_GU2, NTOK, 2 * FFD, DM, BIG, FFD, SSQ(5)); }
    SEAM(22);
    PH(23) { if (FFN2_F8 && QKVD_F8) GEMM_STATIC_F8(pg8::EpiResidB8, BIG, ws + W_D2, NTOK, DM, FFD / 2, XR, DM, 1.0f / (F8_SACT * F8_SW2), SSQ(6), (PG8_LAS float*)(F.lds + RESTAB_OFF), (unsigned char*)XB, F8_SA);
             else if (FFN2_F8) GEMM_STATIC_F8(pg8::EpiResidB, BIG, ws + W_D2, NTOK, DM, FFD / 2, XR, DM, 1.0f / (F8_SACT * F8_SW2), SSQ(6), (PG8_LAS float*)(F.lds + RESTAB_OFF), nullptr, 0.0f);
             else GEMM_STATIC(pg8::EpiResidB, BIG, ws + W_D2, NTOK, DM, FFD, XR, DM, 1.0f, SSQ(6), (PG8_LAS float*)(F.lds + RESTAB_OFF), nullptr, 0.0f); }
    SEAM(23);
    PH(24) { if (QKVD_F8) GEMM_STATIC_F8(pg8::EpiBf16, XB, ws + W_QKV_D, NTOK, 3072, DM / 2, BIG, 3072, SSQ(6), 1.0f / (F8_SA * F8_SW1)); else GEMM_STATIC(pg8::EpiBf16, XR, ws + W_QKV_D, NTOK, 3072, DM, BIG, 3072, SSQ(6), 1.0f); }
    SEAM(24);
    PH(25) { fast_attn_d2(F, BIG, H); }
    SEAM(25);
    PH(26) GEMM_STATIC(pg8::EpiResidB, H, ws + W_O_D, NTOK, DM, DM, XR, DM, 1.0f, SSQ(7), (PG8_LAS float*)(F.lds + RESTAB_OFF), nullptr, 0.0f);
    SEAM(26);
    PH(27) row_phase<1>(F, nullptr, XR, SSQ(7), nullptr, nullptr, nullptr, nullptr, WSP(float, WS_GWR) + DM * 8, WSP(int, WS_TOKE), WSP(float, WS_TOKG), WSP(int, WS_WGCNT));
    SEAM(27);
    PH(28) { LAS int* tot = (LAS int*)(F.lds + RING_OFF); moe_layout(F, WSP(int, WS_WGCNT), tot); slot_phase(F, tot, WSP(int, WS_TOKE), WSP(float, WS_TOKG), WSP(int, WS_TOKS), WSP(float, WS_SGATE), WSP(float, WS_SSS), SSQ(7), XR, (unsigned char*)XB); }
    SEAM(28);
    PH(29) GEMM_MOE(pg8::EpiSwigluF8, XB, ws + W_MOE_GU + W_MOE_L2, 2 * FFE, DM / 2, (unsigned char*)BIG, FFE, 1.0f / (F8_SA * F8_SW1), F8_SACT, WSP(float, WS_SSS), nullptr);
    SEAM(29);
    PH(30) GEMM_MOE(pg8::EpiMoeDown, BIG, ws + W_MOE_D + W_MOE_L2, DM, FFE / 2, XB, DM, WSP(float, WS_SGATE), 1.0f / (F8_SACT * F8_SW2));
    SEAM(30);
    PH(31) row_phase<3>(F, nullptr, XR, nullptr, in[I_FINAL_NORM], args.out, XB, WSP(int, WS_TOKS), nullptr, nullptr, nullptr, nullptr);
#undef IN
#undef SEAM
}

extern "C" void kernel_launch(void* const* d_in, const int* in_sizes, int n_in, void* d_out, int out_size, void* d_ws, size_t ws_size, hipStream_t stream) {
    static int grid = 0;
    if (grid == 0) {
        if (n_in != N_IN || out_size != NTOK * DM || ws_size < WS_SSS + 5 * MiB) { fprintf(stderr, "kernel_launch: unexpected problem shape (n_in %d, out %d, ws %zu)\n", n_in, out_size, ws_size); grid = -1; return; }
        int dev = 0, cus = 0, per_cu = 0;
        if (hipGetDevice(&dev) != hipSuccess || hipDeviceGetAttribute(&cus, hipDeviceAttributeMultiprocessorCount, dev) != hipSuccess) { grid = -1; return; }
        if (hipFuncSetAttribute((const void*)fwd_kernel, hipFuncAttributeMaxDynamicSharedMemorySize, LDS_BYTES) != hipSuccess) { fprintf(stderr, "kernel_launch: hipFuncSetAttribute failed\n"); grid = -1; return; }
        if (hipOccupancyMaxActiveBlocksPerMultiprocessor(&per_cu, (const void*)fwd_kernel, NWAVES * 64, LDS_BYTES) != hipSuccess || per_cu < 1) { fprintf(stderr, "kernel_launch: occupancy query reports %d\n", per_cu); }
        (void)hipGetLastError();
        grid = cus;
    }
    if (grid < 0) return;
    (void)hipMemsetAsync((char*)d_ws + WS_CTL, 0, CTL_ZERO_BYTES, stream);
    Args a{};
    for (int i = 0; i < N_IN; ++i) a.in[i] = (const float*)d_in[i];
    a.out = (float*)d_out; a.ws = (unsigned char*)d_ws;
#if MK_SPLIT
    for (int p = 0; p < N_PHASES; ++p) { a.ph_lo = p; a.ph_hi = p + 1; hipLaunchKernelGGL(fwd_kernel, dim3(grid), dim3(NWAVES * 64), LDS_BYTES, stream, a); }
#else
    a.ph_lo = 0; a.ph_hi = N_PHASES;
    hipLaunchKernelGGL(fwd_kernel, dim3(grid), dim3(NWAVES * 64), LDS_BYTES, stream, a);
#endif
}
```

```cpp
#include <hip/hip_runtime.h>
#include <cstdio>
#include <cstdint>
#include <cmath>

namespace pg8 {
#define PG8_LAS __attribute__((address_space(3)))
typedef unsigned short bf16_t;
typedef short bf16x8 __attribute__((ext_vector_type(8)));
typedef float f32x4 __attribute__((ext_vector_type(4)));
typedef unsigned u32x4 __attribute__((ext_vector_type(4)));
constexpr int BM = 256, BK = 64, HALF = 128, HTB = HALF * BK * 2  , STAGE_BYTES = 8 * HTB, NXCD = 8, WGM = 8;

__host__ __device__ __forceinline__ int lds_byte(int r, int c) { const int st = (r >> 4) * 2 + (c >> 5), rr = r & 15, cc = c & 31, ob = rr * 64 + cc * 2; return st * 1024 + (ob ^ (((ob >> 9) & 1) << 5)); }
__host__ __device__ __forceinline__ void stage_rc(int b, int& R, int& C) { const int st = b / 1024, sb = b % 1024, swz = sb ^ (((sb >> 9) & 1) << 5); R = (st >> 1) * 16 + swz / 64; C = (st & 1) * 32 + (swz % 64) / 2; }
__host__ __device__ __forceinline__ int perm32(int rho) { const int n = rho >> 4, i = rho & 15; return 8 * (i >> 2) + 4 * n + (i & 3); }

struct Unit { int pm, pn, e; };
struct Gemm { const bf16_t* A; const bf16_t* Bt; int M, N, K; size_t estride; int lda; };

struct StaticOrder {
    int nM, nN, nwg, G, c;
    __host__ __device__ void init(int M, int N, int G_, int c_) { nM = M / BM; nN = N / BM; nwg = nM * nN; G = G_; c = c_; }
    __host__ __device__ bool next(int i, Unit& u) const {
        const long L = (long)i * G + c; if (L >= nwg) return false;
        int wgid = (int)L; { const int q = nwg / NXCD, r = nwg % NXCD, xcd = wgid % NXCD, off = wgid / NXCD; wgid = (xcd < r ? xcd * (q + 1) : r * (q + 1) + (xcd - r) * q) + off; }
        const int nig = WGM * nN, gid = wgid / nig, fm = gid * WGM, gsz = (nM - fm) < WGM ? (nM - fm) : WGM;
        u.pm = fm + ((wgid % nig) % gsz); u.pn = (wgid % nig) / gsz; u.e = 0; return true;
    }
    __device__ __forceinline__ void a_ready(const Unit&) const {}
    __device__ __forceinline__ void done(const Unit&) const {}
};
struct MoeOrder {
    StaticOrder so; int pend[8];
    __device__ __forceinline__ bool next(int i, Unit& u) const {
        if (!so.next(i, u)) return false;
        int e = 0;
#pragma unroll
        for (int j = 0; j < 7; ++j) e += (u.pm >= pend[j]) ? 1 : 0;
        u.e = e; return true;
    }
    __device__ __forceinline__ void a_ready(const Unit&) const {}
    __device__ __forceinline__ void done(const Unit&) const {}
};

__device__ __forceinline__ unsigned cvt_pk_bf16(float lo, float hi) { unsigned r; asm volatile("v_cvt_pk_bf16_f32 %0, %1, %2" : "=v"(r) : "v"(lo), "v"(hi)); return r; }

constexpr int SSW = 4;
__device__ __forceinline__ float rstd_of(const float* ss, int row) {
    const f32x4 a = *(const f32x4*)(ss + (size_t)row * SSW);
    return __builtin_amdgcn_rsqf(((a[0] + a[1]) + (a[2] + a[3])) * (1.0f / 1024.0f) + 1e-6f); }
__device__ __forceinline__ void row_scales8(const float* ss, int row0, float (&rs)[8]) {
    f32x4 t[8];
#pragma unroll
    for (int i = 0; i < 8; ++i) t[i] = *(const f32x4*)(ss + (size_t)(row0 + (i >> 2) * HALF + (i & 3) * 16) * SSW);
#pragma unroll
    for (int i = 0; i < 8; ++i) rs[i] = __builtin_amdgcn_rsqf(((t[i][0] + t[i][1]) + (t[i][2] + t[i][3])) * (1.0f / 1024.0f) + 1e-6f);
}
constexpr int PRE_OFF = 131072 + 9216, PRE_SLOT = 4096;
__device__ __forceinline__ void row_scales8_pre(const PG8_LAS float* pre, int mode, int rl0, float (&rs)[8]) {
    if (mode == 1) {
#pragma unroll
        for (int i = 0; i < 8; ++i) { const f32x4 t = *(const PG8_LAS f32x4*)(pre + (rl0 + (i >> 2) * HALF + (i & 3) * 16) * 4); rs[i] = __builtin_amdgcn_rsqf(((t[0] + t[1]) + (t[2] + t[3])) * (1.0f / 1024.0f) + 1e-6f); }
    } else if (mode == 2) {
#pragma unroll
        for (int i = 0; i < 8; ++i) rs[i] = pre[rl0 + (i >> 2) * HALF + (i & 3) * 16];
    } else {
#pragma unroll
        for (int i = 0; i < 8; ++i) rs[i] = 1.0f; }
}
__device__ __forceinline__ float bflo(unsigned w) { return __builtin_bit_cast(float, w << 16); }
__device__ __forceinline__ float bfhi(unsigned w) { return __builtin_bit_cast(float, w & 0xffff0000u); }
struct EpiBf16 {
    static constexpr bool PERM = true, AFTER_DRAIN = false;
    bf16_t* O; int ldc; const float* ss; float cin;
    __device__ __forceinline__ int pre_desc(const Unit& u, const char*& src) const { src = (const char*)(ss + (size_t)u.pm * BM * SSW); return ss ? 1 : 0; }
    __device__ __forceinline__ void operator()(const f32x4 (&acc)[2][2][4][2], const Unit& u, int wr, int wc, int fr, int fq, const PG8_LAS float* pre) const {
        const int row0 = u.pm * BM + wr * 64 + fr, col0 = u.pn * BM + wc * 32 + 8 * fq;
        float rs8[8];
        row_scales8_pre(pre, ss ? 1 : 0, wr * 64 + fr, rs8);
#pragma unroll
        for (int i = 0; i < 8; ++i) rs8[i] *= cin;
#pragma unroll
        for (int ai = 0; ai < 2; ++ai)
#pragma unroll
            for (int m = 0; m < 4; ++m) { const int row = row0 + ai * HALF + m * 16; bf16_t* rowp = O + (size_t)row * ldc + col0; const float rs = rs8[ai * 4 + m];
#pragma unroll
                for (int bj = 0; bj < 2; ++bj) { const f32x4 v0 = acc[ai][bj][m][0] * rs, v1 = acc[ai][bj][m][1] * rs;
                    u32x4 w; w.x = cvt_pk_bf16(v0[0], v0[1]); w.y = cvt_pk_bf16(v0[2], v0[3]); w.z = cvt_pk_bf16(v1[0], v1[1]); w.w = cvt_pk_bf16(v1[2], v1[3]);
                    *(u32x4*)(rowp + bj * HALF) = w; } }
    }
};
struct EpiLat {
    static constexpr bool PERM = true, AFTER_DRAIN = false;
    bf16_t* O; const float* ss; float* ssq; float* sskv; PG8_LAS float* tab;
    __device__ __forceinline__ int pre_desc(const Unit& u, const char*& src) const { src = (const char*)(ss + (size_t)u.pm * BM * SSW); return 1; }
    __device__ __forceinline__ void operator()(const f32x4 (&acc)[2][2][4][2], const Unit& u, int wr, int wc, int fr, int fq, const PG8_LAS float* pre) const {
        const int row0 = u.pm * BM + wr * 64 + fr, col0 = u.pn * BM + wc * 32 + 8 * fq;
        float rs8[8];
        row_scales8_pre(pre, 1, wr * 64 + fr, rs8);
#pragma unroll
        for (int ai = 0; ai < 2; ++ai)
#pragma unroll
            for (int m = 0; m < 4; ++m) { const int row = row0 + ai * HALF + m * 16; bf16_t* rowp = O + (size_t)row * 768 + col0; const float rs = rs8[ai * 4 + m]; float part[2];
#pragma unroll
                for (int bj = 0; bj < 2; ++bj) { const f32x4 v0 = acc[ai][bj][m][0] * rs, v1 = acc[ai][bj][m][1] * rs;
                    u32x4 w; w.x = cvt_pk_bf16(v0[0], v0[1]); w.y = cvt_pk_bf16(v0[2], v0[3]); w.z = cvt_pk_bf16(v1[0], v1[1]); w.w = cvt_pk_bf16(v1[2], v1[3]);
                    *(u32x4*)(rowp + bj * HALF) = w;
                    part[bj] = (bflo(w.x) * bflo(w.x) + bfhi(w.x) * bfhi(w.x)) + (bflo(w.y) * bflo(w.y) + bfhi(w.y) * bfhi(w.y)) + (bflo(w.z) * bflo(w.z) + bfhi(w.z) * bfhi(w.z)) + (bflo(w.w) * bflo(w.w) + bfhi(w.w) * bfhi(w.w)); }
#pragma unroll
                for (int bj = 0; bj < 2; ++bj) { part[bj] += __shfl_xor(part[bj], 16); part[bj] += __shfl_xor(part[bj], 32); }
                if (fq == 0) { PG8_LAS float* t = tab + (ai * HALF + wr * 64 + m * 16 + fr) * 8 + wc; t[0] = part[0]; t[4] = part[1]; } }
        asm volatile("s_waitcnt lgkmcnt(0)" ::: "memory"); __builtin_amdgcn_s_barrier(); asm volatile("" ::: "memory");
        { const int t = wr * 256 + wc * 64 + fq * 16 + fr;
          if (t < 256) { const f32x4 q0 = *(const PG8_LAS f32x4*)(tab + t * 8), q1 = *(const PG8_LAS f32x4*)(tab + t * 8 + 4);
              const float p0 = (q0[0] + q0[1]) + (q0[2] + q0[3]), p1 = (q1[0] + q1[1]) + (q1[2] + q1[3]); const size_t o = (size_t)(u.pm * BM + t) * SSW;
              const float cq = 1024.0f / 384.0f, ckv = 4.0f;
              if (u.pn == 0) { ssq[o] = (p0 + p1) * cq; ssq[o + 2] = 0.f; ssq[o + 3] = 0.f; }
              else if (u.pn == 1) { ssq[o + 1] = p0 * cq; sskv[o] = p1 * ckv; sskv[o + 2] = 0.f; sskv[o + 3] = 0.f; }
              else { sskv[o + 1] = p0 * ckv; } } }
    }
};
__device__ __forceinline__ float silu_mul(float g, float u) { return g * u * __builtin_amdgcn_rcpf(1.0f + __builtin_amdgcn_exp2f(-1.4426950408889634f * g)); }
__device__ __forceinline__ f32x4 swiglu4(const f32x4 a, const f32x4 b, float kx, float kk) {
    const f32x4 t = a * kx; f32x4 r;
#pragma unroll
    for (int i = 0; i < 4; ++i) r[i] = __builtin_amdgcn_rcpf(1.0f + __builtin_amdgcn_exp2f(t[i]));
    return ((a * b) * r) * kk;
}
struct EpiSwiglu {
    static constexpr bool PERM = true, AFTER_DRAIN = false;
    bf16_t* O; int ldc; const float* ss;
    __device__ __forceinline__ int pre_desc(const Unit& u, const char*& src) const { src = (const char*)(ss + (size_t)u.pm * BM * SSW); return ss ? 1 : 0; }
    __device__ __forceinline__ void operator()(const f32x4 (&acc)[2][2][4][2], const Unit& u, int wr, int wc, int fr, int fq, const PG8_LAS float* pre) const {
        const int row0 = u.pm * BM + wr * 64 + fr, col0 = u.pn * HALF + wc * 32 + 8 * fq;
        float rs8[8];
        row_scales8_pre(pre, ss ? 1 : 0, wr * 64 + fr, rs8);
#pragma unroll
        for (int ai = 0; ai < 2; ++ai)
#pragma unroll
            for (int m = 0; m < 4; ++m) { const int row = row0 + ai * HALF + m * 16; bf16_t* rowp = O + (size_t)row * ldc + col0; const float rs = rs8[ai * 4 + m];
                const float kx = -1.4426950408889634f * rs, kk = rs * rs;
                const f32x4 s0 = swiglu4(acc[ai][0][m][0], acc[ai][1][m][0], kx, kk), s1 = swiglu4(acc[ai][0][m][1], acc[ai][1][m][1], kx, kk);
                u32x4 w; w.x = cvt_pk_bf16(s0[0], s0[1]); w.y = cvt_pk_bf16(s0[2], s0[3]); w.z = cvt_pk_bf16(s1[0], s1[1]); w.w = cvt_pk_bf16(s1[2], s1[3]);
                *(u32x4*)rowp = w; }
    }
};
__device__ __forceinline__ float clamp448(float x) { return __builtin_fminf(__builtin_fmaxf(x, -448.0f), 448.0f); }
__device__ __forceinline__ unsigned pk4_fp8(float a, float b, float c, float d) {
    int w = 0; w = __builtin_amdgcn_cvt_pk_fp8_f32(clamp448(a), clamp448(b), w, false); w = __builtin_amdgcn_cvt_pk_fp8_f32(clamp448(c), clamp448(d), w, true); return (unsigned)w; }
struct EpiSwigluF8 {
    static constexpr bool PERM = true, AFTER_DRAIN = false;
    unsigned char* O; int ldc; float cin, so; const float* rs; const float* ssp;
    __device__ __forceinline__ int pre_desc(const Unit& u, const char*& src) const { src = ssp ? (const char*)(ssp + (size_t)u.pm * BM * SSW) : (const char*)(rs + (size_t)u.pm * BM); return ssp ? 1 : (rs ? 2 : 0); }
    __device__ __forceinline__ void operator()(const f32x4 (&acc)[2][2][4][2], const Unit& u, int wr, int wc, int fr, int fq, const PG8_LAS float* pre) const {
        const int row0 = u.pm * BM + wr * 64 + fr, col0 = u.pn * HALF + wc * 32 + 16 * (fq >> 1);
        float cr[8];
        row_scales8_pre(pre, ssp ? 1 : (rs ? 2 : 0), wr * 64 + fr, cr);
#pragma unroll
        for (int i = 0; i < 8; ++i) cr[i] *= cin;
#pragma unroll
        for (int ai = 0; ai < 2; ++ai)
#pragma unroll
            for (int mp = 0; mp < 2; ++mp) { unsigned lo[2], hi[2];
#pragma unroll
                for (int q = 0; q < 2; ++q) { const int m = 2 * mp + q; const float c = cr[ai * 4 + m];
                    const float kx = -1.4426950408889634f * c, kk = c * c * so;
                    const f32x4 s0 = swiglu4(acc[ai][0][m][0], acc[ai][1][m][0], kx, kk), s1 = swiglu4(acc[ai][0][m][1], acc[ai][1][m][1], kx, kk);
                    lo[q] = pk4_fp8(s0[0], s0[1], s0[2], s0[3]); hi[q] = pk4_fp8(s1[0], s1[1], s1[2], s1[3]); }
                const auto s0 = __builtin_amdgcn_permlane16_swap(lo[0], lo[1], false, false); const auto s1 = __builtin_amdgcn_permlane16_swap(hi[0], hi[1], false, false);
                u32x4 w; w.x = s0[0]; w.y = s1[0]; w.z = s0[1]; w.w = s1[1];
                const int row = row0 + ai * HALF + (2 * mp + (fq & 1)) * 16;
                *(u32x4*)(O + (size_t)row * ldc + col0) = w; }
    }
};
struct EpiResid {
    static constexpr bool PERM = false, AFTER_DRAIN = false;
    const float* base; float* out; int ldc; float cin;
    __device__ __forceinline__ void operator()(const f32x4 (&acc)[2][2][4][2], const Unit& u, int wr, int wc, int fr, int fq) const {
        const int row0 = u.pm * BM + wr * 64 + fr, col0 = u.pn * BM + wc * 32 + 4 * fq;
#pragma unroll
        for (int ai = 0; ai < 2; ++ai)
#pragma unroll
            for (int m = 0; m < 4; ++m) { const size_t off = (size_t)(row0 + ai * HALF + m * 16) * ldc + col0;
#pragma unroll
                for (int bj = 0; bj < 2; ++bj)
#pragma unroll
                    for (int n = 0; n < 2; ++n) { const f32x4 b = *(const f32x4*)(base + off + bj * HALF + n * 16); *(f32x4*)(out + off + bj * HALF + n * 16) = b + acc[ai][bj][m][n] * cin; } }
    }
};
template <bool COPY8> struct EpiResidBT {
    static constexpr bool PERM = true, AFTER_DRAIN = false;
    bf16_t* x; int ldc; float cin; float* ssq; PG8_LAS float* tab; unsigned char* x8; float s8;
    __device__ __forceinline__ int pre_desc(const Unit&, const char*& src) const { src = nullptr; return 0; }
    __device__ __forceinline__ void operator()(const f32x4 (&acc)[2][2][4][2], const Unit& u, int wr, int wc, int fr, int fq, const PG8_LAS float*) const {
        const int row0 = u.pm * BM + wr * 64 + fr, col0 = u.pn * BM + wc * 32 + 8 * fq;
#pragma unroll
        for (int ai = 0; ai < 2; ++ai) { u32x4 b[4][2];
#pragma unroll
            for (int m = 0; m < 4; ++m)
#pragma unroll
                for (int bj = 0; bj < 2; ++bj) b[m][bj] = *(const u32x4*)(x + (size_t)(row0 + ai * HALF + m * 16) * ldc + col0 + bj * HALF);
#pragma unroll
            for (int m = 0; m < 4; ++m) { const int row = row0 + ai * HALF + m * 16; bf16_t* rowp = x + (size_t)row * ldc + col0; float part = 0.f;
#pragma unroll
                for (int bj = 0; bj < 2; ++bj) { const u32x4 bb = b[m][bj]; const f32x4 a0 = acc[ai][bj][m][0], a1 = acc[ai][bj][m][1];
                    const float y0 = __builtin_fmaf(a0[0], cin, bflo(bb.x)), y1 = __builtin_fmaf(a0[1], cin, bfhi(bb.x)), y2 = __builtin_fmaf(a0[2], cin, bflo(bb.y)), y3 = __builtin_fmaf(a0[3], cin, bfhi(bb.y));
                    const float y4 = __builtin_fmaf(a1[0], cin, bflo(bb.z)), y5 = __builtin_fmaf(a1[1], cin, bfhi(bb.z)), y6 = __builtin_fmaf(a1[2], cin, bflo(bb.w)), y7 = __builtin_fmaf(a1[3], cin, bfhi(bb.w));
                    u32x4 w; w.x = cvt_pk_bf16(y0, y1); w.y = cvt_pk_bf16(y2, y3); w.z = cvt_pk_bf16(y4, y5); w.w = cvt_pk_bf16(y6, y7);
                    *(u32x4*)(rowp + bj * HALF) = w;
                    if (COPY8) { const unsigned lo8 = pk4_fp8(y0 * s8, y1 * s8, y2 * s8, y3 * s8), hi8 = pk4_fp8(y4 * s8, y5 * s8, y6 * s8, y7 * s8);
                        *(unsigned long long*)(x8 + (size_t)row * ldc + col0 + bj * HALF) = (unsigned long long)lo8 | ((unsigned long long)hi8 << 32); }
                    part += (y0 * y0 + y1 * y1) + (y2 * y2 + y3 * y3) + (y4 * y4 + y5 * y5) + (y6 * y6 + y7 * y7); }
                part += __shfl_xor(part, 16); part += __shfl_xor(part, 32);
                if (fq == 0) tab[(ai * HALF + wr * 64 + m * 16 + fr) * 4 + wc] = part; } }
        asm volatile("s_waitcnt lgkmcnt(0)" ::: "memory"); __builtin_amdgcn_s_barrier(); asm volatile("" ::: "memory");
        { const int t = wr * 256 + wc * 64 + fq * 16 + fr;
          if (t < 256) { const f32x4 q = *(const PG8_LAS f32x4*)(tab + t * 4); ssq[(size_t)(u.pm * BM + t) * SSW + u.pn] = (q[0] + q[1]) + (q[2] + q[3]); } }
    }
};
typedef EpiResidBT<false> EpiResidB; typedef EpiResidBT<true> EpiResidB8;
struct EpiMoeDown {
    static constexpr bool PERM = true, AFTER_DRAIN = false;
    bf16_t* O; int ldc; const float* gate; float cin;
    __device__ __forceinline__ int pre_desc(const Unit& u, const char*& src) const { src = (const char*)(gate + (size_t)u.pm * BM); return 2; }
    __device__ __forceinline__ void operator()(const f32x4 (&acc)[2][2][4][2], const Unit& u, int wr, int wc, int fr, int fq, const PG8_LAS float* pre) const {
        const int row0 = u.pm * BM + wr * 64 + fr, col0 = u.pn * BM + wc * 32 + 8 * fq;
#pragma unroll
        for (int ai = 0; ai < 2; ++ai)
#pragma unroll
            for (int m = 0; m < 4; ++m) { const int row = row0 + ai * HALF + m * 16; const float gt = pre[wr * 64 + fr + ai * HALF + m * 16] * cin; bf16_t* rowp = O + (size_t)row * ldc + col0;
#pragma unroll
                for (int bj = 0; bj < 2; ++bj) { const f32x4 v0 = acc[ai][bj][m][0] * gt, v1 = acc[ai][bj][m][1] * gt;
                    u32x4 w; w.x = cvt_pk_bf16(v0[0], v0[1]); w.y = cvt_pk_bf16(v0[2], v0[3]); w.z = cvt_pk_bf16(v1[0], v1[1]); w.w = cvt_pk_bf16(v1[2], v1[3]);
                    *(u32x4*)(rowp + bj * HALF) = w; } }
    }
};
struct EpiRope {
    static constexpr bool PERM = true, AFTER_DRAIN = false;
    bf16_t* O; int ldc; const float* tab; int rope_pn0, seq;
    __device__ __forceinline__ void operator()(const f32x4 (&acc)[2][2][4][2], const Unit& u, int wr, int wc, int fr, int fq) const {
        const int row0 = u.pm * BM + wr * 64 + fr, col0 = u.pn * BM + wc * 32 + 8 * fq;
        if (u.pn < rope_pn0) {
#pragma unroll
            for (int ai = 0; ai < 2; ++ai)
#pragma unroll
                for (int m = 0; m < 4; ++m) { bf16_t* rowp = O + (size_t)(row0 + ai * HALF + m * 16) * ldc + col0;
#pragma unroll
                    for (int bj = 0; bj < 2; ++bj) { const f32x4 v0 = acc[ai][bj][m][0], v1 = acc[ai][bj][m][1];
                        u32x4 w; w.x = cvt_pk_bf16(v0[0], v0[1]); w.y = cvt_pk_bf16(v0[2], v0[3]); w.z = cvt_pk_bf16(v1[0], v1[1]); w.w = cvt_pk_bf16(v1[2], v1[3]);
                        *(u32x4*)(rowp + bj * HALF) = w; } }
        } else {
#pragma unroll
            for (int ai = 0; ai < 2; ++ai)
#pragma unroll
                for (int m = 0; m < 4; ++m) { const int row = row0 + ai * HALF + m * 16; bf16_t* rowp = O + (size_t)row * ldc + col0;
                    const float* t = tab + (size_t)(row % seq) * 32 + 8 * fq; const f32x4 c0 = *(const f32x4*)t, c1 = *(const f32x4*)(t + 4);
#pragma unroll
                    for (int bj = 0; bj < 2; ++bj) { const f32x4 v0 = acc[ai][bj][m][0], v1 = acc[ai][bj][m][1];
                        u32x4 w; w.x = cvt_pk_bf16(v0[0] * c0[0] - v0[1] * c0[1], v0[0] * c0[1] + v0[1] * c0[0]); w.y = cvt_pk_bf16(v0[2] * c0[2] - v0[3] * c0[3], v0[2] * c0[3] + v0[3] * c0[2]);
                        w.z = cvt_pk_bf16(v1[0] * c1[0] - v1[1] * c1[1], v1[0] * c1[1] + v1[1] * c1[0]); w.w = cvt_pk_bf16(v1[2] * c1[2] - v1[3] * c1[3], v1[2] * c1[3] + v1[3] * c1[2]);
                        *(u32x4*)(rowp + bj * HALF) = w; }
                    asm volatile("" ::: "memory"); }
        }
    }
};

typedef int v4i_t __attribute__((ext_vector_type(4)));
typedef int v8i_t __attribute__((ext_vector_type(8)));
template <bool FP8> __device__ __forceinline__ void mma_block(f32x4 (&acc)[4][2], const bf16x8 (&At)[4][2], const bf16x8 (&Bt)[2][2]) {
    __builtin_amdgcn_s_setprio(1);
#pragma unroll
    for (int m = 0; m < 4; ++m)
#pragma unroll
        for (int n = 0; n < 2; ++n) {
            if constexpr (FP8) {
                const v8i_t b = __builtin_shufflevector(__builtin_bit_cast(v4i_t, Bt[n][0]), __builtin_bit_cast(v4i_t, Bt[n][1]), 0, 1, 2, 3, 4, 5, 6, 7);
                const v8i_t a = __builtin_shufflevector(__builtin_bit_cast(v4i_t, At[m][0]), __builtin_bit_cast(v4i_t, At[m][1]), 0, 1, 2, 3, 4, 5, 6, 7);
                asm volatile("v_mfma_f32_16x16x128_f8f6f4 %0, %1, %2, %0" : "+v"(acc[m][n]) : "v"(b), "v"(a));
            } else {
#pragma unroll
                for (int k = 0; k < 2; ++k) acc[m][n] = __builtin_amdgcn_mfma_f32_16x16x32_bf16(Bt[n][k], At[m][k], acc[m][n], 0, 0, 0);
            }
        }
    __builtin_amdgcn_s_setprio(0);
}
typedef double f64x2_t __attribute__((ext_vector_type(2)));
__device__ __forceinline__ f32x4 zero4() { double a, b; asm volatile("v_mov_b64 %0, 0" : "=v"(a)); asm volatile("v_mov_b64 %0, 0" : "=v"(b)); const f64x2_t d = {a, b}; return __builtin_bit_cast(f32x4, d); }
template <class Epi, class Sched, bool ALIGN_EPI = false, bool SP2 = false, bool FP8 = false>
__device__ __forceinline__ void gemm_phase(PG8_LAS unsigned char* lds, const Gemm g, const Sched& S, const Epi& E) {
    const int tid = threadIdx.x, wid = __builtin_amdgcn_readfirstlane(tid >> 6), lane = tid & 63, wr = wid >> 2, wc = wid & 3, fr = lane & 15, fq = lane >> 4;
    const int K = g.K, nt = K / BK, lda = g.lda ? g.lda : K;
    unsigned voffA[2], voffB[2];
#pragma unroll
    for (int i = 0; i < 2; ++i) { int R, C; stage_rc(tid * 16 + i * 8192, R, C); const int Rb = Epi::PERM ? ((R & ~31) + perm32(R & 31)) : R;
        voffA[i] = (unsigned)(R * lda + C) * 2u; voffB[i] = (unsigned)(Rb * K + C) * 2u; }
    const size_t kstep = (size_t)(BK * 2);
    const size_t hstep = (size_t)HALF * K * 2;
    const size_t tstep = 2 * hstep;
    const size_t hstepA = (size_t)HALF * lda * 2, tstepA = 2 * hstepA;
    const unsigned ldsw = (unsigned)wid * 1024u;
    const int aoff = lds_byte(wr * 64 + fr, fq * 8), boff = lds_byte(wc * 32 + fr, fq * 8);
#define PG8_SA(b, h) (((b) * 2 + (h)) * HTB)
#define PG8_SB(b, h) ((4 + (b) * 2 + (h)) * HTB)
#define PG8_STAGE(bufoff, gbase, voff) do { _Pragma("unroll") for (int _i = 0; _i < 2; ++_i) \
        __builtin_amdgcn_global_load_lds((const unsigned*)((const char*)(gbase) + (voff)[_i]), (PG8_LAS unsigned*)(lds + (bufoff) + ldsw + _i * 8192), 16, 0, 0); } while (0)
#define PG8_LDA(dst, b, h) do { _Pragma("unroll") for (int m = 0; m < 4; ++m) _Pragma("unroll") for (int k = 0; k < 2; ++k) dst[m][k] = *(const PG8_LAS bf16x8*)(lds + PG8_SA(b, h) + aoff + m * 2048 + k * 1024); } while (0)
#define PG8_LDB(dst, b, h) do { _Pragma("unroll") for (int n = 0; n < 2; ++n) _Pragma("unroll") for (int k = 0; k < 2; ++k) dst[n][k] = *(const PG8_LAS bf16x8*)(lds + PG8_SB(b, h) + boff + n * 2048 + k * 1024); } while (0)
#define PG8_MMA(ai, bj, At, Bt) mma_block<FP8>(acc[ai][bj], At, Bt)
#define PG8_WAIT_V(n) asm volatile("s_waitcnt vmcnt(" #n ")" ::: "memory")
#define PG8_WAIT_L(n) asm volatile("s_waitcnt lgkmcnt(" #n ")" ::: "memory")
#define PG8_BAR __builtin_amdgcn_s_barrier()
#define PG8_SCHED __builtin_amdgcn_sched_barrier(0)
    Unit cur, nxt; int ui = 0;
    if (!S.next(0, cur)) return;
    f32x4 acc[2][2][4][2];
#pragma unroll
    for (int a = 0; a < 2; ++a)
#pragma unroll
        for (int b = 0; b < 2; ++b)
#pragma unroll
            for (int m = 0; m < 4; ++m)
#pragma unroll
                for (int n = 0; n < 2; ++n) acc[a][b][m][n] = zero4();
    bf16x8 At[4][2], B0[2][2], B1[2][2];
    const char* cA = (const char*)g.A + (size_t)cur.pm * tstepA; const char* cB = (const char*)g.Bt + (size_t)cur.e * g.estride + (size_t)cur.pn * tstep;
    S.a_ready(cur);
#define PG8_PRE(unit_, slot_) do { const char* src_; const int md_ = E.pre_desc(unit_, src_); \
        if (md_ == 1) { if (wid < 4) __builtin_amdgcn_global_load_lds((const unsigned*)(src_ + (size_t)(wid * 64 + lane) * 16), (PG8_LAS unsigned*)(lds + PRE_OFF + (slot_) * PRE_SLOT + wid * 1024), 16, 0, 0); } \
        else if (md_ == 2) { if (wid == 0) __builtin_amdgcn_global_load_lds((const unsigned*)(src_ + (size_t)lane * 16), (PG8_LAS unsigned*)(lds + PRE_OFF + (slot_) * PRE_SLOT), 16, 0, 0); } } while (0)
    PG8_PRE(cur, 0);
    if constexpr (SP2) {
        PG8_STAGE(PG8_SB(0, 0), cB, voffB); PG8_STAGE(PG8_SB(0, 1), cB + hstep, voffB); PG8_STAGE(PG8_SA(0, 0), cA, voffA); PG8_STAGE(PG8_SA(0, 1), cA + hstepA, voffA);
        PG8_STAGE(PG8_SB(1, 0), cB + kstep, voffB); PG8_STAGE(PG8_SA(1, 0), cA + kstep, voffA); PG8_STAGE(PG8_SB(1, 1), cB + hstep + kstep, voffB);
        if (wr == 1) PG8_BAR;
        PG8_WAIT_V(8); PG8_BAR;
        PG8_WAIT_V(6); PG8_BAR;
    } else {
        PG8_STAGE(PG8_SB(0, 0), cB, voffB); PG8_STAGE(PG8_SA(0, 0), cA, voffA); PG8_STAGE(PG8_SB(0, 1), cB + hstep, voffB); PG8_STAGE(PG8_SA(0, 1), cA + hstepA, voffA);
        if (wr == 1) PG8_BAR;
        PG8_WAIT_V(4); PG8_BAR;
        PG8_STAGE(PG8_SB(1, 0), cB + kstep, voffB); PG8_STAGE(PG8_SA(1, 0), cA + kstep, voffA); PG8_STAGE(PG8_SB(1, 1), cB + hstep + kstep, voffB);
        PG8_WAIT_V(6); PG8_BAR;
    }
    for (;;) {
        const bool has_next = S.next(ui + 1, nxt);
        const char* nA = has_next ? (const char*)g.A + (size_t)nxt.pm * tstepA : cA; const char* nB = has_next ? (const char*)g.Bt + (size_t)nxt.e * g.estride + (size_t)nxt.pn * tstep : cB;
#pragma nounroll
        for (int t = 0; t < nt; t += 2) {
            const bool last = (t == nt - 2);
            const char* a1 = cA + (size_t)(t + 1) * kstep;
            const char* a2 = last ? nA : cA + (size_t)(t + 2) * kstep; const char* b2 = last ? nB : cB + (size_t)(t + 2) * kstep;
            const char* a3 = a2 + kstep; const char* b3 = b2 + kstep;
            if (last && has_next) S.a_ready(nxt);
            if constexpr (SP2) {
            PG8_LDB(B0, 0, 0); PG8_LDB(B1, 0, 1); PG8_SCHED; PG8_LDA(At, 0, 0); PG8_STAGE(PG8_SA(1, 1), a1 + hstepA, voffA);
            PG8_WAIT_V(8); PG8_WAIT_L(0); PG8_BAR; PG8_MMA(0, 0, At, B0); PG8_MMA(0, 1, At, B1); PG8_BAR; PG8_SCHED;
            PG8_LDA(At, 0, 1); PG8_STAGE(PG8_SB(0, 0), b2, voffB); PG8_STAGE(PG8_SB(0, 1), b2 + hstep, voffB); PG8_STAGE(PG8_SA(0, 0), a2, voffA);
            PG8_WAIT_V(8); PG8_WAIT_L(0); PG8_BAR; PG8_MMA(1, 0, At, B0); PG8_MMA(1, 1, At, B1); PG8_BAR; PG8_SCHED;
            PG8_LDB(B0, 1, 0); PG8_LDB(B1, 1, 1); PG8_SCHED; PG8_LDA(At, 1, 0); PG8_STAGE(PG8_SA(0, 1), a2 + hstepA, voffA);
            PG8_WAIT_V(8); PG8_WAIT_L(0); PG8_BAR; PG8_MMA(0, 0, At, B0); PG8_MMA(0, 1, At, B1); PG8_BAR; PG8_SCHED;
            PG8_LDA(At, 1, 1); PG8_STAGE(PG8_SB(1, 0), b3, voffB); PG8_STAGE(PG8_SB(1, 1), b3 + hstep, voffB); PG8_STAGE(PG8_SA(1, 0), a3, voffA);
            PG8_WAIT_V(8); PG8_WAIT_L(0); PG8_BAR; PG8_MMA(1, 0, At, B0); PG8_MMA(1, 1, At, B1); PG8_BAR; PG8_SCHED;
            } else {
            PG8_LDB(B0, 0, 0); PG8_SCHED; PG8_LDA(At, 0, 0); PG8_STAGE(PG8_SA(1, 1), a1 + hstepA, voffA);
            PG8_WAIT_L(8); PG8_BAR; PG8_WAIT_L(0); PG8_MMA(0, 0, At, B0); PG8_BAR; PG8_SCHED;
            PG8_LDB(B1, 0, 1); PG8_STAGE(PG8_SB(0, 0), b2, voffB);
            PG8_BAR; PG8_WAIT_L(0); PG8_MMA(0, 1, At, B1); PG8_BAR;
            PG8_LDA(At, 0, 1); PG8_STAGE(PG8_SA(0, 0), a2, voffA);
            PG8_BAR; PG8_WAIT_L(0); PG8_MMA(1, 0, At, B0); PG8_BAR; PG8_SCHED;
            PG8_STAGE(PG8_SB(0, 1), b2 + hstep, voffB);
            PG8_WAIT_V(6); PG8_BAR; PG8_MMA(1, 1, At, B1); PG8_BAR;
            PG8_LDB(B0, 1, 0); PG8_SCHED; PG8_LDA(At, 1, 0); PG8_STAGE(PG8_SA(0, 1), a2 + hstepA, voffA);
            PG8_WAIT_L(8); PG8_BAR; PG8_WAIT_L(0); PG8_MMA(0, 0, At, B0); PG8_BAR; PG8_SCHED;
            PG8_LDB(B1, 1, 1); PG8_STAGE(PG8_SB(1, 0), b3, voffB);
            PG8_BAR; PG8_WAIT_L(0); PG8_MMA(0, 1, At, B1); PG8_BAR;
            PG8_LDA(At, 1, 1); PG8_STAGE(PG8_SA(1, 0), a3, voffA);
            PG8_BAR; PG8_WAIT_L(0); PG8_MMA(1, 0, At, B0); PG8_BAR; PG8_SCHED;
            PG8_STAGE(PG8_SB(1, 1), b3 + hstep, voffB);
            PG8_WAIT_V(6); PG8_BAR; PG8_MMA(1, 1, At, B1); PG8_BAR;
            }
        }
        if constexpr (ALIGN_EPI) { if (wr == 0) PG8_BAR; }
        if constexpr (FP8) {
#pragma unroll
            for (int a = 0; a < 2; ++a)
#pragma unroll
                for (int b = 0; b < 2; ++b) asm volatile("s_nop 15\n\ts_nop 15" : "+v"(acc[a][b][0][0]), "+v"(acc[a][b][0][1]), "+v"(acc[a][b][1][0]), "+v"(acc[a][b][1][1]), "+v"(acc[a][b][2][0]), "+v"(acc[a][b][2][1]), "+v"(acc[a][b][3][0]), "+v"(acc[a][b][3][1]));
        }
        if constexpr (!Epi::AFTER_DRAIN) { if (has_next) PG8_PRE(nxt, (ui + 1) & 1);
            E(acc, cur, wr, wc, fr, fq, (const PG8_LAS float*)(lds + PRE_OFF + (ui & 1) * PRE_SLOT)); S.done(cur); }
        if (!has_next) break;
#pragma unroll
        for (int a = 0; a < 2; ++a)
#pragma unroll
            for (int b = 0; b < 2; ++b)
#pragma unroll
                for (int m = 0; m < 4; ++m)
#pragma unroll
                    for (int n = 0; n < 2; ++n) acc[a][b][m][n] = zero4();
        cur = nxt; cA = nA; cB = nB; ++ui;
        if constexpr (ALIGN_EPI) { if (wr == 1) PG8_BAR; }
    }
    PG8_WAIT_V(0);
    if constexpr (!ALIGN_EPI) { if (wr == 0) PG8_BAR; }
    PG8_BAR;
    if constexpr (Epi::AFTER_DRAIN) { E.fused(acc, cur, wr, wc, fr, fq, lds, wid, lane); S.done(cur); }
#undef PG8_PRE
#undef PG8_SA
#undef PG8_SB
#undef PG8_STAGE
#undef PG8_LDA
#undef PG8_LDB
#undef PG8_MMA
#undef PG8_WAIT_V
#undef PG8_WAIT_L
#undef PG8_BAR
#undef PG8_SCHED
}
}
#ifndef PG8_SP2
#define PG8_SP2 true
#endif
#ifndef PG8_ALIGN
#define PG8_ALIGN true
#endif

constexpr int NWAVES = 8;
constexpr int BATCH = 8, SEQ = 4096, DM = 1024, NTOK = BATCH * SEQ;
constexpr int FFD = 2816, FFE = 3584, NEXP = 8;
constexpr int NSLOT = (NTOK * 2 / 256 + NEXP) * 256;
constexpr float NORM_EPS = 1e-6f, SUBLN_EPS = 1e-5f, LOG2E = 1.4426950408889634f;
constexpr int N_IN = 41;
enum { I_X = 0, I_A_NORM, I_A_WQKV, I_A_WO, I_F0_NORM, I_F0_WG, I_F0_WU, I_F0_WD, I_B_NORM, I_B_WQKV, I_B_LQ1, I_B_LK1, I_B_LQ2, I_B_LK2, I_B_SUBLN, I_B_WO,
       I_M1_NORM, I_M1_WR, I_M1_WG, I_M1_WU, I_M1_WD, I_C_NORM, I_C_WIN, I_C_QNORM, I_C_WQUP, I_C_KVNORM, I_C_WKVUP, I_C_WO, I_F2_NORM, I_F2_WG, I_F2_WU, I_F2_WD,
       I_D_NORM, I_D_WQKV, I_D_WO, I_M3_NORM, I_M3_WR, I_M3_WG, I_M3_WU, I_M3_WD, I_FINAL_NORM };

constexpr size_t MiB = 1ull << 20, KiB = 1024;
constexpr size_t WS_CTL = 0, CTL_ZERO_BYTES = 64 * KiB;
constexpr size_t WS_ROPE = 1 * MiB;
constexpr size_t WS_WGCNT = 1 * MiB + 512 * KiB;
constexpr size_t WS_KN = 1 * MiB + 576 * KiB;
constexpr size_t WS_TOKE = 2 * MiB, WS_TOKG = WS_TOKE + 256 * KiB, WS_TOKS = WS_TOKG + 256 * KiB;
constexpr size_t WS_SGATE = 3 * MiB;
constexpr size_t WS_W = 4 * MiB;
constexpr size_t W_QKV_A = WS_W, W_O_A = WS_W + 9 * MiB, W_GU0 = WS_W + 10 * MiB, W_D0 = WS_W + 21 * MiB, W_QKV_B = WS_W + 27 * MiB, W_O_B = WS_W + 33 * MiB,
                 W_IN_C = WS_W + 35 * MiB, W_QUP_C = WS_W + 37 * MiB, W_KVUP_C = WS_W + 39 * MiB, W_O_C = WS_W + 40 * MiB, W_GU2 = WS_W + 42 * MiB, W_D2 = WS_W + 53 * MiB,
                 W_QKV_D = WS_W + 59 * MiB, W_O_D = WS_W + 65 * MiB;
constexpr size_t W_MOE_GU = 72 * MiB, W_MOE_D = 128 * MiB, W_MOE_L2 = 84 * MiB;
constexpr size_t WS_H = 240 * MiB;
constexpr size_t WS_XB = 304 * MiB;
constexpr size_t WS_BIG = 436 * MiB;
constexpr size_t WS_END = 898 * MiB;
constexpr size_t WS_XR = WS_BIG + 288 * MiB;
constexpr size_t WS_SS = WS_END, SS_BYTES = 16 * MiB;
constexpr size_t WS_SSS = WS_END + 16 * MiB;
constexpr size_t WS_GWR = 1 * MiB + 640 * KiB;
static_assert(WS_BIG + (size_t)NSLOT * FFE * 2 <= WS_END && WS_XB + (size_t)NSLOT * DM * 2 <= WS_BIG && WS_H + (size_t)NTOK * DM * 2 <= WS_XB && W_MOE_D + W_MOE_L2 + 8ull * 1024 * 3584 <= WS_H, "d_ws map");
constexpr size_t C_LAT = WS_BIG, C_Q = WS_BIG + 48 * MiB, C_KV = WS_BIG + 144 * MiB;
constexpr size_t C_QN = WS_XB, C_KVN = WS_XB + 24 * MiB, C_KPE = WS_XB + 40 * MiB;
constexpr int CW_TMO = 0, CW_QB = 64, CW_BAR = 4096;

constexpr int RING_OFF = 0, RING_BYTES = 131072;
constexpr int MISC_OFF = RING_BYTES + 320;
constexpr int RESTAB_OFF = RING_BYTES + 1024;
constexpr int LDS_BYTES = 149504;
static_assert(RESTAB_OFF + 8192 <= pg8::PRE_OFF && pg8::PRE_OFF + 2 * pg8::PRE_SLOT <= LDS_BYTES, "LDS map");
#define GAS __attribute__((address_space(1)))
#define LAS __attribute__((address_space(3)))
typedef unsigned short bf16;
typedef unsigned v4u __attribute__((ext_vector_type(4)));
typedef float f32x4 __attribute__((ext_vector_type(4)));
typedef short bf16x8 __attribute__((ext_vector_type(8)));
typedef GAS unsigned gu32;
typedef GAS unsigned long long gu64;
#define RLX_AGENT __ATOMIC_RELAXED, __HIP_MEMORY_SCOPE_AGENT
#define LDS_WAIT() asm volatile("s_waitcnt lgkmcnt(0)" ::: "memory")
#define VM_WAIT() asm volatile("s_waitcnt vmcnt(0)" ::: "memory")
__device__ __forceinline__ unsigned long long rt() { return __builtin_amdgcn_s_memrealtime(); }
__device__ __forceinline__ unsigned f2bf(float f) { unsigned u = __builtin_bit_cast(unsigned, f); return (u + 0x7fffu + ((u >> 16) & 1u)) >> 16; }
__device__ __forceinline__ unsigned pk2(float lo, float hi) { return f2bf(lo) | (f2bf(hi) << 16); }

#define XB_TMO      128
#define XB_XCNT(j)  (256  + 64 * (j))
#define XB_XSUB(j)  (1280 + 64 * (j))
#define XB_XGEN(j)  (2304 + 64 * (j))
#define XB_TOP      3328
#define XB_TOPGEN   3392
#define XCD_BAR_WORDS 3456
#define XB_SPIN_CAP (1u << 18)

__device__ __forceinline__ unsigned xb_ld(unsigned* p)              { return __hip_atomic_load(p, __ATOMIC_RELAXED, __HIP_MEMORY_SCOPE_AGENT); }
__device__ __forceinline__ unsigned xb_add(unsigned* p, unsigned v) { return __hip_atomic_fetch_add(p, v, __ATOMIC_RELAXED, __HIP_MEMORY_SCOPE_AGENT); }
__device__ __forceinline__ unsigned xb_xcc_id() { return (unsigned)__builtin_amdgcn_s_getreg((3 << 11) | 20) & 0xFu; }
#define XB_SPIN(cond, bar) do { unsigned _sp = 0; while (cond) { __builtin_amdgcn_s_sleep(1); \
    if ((++_sp & 255u) == 0u) { if (xb_ld(&(bar)[XB_TMO])) break; if (_sp > XB_SPIN_CAP) { atomicAdd(&(bar)[XB_TMO], 1u); break; } } } } while (0)

struct XcdBarrier {
    unsigned* bar; unsigned x;
    volatile LAS unsigned* st;
};

__device__ __forceinline__ XcdBarrier xcd_barrier_post(unsigned* bar, volatile LAS unsigned* st) {
    XcdBarrier b; b.bar = bar; b.x = xb_xcc_id(); b.st = st;
    if (threadIdx.x == 0) (void)xb_add(&bar[XB_XCNT(b.x)], 1u);
    return b;
}
__device__ __forceinline__ void xcd_barrier_complete(unsigned* bar, unsigned x, unsigned& nloc, unsigned& nx) {
    const unsigned G = gridDim.x * gridDim.y * gridDim.z;
    unsigned sum, cnt, mine, sp = 0u;
    for (;;) {
        sum = 0u; cnt = 0u; mine = 0u;
#pragma unroll
        for (unsigned j = 0; j < 16; ++j) { const unsigned c = xb_ld(&bar[XB_XCNT(j)]); sum += c; cnt += (c > 0u) ? 1u : 0u; mine = (j == x) ? c : mine; }
        if (sum == G) break;
        __builtin_amdgcn_s_sleep(1);
        if ((++sp & 255u) == 0u) { if (xb_ld(&bar[XB_TMO])) break; if (sp > XB_SPIN_CAP) { atomicAdd(&bar[XB_TMO], 1u); break; } }
    }
    nloc = mine > 0u ? mine : 1u; nx = cnt > 0u ? cnt : 1u;
}

__device__ __forceinline__ void xcd_barrier(const XcdBarrier& b) {
    asm volatile("s_waitcnt vmcnt(0)" ::: "memory");
    __syncthreads();
    if (threadIdx.x == 0) {
        unsigned* bar = b.bar;
        __builtin_amdgcn_s_waitcnt(0);
        unsigned nloc = b.st[0], nx = b.st[1];
        if (nloc == 0u) { xcd_barrier_complete(bar, b.x, nloc, nx); b.st[0] = nloc; b.st[1] = nx; }
        const unsigned old = xb_add(&bar[XB_XSUB(b.x)], 1u);
        const unsigned gen = old / nloc;
        if (old + 1u == (gen + 1u) * nloc) {
            __builtin_amdgcn_fence(__ATOMIC_RELEASE, "agent");
            asm volatile("s_waitcnt vmcnt(0)" ::: "memory");
            const unsigned og = xb_add(&bar[XB_TOP], 1u);
            const unsigned tg = og / nx;
            if (og + 1u == (tg + 1u) * nx) xb_add(&bar[XB_TOPGEN], 1u);
            else XB_SPIN(xb_ld(&bar[XB_TOPGEN]) == tg, bar);
            __builtin_amdgcn_fence(__ATOMIC_ACQUIRE, "agent");
            xb_add(&bar[XB_XGEN(b.x)], 1u);
            asm volatile("s_waitcnt vmcnt(0)" ::: "memory");
        } else {
            XB_SPIN(xb_ld(&bar[XB_XGEN(b.x)]) == gen, bar);
            __builtin_amdgcn_fence(__ATOMIC_ACQUIRE, "agent");
            asm volatile("s_waitcnt vmcnt(0)" ::: "memory");
        }
    }
    __syncthreads();
}

__device__ __forceinline__ float wave_sum(float v) {
#pragma unroll
    for (int o = 1; o < 64; o <<= 1) v += __shfl_xor(v, o);
    return v;
}
__device__ __forceinline__ float bf_lo(unsigned w) { return __builtin_bit_cast(float, w << 16); }
__device__ __forceinline__ float bf_hi(unsigned w) { return __builtin_bit_cast(float, w & 0xffff0000u); }
__device__ __forceinline__ void ld8(const bf16* p, float* f) {
    const v4u w = *(const GAS v4u*)p;
    f[0] = bf_lo(w.x); f[1] = bf_hi(w.x); f[2] = bf_lo(w.y); f[3] = bf_hi(w.y); f[4] = bf_lo(w.z); f[5] = bf_hi(w.z); f[6] = bf_lo(w.w); f[7] = bf_hi(w.w);
}
__device__ __forceinline__ float ex2(float x) { return __builtin_amdgcn_exp2f(x); }

struct Frame {
    LAS unsigned char* lds;
    volatile LAS unsigned* MISC;
    gu32* ctl;
    int tid, lane, wave, G, bid;
    const float* const* in;
};

enum { MAP_ID = 0, MAP_GATE, MAP_UP, MAP_CIN, MAP_CQUP, MAP_CKVUP };
__device__ __forceinline__ int map_row(int map, int n) {
    if (map == MAP_GATE) return ((n >> 7) << 8) + (n & 127);
    if (map == MAP_UP) return ((n >> 7) << 8) + 128 + (n & 127);
    if (map == MAP_CIN) { if (n < 640) return n; const int i = n - 640; return 640 + ((i & 15) << 1) + (i >> 4); }
    if (map == MAP_CQUP) { const int h = n / 96, j = n - 96 * h; if (j < 64) return 64 * h + j; const int i = j - 64; return 1024 + 32 * h + ((i & 15) << 1) + (i >> 4); }
    if (map == MAP_CKVUP) { const int h = n >> 7, j = n & 127; return j < 64 ? 64 * h + j : 1024 + 64 * h + (j - 64); }
    return n;
}
__device__ __forceinline__ void conv_item(const float* W, int K, int N, bf16* WT, int map, int nscale, float scale, const float* gain, LAS float* scr, int item, int lane) {
    const int nblk = N / 32, kb = item / nblk, nb = item - kb * nblk, k0 = 64 * kb, n0 = 32 * nb;
#pragma unroll
    for (int i = 0; i < 8; ++i) { const int kk = 8 * i + (lane >> 3); const f32x4 w = *(const GAS f32x4*)(W + (size_t)(k0 + kk) * N + n0 + 4 * (lane & 7));
        const float gk = gain ? gain[k0 + kk] : 1.0f;
        LAS float* dd = scr + kk * 33 + 4 * (lane & 7); dd[0] = w.x * gk; dd[1] = w.y * gk; dd[2] = w.z * gk; dd[3] = w.w * gk; }
    LDS_WAIT(); asm volatile("" ::: "memory");
    const int c = lane & 7;
#pragma unroll
    for (int j = 0; j < 4; ++j) { const int n = (lane >> 3) + 8 * j; const LAS float* s = scr + (8 * c) * 33 + n; const int nn = n0 + n; const float sc = nn < nscale ? scale : 1.0f;
        v4u o; o.x = pk2(s[0 * 33] * sc, s[1 * 33] * sc); o.y = pk2(s[2 * 33] * sc, s[3 * 33] * sc); o.z = pk2(s[4 * 33] * sc, s[5 * 33] * sc); o.w = pk2(s[6 * 33] * sc, s[7 * 33] * sc);
        *(GAS v4u*)(WT + (size_t)map_row(map, nn) * K + k0 + 8 * c) = o; }
    LDS_WAIT(); asm volatile("" ::: "memory");
}
__device__ __forceinline__ void conv_matrix(const float* W, int K, int N, bf16* WT, int map, int nscale, float scale, const float* gain, LAS float* scr, int gw, int NGW, int& base, int lane) {
    const int nit = (K / 64) * (N / 32);
    int first = gw - base; if (first < 0) first += NGW;
    for (int it = first; it < nit; it += NGW) conv_item(W, K, N, WT, map, nscale, scale, gain, scr, it, lane);
    base = (base + nit) % NGW;
}
__device__ __forceinline__ void conv_item_f8(const float* W, int K, int N, unsigned char* WT, int map, float scale, const float* gain, LAS float* scr, int item, int lane) {
    const int nblk = N / 32, kb = item / nblk, nb = item - kb * nblk, k0 = 64 * kb, n0 = 32 * nb;
#pragma unroll
    for (int i = 0; i < 8; ++i) { const int kk = 8 * i + (lane >> 3); const f32x4 w = *(const GAS f32x4*)(W + (size_t)(k0 + kk) * N + n0 + 4 * (lane & 7));
        const float gk = gain ? gain[k0 + kk] : 1.0f;
        LAS float* dd = scr + kk * 33 + 4 * (lane & 7); dd[0] = w.x * gk; dd[1] = w.y * gk; dd[2] = w.z * gk; dd[3] = w.w * gk; }
    LDS_WAIT(); asm volatile("" ::: "memory");
    const int c = lane & 3;
#pragma unroll
    for (int j = 0; j < 2; ++j) { const int n = (lane >> 2) + 16 * j; const LAS float* s = scr + (16 * c) * 33 + n;
        v4u o; o.x = pg8::pk4_fp8(s[0 * 33] * scale, s[1 * 33] * scale, s[2 * 33] * scale, s[3 * 33] * scale); o.y = pg8::pk4_fp8(s[4 * 33] * scale, s[5 * 33] * scale, s[6 * 33] * scale, s[7 * 33] * scale);
        o.z = pg8::pk4_fp8(s[8 * 33] * scale, s[9 * 33] * scale, s[10 * 33] * scale, s[11 * 33] * scale); o.w = pg8::pk4_fp8(s[12 * 33] * scale, s[13 * 33] * scale, s[14 * 33] * scale, s[15 * 33] * scale);
        *(GAS v4u*)(WT + (size_t)map_row(map, n0 + n) * K + k0 + 16 * c) = o; }
    LDS_WAIT(); asm volatile("" ::: "memory");
}
__device__ __forceinline__ void conv_item_f8q(const float* W, int K, int N, unsigned char* WT, int map, float scale, int nscale, float qscale, const float* gain, LAS float* scr, int item, int lane) {
    const int nblk = N / 32, kb = item / nblk, nb = item - kb * nblk, k0 = 64 * kb, n0 = 32 * nb;
#pragma unroll
    for (int i = 0; i < 8; ++i) { const int kk = 8 * i + (lane >> 3); const f32x4 w = *(const GAS f32x4*)(W + (size_t)(k0 + kk) * N + n0 + 4 * (lane & 7));
        const float gk = (gain ? gain[k0 + kk] : 1.0f) * scale * ((n0 < nscale) ? qscale : 1.0f);
        LAS float* dd = scr + kk * 33 + 4 * (lane & 7); dd[0] = w.x * gk; dd[1] = w.y * gk; dd[2] = w.z * gk; dd[3] = w.w * gk; }
    LDS_WAIT(); asm volatile("" ::: "memory");
    const int c = lane & 3;
#pragma unroll
    for (int j = 0; j < 2; ++j) { const int n = (lane >> 2) + 16 * j; const LAS float* s = scr + (16 * c) * 33 + n;
        v4u o; o.x = pg8::pk4_fp8(s[0 * 33], s[1 * 33], s[2 * 33], s[3 * 33]); o.y = pg8::pk4_fp8(s[4 * 33], s[5 * 33], s[6 * 33], s[7 * 33]);
        o.z = pg8::pk4_fp8(s[8 * 33], s[9 * 33], s[10 * 33], s[11 * 33]); o.w = pg8::pk4_fp8(s[12 * 33], s[13 * 33], s[14 * 33], s[15 * 33]);
        *(GAS v4u*)(WT + (size_t)map_row(map, n0 + n) * K + k0 + 16 * c) = o; }
    LDS_WAIT(); asm volatile("" ::: "memory");
}
__device__ __forceinline__ void conv_matrix_f8q(const float* W, int K, int N, unsigned char* WT, int map, float scale, int nscale, float qscale, const float* gain, LAS float* scr, int gw, int NGW, int& base, int lane) {
    const int nit = (K / 64) * (N / 32);
    int first = gw - base; if (first < 0) first += NGW;
    for (int it = first; it < nit; it += NGW) conv_item_f8q(W, K, N, WT, map, scale, nscale, qscale, gain, scr, it, lane);
    base = (base + nit) % NGW;
}
__device__ __forceinline__ void conv_matrix_f8(const float* W, int K, int N, unsigned char* WT, int map, float scale, const float* gain, LAS float* scr, int gw, int NGW, int& base, int lane) {
    const int nit = (K / 64) * (N / 32);
    int first = gw - base; if (first < 0) first += NGW;
    for (int it = first; it < nit; it += NGW) conv_item_f8(W, K, N, WT, map, scale, gain, scr, it, lane);
    base = (base + nit) % NGW;
}
constexpr float F8_SA = 16.0f, F8_SW1 = 512.0f, F8_SACT = 8.0f, F8_SW2 = 1024.0f;
__device__ __forceinline__ void conv_moe(const float* Wg, const float* Wu, const float* Wd, const float* gain, unsigned char* wgu, unsigned char* wd, LAS float* scr, int gw, int NGW, int lane, int e_lo = 0, int e_hi = NEXP) {
    int base = 0;
    for (int e = e_lo; e < e_hi; ++e) {
        unsigned char* gu = wgu + (size_t)e * 2 * FFE * DM;
        conv_matrix_f8(Wg + (size_t)e * DM * FFE, DM, FFE, gu, MAP_GATE, F8_SW1, gain, scr, gw, NGW, base, lane);
        conv_matrix_f8(Wu + (size_t)e * DM * FFE, DM, FFE, gu, MAP_UP, F8_SW1, gain, scr, gw, NGW, base, lane);
        conv_matrix_f8(Wd + (size_t)e * FFE * DM, FFE, DM, wd + (size_t)e * DM * FFE, MAP_ID, F8_SW2, nullptr, scr, gw, NGW, base, lane);
    }
}

__device__ __forceinline__ void rowb_load(const bf16* xrow, int lane, float (&v)[16]) { ld8(xrow + 8 * lane, v); ld8(xrow + 512 + 8 * lane, v + 8); }
__device__ __forceinline__ void rowb_add(const bf16* yrow, int lane, float (&v)[16]) { float t[16]; ld8(yrow + 8 * lane, t); ld8(yrow + 512 + 8 * lane, t + 8);
#pragma unroll
    for (int i = 0; i < 16; ++i) v[i] += t[i]; }
__device__ __forceinline__ float rowb_store_ss(bf16* xrow, int lane, const float (&v)[16]) {
    unsigned w[8]; float s = 0.f;
#pragma unroll
    for (int i = 0; i < 8; ++i) { w[i] = pk2(v[2 * i], v[2 * i + 1]); const float a = bf_lo(w[i]), b = bf_hi(w[i]); s += a * a + b * b; }
    v4u o0 = {w[0], w[1], w[2], w[3]}, o1 = {w[4], w[5], w[6], w[7]};
    *(GAS v4u*)(xrow + 8 * lane) = o0; *(GAS v4u*)(xrow + 512 + 8 * lane) = o1;
    return wave_sum(s);
}
__device__ __forceinline__ float ss_total(const float* ss, int row) { const f32x4 a = *(const GAS f32x4*)(ss + (size_t)row * pg8::SSW); return (a[0] + a[1]) + (a[2] + a[3]); }
__device__ __forceinline__ void ss_store(float* ss, int row, float s, int lane) { if (lane == 0) *(GAS f32x4*)(ss + (size_t)row * pg8::SSW) = (f32x4){s, 0.f, 0.f, 0.f}; }
template <int MODE>
__device__ __forceinline__ void row_phase(Frame& F, const float* xin, bf16* XR, float* ss, const float* g, float* out, const bf16* Y, const int* toks,
                                          const float* gWr, int* toke, float* tokg, int* wgcnt) {
    const int RPW = (NTOK + F.G - 1) / F.G; const int r0 = F.bid * RPW, r1 = (r0 + RPW < NTOK) ? r0 + RPW : NTOK;
    LAS int* cnt = (LAS int*)(F.lds + RING_OFF);
    if (MODE == 1) { if (F.tid < 8) cnt[F.tid] = 0; __syncthreads(); }
    f32x4 wr[16][2];
    if (MODE == 1) {
#pragma unroll
        for (int i = 0; i < 16; ++i) { const int k = (i < 8) ? 8 * F.lane + i : 512 + 8 * F.lane + (i - 8); wr[i][0] = *(const GAS f32x4*)(gWr + (size_t)k * 8); wr[i][1] = *(const GAS f32x4*)(gWr + (size_t)k * 8 + 4); } }
    if (MODE == 0) {
        for (int rA = r0 + F.wave; rA < r1; rA += 2 * NWAVES) {
            const bool hasB = rA + NWAVES < r1; const int rB = hasB ? rA + NWAVES : rA;
            const GAS f32x4* xa = (const GAS f32x4*)(xin + (size_t)rA * DM); const GAS f32x4* xb = (const GAS f32x4*)(xin + (size_t)rB * DM);
            const f32x4 a0 = xa[2 * F.lane], a1 = xa[2 * F.lane + 1], a2 = xa[128 + 2 * F.lane], a3 = xa[128 + 2 * F.lane + 1];
            const f32x4 c0 = xb[2 * F.lane], c1 = xb[2 * F.lane + 1], c2 = xb[128 + 2 * F.lane], c3 = xb[128 + 2 * F.lane + 1];
            { float v[16] = {a0.x, a0.y, a0.z, a0.w, a1.x, a1.y, a1.z, a1.w, a2.x, a2.y, a2.z, a2.w, a3.x, a3.y, a3.z, a3.w};
              const float s = rowb_store_ss(XR + (size_t)rA * DM, F.lane, v); ss_store(ss, rA, s, F.lane); }
            if (hasB) { float v[16] = {c0.x, c0.y, c0.z, c0.w, c1.x, c1.y, c1.z, c1.w, c2.x, c2.y, c2.z, c2.w, c3.x, c3.y, c3.z, c3.w};
              const float s = rowb_store_ss(XR + (size_t)rB * DM, F.lane, v); ss_store(ss, rB, s, F.lane); } }
    } else {
        for (int rA = r0 + F.wave; rA < r1; rA += 2 * NWAVES) {
            const bool hasB = rA + NWAVES < r1; const int rB = hasB ? rA + NWAVES : rA;
            float vA[16], vB[16]; int sA0 = 0, sA1 = 0, sB0 = 0, sB1 = 0; float tA = 0.f, tB = 0.f;
            if (MODE == 2 || MODE == 3) { sA0 = toks[2 * rA]; sA1 = toks[2 * rA + 1]; sB0 = toks[2 * rB]; sB1 = toks[2 * rB + 1]; }
            rowb_load(XR + (size_t)rA * DM, F.lane, vA); rowb_load(XR + (size_t)rB * DM, F.lane, vB);
            if (MODE == 1) { tA = ss_total(ss, rA); tB = ss_total(ss, rB); }
            if (MODE == 2 || MODE == 3) { float yA0[16], yA1[16], yB0[16], yB1[16];
                rowb_load(Y + (size_t)sA0 * DM, F.lane, yA0); rowb_load(Y + (size_t)sA1 * DM, F.lane, yA1); rowb_load(Y + (size_t)sB0 * DM, F.lane, yB0); rowb_load(Y + (size_t)sB1 * DM, F.lane, yB1);
#pragma unroll
                for (int i = 0; i < 16; ++i) { vA[i] = (vA[i] + yA0[i]) + yA1[i]; vB[i] = (vB[i] + yB0[i]) + yB1[i]; } }
#pragma unroll
            for (int half = 0; half < 2; ++half) {
                if (half == 1 && !hasB) break;
                const int r = half ? rB : rA; float (&v)[16] = half ? vB : vA;
                if (MODE == 2) { const float s = rowb_store_ss(XR + (size_t)r * DM, F.lane, v); ss_store(ss, r, s, F.lane); }
                if (MODE == 3) { float s = 0.f;
#pragma unroll
                    for (int i = 0; i < 16; ++i) s += v[i] * v[i];
                    const float rstd = 1.0f / sqrtf(wave_sum(s) * (1.0f / DM) + NORM_EPS);
                    const GAS f32x4* gr = (const GAS f32x4*)g; const f32x4 g0 = gr[2 * F.lane], g1 = gr[2 * F.lane + 1], g2 = gr[128 + 2 * F.lane], g3 = gr[128 + 2 * F.lane + 1];
                    GAS f32x4* orow = (GAS f32x4*)(out + (size_t)r * DM);
                    orow[2 * F.lane] = (f32x4){v[0], v[1], v[2], v[3]} * rstd * g0; orow[2 * F.lane + 1] = (f32x4){v[4], v[5], v[6], v[7]} * rstd * g1;
                    orow[128 + 2 * F.lane] = (f32x4){v[8], v[9], v[10], v[11]} * rstd * g2; orow[128 + 2 * F.lane + 1] = (f32x4){v[12], v[13], v[14], v[15]} * rstd * g3; }
                if (MODE == 1) {
                    const float rstd = 1.0f / sqrtf((half ? tB : tA) * (1.0f / DM) + NORM_EPS);
                    float lg[8];
#pragma unroll
                    for (int e = 0; e < 8; ++e) lg[e] = 0.f;
#pragma unroll
                    for (int i = 0; i < 16; ++i) { const f32x4 w0 = wr[i][0], w1 = wr[i][1]; const float hv = v[i];
                        lg[0] += hv * w0.x; lg[1] += hv * w0.y; lg[2] += hv * w0.z; lg[3] += hv * w0.w; lg[4] += hv * w1.x; lg[5] += hv * w1.y; lg[6] += hv * w1.z; lg[7] += hv * w1.w; }
                    {
                        const bool b5 = (F.lane & 32) != 0, b4 = (F.lane & 16) != 0, b3 = (F.lane & 8) != 0;
                        float a4[4], a2[2];
#pragma unroll
                        for (int i = 0; i < 4; ++i) { const float keep = b5 ? lg[4 + i] : lg[i], send = b5 ? lg[i] : lg[4 + i]; a4[i] = keep + __shfl_xor(send, 32); }
#pragma unroll
                        for (int i = 0; i < 2; ++i) { const float keep = b4 ? a4[2 + i] : a4[i], send = b4 ? a4[i] : a4[2 + i]; a2[i] = keep + __shfl_xor(send, 16); }
                        float c = (b3 ? a2[1] : a2[0]) + __shfl_xor(b3 ? a2[0] : a2[1], 8);
                        c += __shfl_xor(c, 4); c += __shfl_xor(c, 2); c += __shfl_xor(c, 1);
                        c *= rstd;
#pragma unroll
                        for (int e = 0; e < 8; ++e) lg[e] = __builtin_bit_cast(float, __builtin_amdgcn_readlane(__builtin_bit_cast(int, c), 8 * e));
                    }
                    int e0 = 0; float l0 = lg[0];
#pragma unroll
                    for (int e = 1; e < 8; ++e) if (lg[e] > l0) { l0 = lg[e]; e0 = e; }
                    int e1 = -1; float l1 = -INFINITY;
#pragma unroll
                    for (int e = 0; e < 8; ++e) if (e != e0 && lg[e] > l1) { l1 = lg[e]; e1 = e; }
                    const float g0 = 1.0f / (1.0f + __expf(l1 - l0)), g1 = 1.0f - g0;
                    if (F.lane == 0) { toke[2 * r] = e0; toke[2 * r + 1] = e1; tokg[2 * r] = g0; tokg[2 * r + 1] = g1; __hip_atomic_fetch_add(&cnt[e0], 1, __ATOMIC_RELAXED, __HIP_MEMORY_SCOPE_WORKGROUP); __hip_atomic_fetch_add(&cnt[e1], 1, __ATOMIC_RELAXED, __HIP_MEMORY_SCOPE_WORKGROUP); }
                }
            }
        }
    }
    if (MODE == 1) { __syncthreads(); if (F.tid < 8) wgcnt[F.bid * 8 + F.tid] = cnt[F.tid]; __syncthreads(); }
}

__device__ __forceinline__ void slot_phase(Frame& F, LAS int* tot, const int* toke, const float* tokg, int* toks, float* sgate, float* sss, const float* ss, const bf16* XR, unsigned char* XB) {
    const int RPW = (NTOK + F.G - 1) / F.G; const int r0 = F.bid * RPW, r1 = (r0 + RPW < NTOK) ? r0 + RPW : NTOK;
    LAS int* slotof = tot + 64;
    const int np = 2 * (r1 - r0);
    for (int p = F.tid; p < np; p += NWAVES * 64) { const int idx = 2 * r0 + p; const int e = toke[idx]; const int slot = __hip_atomic_fetch_add(&tot[16 + e], 1, __ATOMIC_RELAXED, __HIP_MEMORY_SCOPE_WORKGROUP);
        toks[idx] = slot; sgate[slot] = tokg[idx]; slotof[p] = slot; }
    __syncthreads();
    for (int p = F.wave; p < np; p += NWAVES) { const int tok = r0 + (p >> 1); const int slot = slotof[p];
        float v[16]; rowb_load(XR + (size_t)tok * DM, F.lane, v);
        if (F.lane == 0) sss[slot] = __builtin_amdgcn_rsqf(ss_total(ss, tok) * (1.0f / DM) + NORM_EPS);
        GAS unsigned long long* d = (GAS unsigned long long*)(XB + (size_t)slot * DM);
        d[F.lane] = (unsigned long long)pg8::pk4_fp8(v[0] * F8_SA, v[1] * F8_SA, v[2] * F8_SA, v[3] * F8_SA) | ((unsigned long long)pg8::pk4_fp8(v[4] * F8_SA, v[5] * F8_SA, v[6] * F8_SA, v[7] * F8_SA) << 32);
        d[64 + F.lane] = (unsigned long long)pg8::pk4_fp8(v[8] * F8_SA, v[9] * F8_SA, v[10] * F8_SA, v[11] * F8_SA) | ((unsigned long long)pg8::pk4_fp8(v[12] * F8_SA, v[13] * F8_SA, v[14] * F8_SA, v[15] * F8_SA) << 32); }
    __syncthreads();
}

__device__ __forceinline__ void kpe_phase(Frame& F, const bf16* LAT, const float* tab, bf16* KPE) {
    for (int i = F.bid * NWAVES * 64 + F.tid; i < NTOK * 16; i += F.G * NWAVES * 64) { const int r = i >> 4, p = i & 15;
        const unsigned w = *(const GAS unsigned*)(LAT + (size_t)r * 768 + 640 + 2 * p); const float x1 = bf_lo(w), x2 = bf_hi(w);
        const float c = tab[(size_t)(r % SEQ) * 32 + 2 * p], sn = tab[(size_t)(r % SEQ) * 32 + 2 * p + 1];
        *(GAS unsigned*)(KPE + (size_t)r * 32 + 2 * p) = pk2(x1 * c - x2 * sn, x1 * sn + x2 * c); }
}
__device__ __forceinline__ void latpost_phase(Frame& F, const bf16* LAT, const float* qg, const float* kvg, const float* tab, bf16* QN, bf16* KVN, bf16* KPE) {
    const int gw = F.bid * NWAVES + F.wave, NGW = F.G * NWAVES;
    for (int r = gw; r < NTOK; r += NGW) {
        const bf16* row = LAT + (size_t)r * 768;
        float q[6]; float s = 0.f;
#pragma unroll
        for (int i = 0; i < 6; ++i) { q[i] = bf_lo((unsigned)row[F.lane + 64 * i]); s += q[i] * q[i]; }
        const float rq = 1.0f / sqrtf(wave_sum(s) * (1.0f / 384.0f) + NORM_EPS);
#pragma unroll
        for (int i = 0; i < 6; ++i) QN[(size_t)r * 384 + F.lane + 64 * i] = (bf16)f2bf(q[i] * rq * qg[F.lane + 64 * i]);
        float k[4]; s = 0.f;
#pragma unroll
        for (int i = 0; i < 4; ++i) { k[i] = bf_lo((unsigned)row[384 + F.lane + 64 * i]); s += k[i] * k[i]; }
        const float rk = 1.0f / sqrtf(wave_sum(s) * (1.0f / 256.0f) + NORM_EPS);
#pragma unroll
        for (int i = 0; i < 4; ++i) KVN[(size_t)r * 256 + F.lane + 64 * i] = (bf16)f2bf(k[i] * rk * kvg[F.lane + 64 * i]);
        if (F.lane < 16) { const float x1 = bf_lo((unsigned)row[640 + 2 * F.lane]), x2 = bf_lo((unsigned)row[640 + 2 * F.lane + 1]);
            const float c = tab[(size_t)(r % SEQ) * 32 + 2 * F.lane], sn = tab[(size_t)(r % SEQ) * 32 + 2 * F.lane + 1];
            *(GAS unsigned*)(KPE + (size_t)r * 32 + 2 * F.lane) = pk2(x1 * c - x2 * sn, x1 * sn + x2 * c); }
    }
}

namespace fa {
typedef float f32x16 __attribute__((ext_vector_type(16)));
typedef short s16x4 __attribute__((ext_vector_type(4)));
typedef short v4i16_t __attribute__((ext_vector_type(4)));
typedef float f32x2_t __attribute__((ext_vector_type(2)));
typedef __bf16 bf16x2_t __attribute__((ext_vector_type(2)));
__device__ __forceinline__ unsigned cvtpk(float lo, float hi) { f32x2_t v = {lo, hi}; bf16x2_t b = __builtin_convertvector(v, bf16x2_t); return __builtin_bit_cast(unsigned, b); }
__device__ __forceinline__ float fsub1(float a, float b) { float r; asm("v_sub_f32_e32 %0, %1, %2" : "=v"(r) : "v"(a), "v"(b)); return r; }
__device__ __forceinline__ float fadd1(float a, float b) { float r; asm("v_add_f32_e32 %0, %1, %2" : "=v"(r) : "v"(a), "v"(b)); return r; }
__device__ __forceinline__ bf16x8 pack8(const f32x16& x, int s) {
    v4u p; p.x = cvtpk(x[8 * s], x[8 * s + 1]); p.y = cvtpk(x[8 * s + 2], x[8 * s + 3]); p.z = cvtpk(x[8 * s + 4], x[8 * s + 5]); p.w = cvtpk(x[8 * s + 6], x[8 * s + 7]);
    return __builtin_bit_cast(bf16x8, p);
}
__device__ __forceinline__ s16x4 vtr(const LAS unsigned char* p) { return __builtin_bit_cast(s16x4, __builtin_amdgcn_ds_read_tr16_b64_v4i16((LAS v4i16_t*)p)); }
#define FA_MFMA(a, b, c) __builtin_amdgcn_mfma_f32_32x32x16_bf16((a), (b), (c), 0, 0, 0)
#define FA_CI(i) (((i) & 3) + 8 * ((i) >> 2))

struct Desc {
    const bf16* q0; const bf16* q1; int qstride;
    const bf16* k0; int kstride; const bf16* k1; int k1stride;
    const bf16* v; int vstride;
    int qpos0;
    int t_lo, t_hi;
    int W;
    float sl2;
    const LAS float* pm; LAS unsigned* ecnt;
    const float* ropetab;
};
template <int DQK0, int DQK1, int DV> struct Geo {
    static constexpr int DQK = DQK0 + DQK1, RSK = DQK * 2 + 16, RSV = DV * 2 + 64, KBYTES = 64 * RSK, VBYTES = 64 * RSV, BUF = KBYTES + VBYTES;
    static constexpr int C0 = DQK0 / 8, C1 = DQK1 / 8, CV = DV / 8, NV = DV / 64;
};
#define FA_OFFSETS() unsigned koff, k1off = 0u, voff[G::NV], klds, k1lds = 0u, vlds[G::NV]; \
        { const int row_ = tid / G::C0, ch_ = tid % G::C0; koff = (unsigned)(row_ * d.kstride + ch_ * 8) * 2u; klds = (unsigned)(row_ * G::RSK + ch_ * 16); } \
        if (G::C1 > 0) { const int row_ = tid / (G::C1 > 0 ? G::C1 : 1), ch_ = tid % (G::C1 > 0 ? G::C1 : 1); k1off = (unsigned)(row_ * d.k1stride + ch_ * 8) * 2u; k1lds = (unsigned)(row_ * G::RSK + DQK0 * 2 + ch_ * 16); } \
        _Pragma("unroll") for (int i_ = 0; i_ < G::NV; ++i_) { const int c_ = tid + 512 * i_, row_ = c_ / G::CV, ch_ = c_ % G::CV; voff[i_] = (unsigned)(row_ * d.vstride + ch_ * 8) * 2u; vlds[i_] = (unsigned)(G::KBYTES + row_ * G::RSV + ch_ * 16); }
#define FA_RSRC() const __amdgpu_buffer_rsrc_t rk0 = __builtin_amdgcn_make_buffer_rsrc((void*)d.k0, 0, 0x7fffffff, 0x00020000), rv = __builtin_amdgcn_make_buffer_rsrc((void*)d.v, 0, 0x7fffffff, 0x00020000), \
        rk1 = __builtin_amdgcn_make_buffer_rsrc((void*)(G::C1 > 0 ? d.k1 : d.k0), 0, 0x7fffffff, 0x00020000)
#define FA_GLOAD(t_) do { const int key0_ = (t_) * 64;     \
        sk0 = __builtin_bit_cast(v4u, __builtin_amdgcn_raw_buffer_load_b128(rk0, (int)koff, key0_ * d.kstride * 2, 0)); \
        if (G::C1 > 0) { if (tid < 64 * G::C1) sk1 = __builtin_bit_cast(v4u, __builtin_amdgcn_raw_buffer_load_b128(rk1, (int)k1off, key0_ * d.k1stride * 2, 0)); } \
        _Pragma("unroll") for (int i_ = 0; i_ < G::NV; ++i_) sv[i_] = __builtin_bit_cast(v4u, __builtin_amdgcn_raw_buffer_load_b128(rv, (int)voff[i_], key0_ * d.vstride * 2, 0)); } while (0)
#define FA_LSTORE(buf_) do { LAS unsigned char* kb_ = lds + (buf_) * G::BUF; \
        *(LAS v4u*)(kb_ + klds) = sk0; \
        if (G::C1 > 0) { if (tid < 64 * G::C1) *(LAS v4u*)(kb_ + k1lds) = sk1; } \
        _Pragma("unroll") for (int i_ = 0; i_ < G::NV; ++i_) *(LAS v4u*)(kb_ + vlds[i_]) = sv[i_]; } while (0)
#define FA_QK1(kbuf_, kb_, P_) do { const LAS unsigned char* kp_ = (kbuf_) + (32 * (kb_) + r) * G::RSK + h * 16; \
        _Pragma("unroll") for (int s_ = 0; s_ < G::DQK / 16; ++s_) { bf16x8 qv_; if (QLDS) qv_ = *(const LAS bf16x8*)(qs + s_ * 1024); else qv_ = qf[s_]; \
            const bf16x8 kf_ = *(const LAS bf16x8*)(kp_ + s_ * 32); P_ = FA_MFMA(kf_, qv_, s_ == 0 ? zero : P_); } } while (0)
#define FA_PV(vbuf_) do { const LAS unsigned char* vp_ = (vbuf_) + (4 * h + ((lane & 15) >> 2)) * G::RSV + ((lane >> 4) & 1) * 32 + (lane & 3) * 8; \
        _Pragma("unroll") for (int ks_ = 0; ks_ < 4; ++ks_) _Pragma("unroll") for (int c_ = 0; c_ < DV / 32; ++c_) { \
            const s16x4 lo_ = vtr(vp_ + (16 * ks_) * G::RSV + c_ * 64), hi_ = vtr(vp_ + (16 * ks_ + 8) * G::RSV + c_ * 64); \
            const bf16x8 vf_ = {lo_[0], lo_[1], lo_[2], lo_[3], hi_[0], hi_[1], hi_[2], hi_[3]}; o[c_] = FA_MFMA(vf_, pf[ks_], o[c_]); } } while (0)

template <int DQK0, int DQK1, int DV, bool BIAS, bool QLDS, bool EXIT = false>
__device__ __forceinline__ void flash_unit(LAS unsigned char* lds, const Desc& d, int tid, f32x16 (&o)[DV / 32], float& m_out, float& l_out) {
    typedef Geo<DQK0, DQK1, DV> G;
    const int lane = tid & 63, wave = __builtin_amdgcn_readfirstlane(tid >> 6), r = lane & 31, h = lane >> 5;
    bf16x8 qf[G::DQK / 16];
    LAS unsigned char* qs = lds + 2 * G::BUF + wave * (G::DQK / 16) * 1024 + lane * 16;
    { const unsigned qoff = (unsigned)((wave * 32 + r) * d.qstride);
#pragma unroll
      for (int s = 0; s < DQK0 / 16; ++s) qf[s] = *(const GAS bf16x8*)(d.q0 + qoff + s * 16 + h * 8);
#pragma unroll
      for (int s = 0; s < DQK1 / 16; ++s) qf[DQK0 / 16 + s] = *(const GAS bf16x8*)(d.q1 + qoff + s * 16 + h * 8);
      if (DQK1 > 0) { if (d.ropetab) {
#pragma unroll
          for (int s = 0; s < DQK1 / 16; ++s) { const float* t = d.ropetab + (size_t)(d.qpos0 + wave * 32 + r) * 32 + 16 * s + 8 * h; const f32x4 c0 = *(const GAS f32x4*)t, c1 = *(const GAS f32x4*)(t + 4);
              const v4u w = __builtin_bit_cast(v4u, qf[DQK0 / 16 + s]); v4u o_; float a, b;
              a = bf_lo(w.x); b = bf_hi(w.x); o_.x = pk2(a * c0[0] - b * c0[1], a * c0[1] + b * c0[0]);
              a = bf_lo(w.y); b = bf_hi(w.y); o_.y = pk2(a * c0[2] - b * c0[3], a * c0[3] + b * c0[2]);
              a = bf_lo(w.z); b = bf_hi(w.z); o_.z = pk2(a * c1[0] - b * c1[1], a * c1[1] + b * c1[0]);
              a = bf_lo(w.w); b = bf_hi(w.w); o_.w = pk2(a * c1[2] - b * c1[3], a * c1[3] + b * c1[2]);
              qf[DQK0 / 16 + s] = __builtin_bit_cast(bf16x8, o_); } } }
      if (QLDS) {
#pragma unroll
          for (int s = 0; s < G::DQK / 16; ++s) *(LAS bf16x8*)(qs + s * 1024) = qf[s]; } }
    float qn = 0.f;
    if (EXIT) {
#pragma unroll
        for (int s = 0; s < G::DQK / 16; ++s)
#pragma unroll
            for (int j = 0; j < 8; ++j) { const float f = bf_lo((unsigned)(unsigned short)qf[s][j]); qn += f * f; }
        qn += __shfl_xor(qn, 32); qn = sqrtf(qn) * 1.01f;
    }
    f32x16 zero;
#pragma unroll
    for (int i = 0; i < 16; ++i) zero[i] = 0.f;
#pragma unroll
    for (int c = 0; c < DV / 32; ++c)
#pragma unroll
        for (int i = 0; i < 16; ++i) o[c][i] = 0.f;
    float m = -1e30f, l = 0.f;
    const int qmin = d.qpos0 + wave * 32, qpos = qmin + r;
    if (__builtin_amdgcn_readfirstlane(tid) >= 256) __builtin_amdgcn_s_setprio(1);
    v4u sk0, sk1, sv[G::NV];
    FA_OFFSETS();
    FA_RSRC();
    FA_GLOAD(d.t_hi); FA_LSTORE(0); __syncthreads();
    int buf = 0; unsigned prev0 = 0u, prev1 = 0u; bool done_w = false;
    for (int t = d.t_hi; t >= d.t_lo; --t) {
        if (QLDS) { int tl = tid; asm volatile("" : "+v"(tl));
            { const int row_ = tl / G::C0, ch_ = tl % G::C0; koff = (unsigned)(row_ * d.kstride + ch_ * 8) * 2u; klds = (unsigned)(row_ * G::RSK + ch_ * 16); }
#pragma unroll
            for (int i_ = 0; i_ < G::NV; ++i_) { const int c_ = tl + 512 * i_, row_ = c_ / G::CV, ch_ = c_ % G::CV; voff[i_] = (unsigned)(row_ * d.vstride + ch_ * 8) * 2u; vlds[i_] = (unsigned)(G::KBYTES + row_ * G::RSV + ch_ * 16); } }
        if (t > d.t_lo) FA_GLOAD(t - 1);
        const int k0 = t * 64;
        const bool act = (k0 <= qmin + 31 && k0 + 63 >= qmin - d.W) && !done_w;
        const LAS unsigned char* kbuf = lds + buf * G::BUF; const LAS unsigned char* vbuf = kbuf + G::KBYTES;
        bf16x8 pf[4];
        if (act) {
            f32x16 p[2];
            FA_QK1(kbuf, 0, p[0]); FA_QK1(kbuf, 1, p[1]);
            if (BIAS) {
#pragma unroll
                for (int i = 0; i < 16; ++i) { p[0][i] = __builtin_fmaf(d.sl2, (float)FA_CI(i), p[0][i]); p[1][i] = __builtin_fmaf(d.sl2, (float)FA_CI(i), p[1][i]); } }
            const int dq0 = qpos - k0 - 4 * h;
            const float off0 = BIAS ? d.sl2 * (float)dq0 : 0.f, off1 = BIAS ? d.sl2 * (float)(dq0 - 32) : 0.f;
            if (k0 + 63 > qmin || k0 < qmin + 31 - d.W) {
#pragma unroll
                for (int kb = 0; kb < 2; ++kb) { const int dq = dq0 - 32 * kb;
#pragma unroll
                    for (int i = 0; i < 16; ++i) { const bool ok = (FA_CI(i) <= dq) && (FA_CI(i) >= dq - d.W); p[kb][i] = ok ? p[kb][i] : -INFINITY; } }
            }
            float mx0 = p[0][0], mx1 = p[1][0];
#pragma unroll
            for (int i = 1; i < 16; ++i) { mx0 = fmaxf(mx0, p[0][i]); mx1 = fmaxf(mx1, p[1][i]); }
            float tm = fmaxf(mx0 - off0, mx1 - off1);
            tm = fmaxf(tm, __shfl_xor(tm, 32));
            if (__any(tm > m + 8.0f)) {
                const float mn = fmaxf(m, tm), al = ex2(m - mn); m = mn; l *= al;
#pragma unroll
                for (int c = 0; c < DV / 32; ++c)
#pragma unroll
                    for (int i = 0; i < 16; ++i) o[c][i] *= al;
            }
            const float mk0 = m + off0, mk1 = m + off1; float ps = 0.f;
#pragma unroll
            for (int i = 0; i < 16; ++i) { p[0][i] = ex2(p[0][i] - mk0); p[1][i] = ex2(p[1][i] - mk1); ps += p[0][i] + p[1][i]; }
            l += ps;
            pf[0] = pack8(p[0], 0); pf[1] = pack8(p[0], 1); pf[2] = pack8(p[1], 0); pf[3] = pack8(p[1], 1);
        }
        if (EXIT) {
            if (!done_w && t > d.t_lo) { const float bound = qn * d.pm[t - 1] + d.sl2 * (float)(k0 - 1 - qpos); done_w = __all(bound - m < -40.0f); }
            if (!done_w && lane == 0) __hip_atomic_fetch_add(&d.ecnt[t & 1], 1u, __ATOMIC_RELAXED, __HIP_MEMORY_SCOPE_WORKGROUP);
        }
        if (QLDS) { if (t > d.t_lo) FA_LSTORE(buf ^ 1); }
        if (act) { FA_PV(vbuf); }
        if (!QLDS) { if (t > d.t_lo) FA_LSTORE(buf ^ 1); }
        __syncthreads();
        buf ^= 1;
        if (EXIT) { const unsigned c = d.ecnt[t & 1]; if (t & 1) { if (c == prev1) break; prev1 = c; } else { if (c == prev0) break; prev0 = c; } }
    }
    if (EXIT) __syncthreads();
    __builtin_amdgcn_s_setprio(0);
    m_out = m; l_out = l;
}
__device__ __forceinline__ void sb_unit(LAS unsigned char* lds, const Desc& d, int tid, f32x16 (&o)[2], LAS unsigned* ecnt) {
    typedef Geo<64, 0, 64> G; constexpr int DQK0 = 64, DV = 64; constexpr bool QLDS = false; LAS unsigned char* qs = nullptr;
    const int lane = tid & 63, wave = __builtin_amdgcn_readfirstlane(tid >> 6), r = lane & 31, h = lane >> 5;
    bf16x8 qf[4];
    { const unsigned qoff = (unsigned)((wave * 32 + r) * d.qstride);
#pragma unroll
      for (int s = 0; s < 4; ++s) qf[s] = *(const GAS bf16x8*)(d.q0 + qoff + s * 16 + h * 8); }
    f32x16 zero;
#pragma unroll
    for (int i = 0; i < 16; ++i) { zero[i] = 0.f; o[0][i] = 0.f; o[1][i] = 0.f; }
    float carry = 1.0f;
    const int qmin = d.qpos0 + wave * 32, qpos = qmin + r;
    v4u sk0, sk1, sv[G::NV];
    FA_OFFSETS();
    FA_RSRC();
    if (tid < 2) ecnt[tid] = 0u;
    FA_GLOAD(d.t_hi); FA_LSTORE(0); __syncthreads();
    int buf = 0; unsigned prev0 = 0u, prev1 = 0u; bool done_w = false;
    for (int t = d.t_hi; t >= d.t_lo; --t) {
        if (t > d.t_lo) FA_GLOAD(t - 1);
        const int k0 = t * 64;
        if (k0 < qmin + 31 && !done_w) {
            const LAS unsigned char* kbuf = lds + buf * G::BUF; const LAS unsigned char* vbuf = kbuf + G::KBYTES;
            f32x16 p[2];
            FA_QK1(kbuf, 0, p[0]); FA_QK1(kbuf, 1, p[1]);
            const int dq0 = qpos - k0 - 4 * h;
            if (k0 + 63 >= qmin) {
#pragma unroll
                for (int kb = 0; kb < 2; ++kb) { const int dq = dq0 - 32 * kb;
#pragma unroll
                    for (int i = 0; i < 16; ++i) p[kb][i] = (FA_CI(i) < dq) ? p[kb][i] : -INFINITY; }
            }
#pragma unroll
            for (int kk = 0; kk < 2; ++kk) { const int kb = 1 - kk;
                float T[4];
#pragma unroll
                for (int g = 0; g < 4; ++g) {
                    float kp[4], bt[4];
#pragma unroll
                    for (int j = 0; j < 4; ++j) { const float ez = ex2(p[kb][4 * g + j]); kp[j] = __builtin_amdgcn_rcpf(1.0f + ez); bt[j] = ez * kp[j]; }
                    const float e2 = kp[3], e1 = e2 * kp[2], e0 = e1 * kp[1]; T[g] = e0 * kp[0];
                    p[kb][4 * g + 3] = bt[3]; p[kb][4 * g + 2] = bt[2] * e2; p[kb][4 * g + 1] = bt[1] * e1; p[kb][4 * g] = bt[0] * e0;
                }
                float PT[4];
#pragma unroll
                for (int g = 0; g < 4; ++g) PT[g] = __shfl_xor(T[g], 32);
                const float S3 = carry * (h ? 1.0f : PT[3]);
                const float S2 = S3 * T[3] * (h ? PT[3] : PT[2]);
                const float S1 = S2 * T[2] * (h ? PT[2] : PT[1]);
                const float S0 = S1 * T[1] * (h ? PT[1] : PT[0]);
                carry = S0 * T[0] * (h ? PT[0] : 1.0f);
#pragma unroll
                for (int j = 0; j < 4; ++j) { p[kb][12 + j] *= S3; p[kb][8 + j] *= S2; p[kb][4 + j] *= S1; p[kb][j] *= S0; }
            }
            bf16x8 pf[4]; pf[0] = pack8(p[0], 0); pf[1] = pack8(p[0], 1); pf[2] = pack8(p[1], 0); pf[3] = pack8(p[1], 1);
            FA_PV(vbuf);
            done_w = __all(carry <= 1e-30f);
        }
        if (!done_w && lane == 0) __hip_atomic_fetch_add(&ecnt[t & 1], 1u, __ATOMIC_RELAXED, __HIP_MEMORY_SCOPE_WORKGROUP);
        if (t > d.t_lo) FA_LSTORE(buf ^ 1);
        __syncthreads();
        buf ^= 1;
        const unsigned c = ecnt[t & 1];
        if (t & 1) { if (c == prev1) break; prev1 = c; } else { if (c == prev0) break; prev0 = c; }
    }
    __syncthreads();
}
}
#ifndef B_EXIT
#define B_EXIT 1
#endif
__device__ __forceinline__ int vcu_of(const Frame& F) { return (F.G % 8 == 0) ? (F.bid % 8) * (F.G / 8) + F.bid / 8 : F.bid; }
template <int NV> __device__ __forceinline__ void store_rows_own(bf16* out, int rstride, int wave, int lane, const fa::f32x16 (&o)[NV], float scale) {
    const int r = lane & 31, h = lane >> 5; bf16* rowp = out + (unsigned)((wave * 32 + r) * rstride + 4 * h);
#pragma unroll
    for (int c = 0; c < NV; ++c)
#pragma unroll
        for (int g = 0; g < 4; ++g) { const unsigned lo = fa::cvtpk(o[c][4 * g] * scale, o[c][4 * g + 1] * scale), hi = fa::cvtpk(o[c][4 * g + 2] * scale, o[c][4 * g + 3] * scale);
            *(GAS unsigned long long*)(rowp + 32 * c + 8 * g) = (unsigned long long)lo | ((unsigned long long)hi << 32); }
}
template <int NV> __device__ __forceinline__ void store_rows(bf16* out, int rstride, int wave, int lane, const fa::f32x16 (&o)[NV], float scale) {
    const int r = lane & 31, h = lane >> 5; bf16* rowp = out + (unsigned)((wave * 32 + r) * rstride + 8 * h);
#pragma unroll
    for (int c = 0; c < NV; ++c)
#pragma unroll
        for (int k = 0; k < 4; k += 2) {
            unsigned ax = fa::cvtpk(o[c][4 * k] * scale, o[c][4 * k + 1] * scale), ay = fa::cvtpk(o[c][4 * k + 2] * scale, o[c][4 * k + 3] * scale);
            unsigned bx = fa::cvtpk(o[c][4 * k + 4] * scale, o[c][4 * k + 5] * scale), by = fa::cvtpk(o[c][4 * k + 6] * scale, o[c][4 * k + 7] * scale);
            const auto r0 = __builtin_amdgcn_permlane32_swap(ax, bx, false, false); const auto r1 = __builtin_amdgcn_permlane32_swap(ay, by, false, false);
            const v4u w = {r0[0], r1[0], r0[1], r1[1]};
            *(GAS v4u*)(rowp + 32 * c + 8 * k) = w; }
}
__device__ __forceinline__ void fast_attn_c(Frame& F, const bf16* Q, const bf16* KV, const bf16* KPE, const float* ropetab, bf16* OUT) {
    const int v = vcu_of(F);
    for (int P = v; P < BATCH * 16 * 8; P += F.G) {
        const int bh = P >> 3, pi = P & 7, b = bh >> 4, hd = bh & 15;
        for (int half = 0; half < 2; ++half) { const int qb = half ? pi : 15 - pi; const long row0 = (long)b * SEQ + qb * 256;
            fa::Desc d; d.q0 = Q + row0 * 1536 + 64 * hd; d.q1 = Q + row0 * 1536 + 1024 + 32 * hd; d.qstride = 1536;
            d.k0 = KV + (long)b * SEQ * 2048 + 64 * hd; d.kstride = 2048; d.k1 = KPE + (long)b * SEQ * 32; d.k1stride = 32;
            d.v = KV + (long)b * SEQ * 2048 + 1024 + 64 * hd; d.vstride = 2048; d.qpos0 = qb * 256; d.t_lo = 0; d.t_hi = 4 * qb + 3; d.W = 1 << 29; d.sl2 = 0.f; d.pm = nullptr; d.ecnt = nullptr; d.ropetab = ropetab;
            fa::f32x16 o[2]; float m, l;
            fa::flash_unit<64, 32, 64, false, false>(F.lds + RING_OFF, d, F.tid, o, m, l);
            const float lt = l + __shfl_xor(l, 32);
            store_rows<2>(OUT + row0 * 1024 + 64 * hd, 1024, F.wave, F.lane, o, 1.0f / lt);
        }
    }
}
__device__ __forceinline__ void fast_attn_d(Frame& F, const bf16* QKV, bf16* OUT) {
    const int v = vcu_of(F);
    LAS unsigned* ecnt = (LAS unsigned*)(F.lds + RING_OFF + 2 * fa::Geo<64, 0, 64>::BUF);
    for (int P = v; P < BATCH * 16 * 8; P += F.G) {
        const int bh = P >> 3, pi = P & 7, b = bh >> 4, hd = bh & 15;
        for (int half = 0; half < 2; ++half) { const int qb = half ? pi : 15 - pi; const long row0 = (long)b * SEQ + qb * 256;
            fa::Desc d; d.q0 = QKV + row0 * 3072 + 64 * hd; d.q1 = nullptr; d.qstride = 3072;
            d.k0 = QKV + (long)b * SEQ * 3072 + 1024 + 64 * hd; d.kstride = 3072; d.k1 = nullptr; d.k1stride = 0;
            d.v = QKV + (long)b * SEQ * 3072 + 2048 + 64 * hd; d.vstride = 3072; d.qpos0 = qb * 256; d.t_lo = 0; d.t_hi = 4 * qb + 3; d.W = 1 << 29; d.sl2 = 0.f; d.pm = nullptr; d.ecnt = nullptr; d.ropetab = nullptr;
            fa::f32x16 o[2];
            fa::sb_unit(F.lds + RING_OFF, d, F.tid, o, ecnt);
            store_rows<2>(OUT + row0 * 1024 + 64 * hd, 1024, F.wave, F.lane, o, 1.0f);
        }
    }
}
__device__ __forceinline__ void fast_attn_b(Frame& F, const bf16* QKV, const float* KN, unsigned* queue, bf16* OUT, const float* lq1, const float* lk1, const float* lq2, const float* lk2, const float* subln) {
    float d1 = 0.f, d2 = 0.f;
    for (int i = 0; i < 64; ++i) { d1 += lq1[i] * lk1[i]; d2 += lq2[i] * lk2[i]; }
    const float lam_init = 0.8f - 0.6f * expf(-0.3f * 1.0f), lam = __builtin_bit_cast(float, __builtin_amdgcn_readfirstlane(__builtin_bit_cast(int, expf(d1) - expf(d2) + lam_init)));
    LAS int* qslot = (LAS int*)(F.lds + RING_OFF + 2 * fa::Geo<64, 0, 128>::BUF + NWAVES * 4096 + 512);
    for (;;) {
        if (F.tid == 0) *qslot = (int)__hip_atomic_fetch_add(queue, 1u, __ATOMIC_RELAXED, __HIP_MEMORY_SCOPE_AGENT);
        __syncthreads();
        const int P = *qslot;
        __syncthreads();
        if (P >= BATCH * 8 * 8) break;
        const int hd = 7 - (P >> 6), b = (P >> 3) & 7, pi = P & 7;
        for (int half = 0; half < 2; ++half) { const int qb = half ? pi : 15 - pi; const long row0 = (long)b * SEQ + qb * 256;
            fa::f32x16 o[4]; float m, l;
            bf16* orow = OUT + row0 * 1024 + 128 * hd;
            for (int mm = 0; mm < 2; ++mm) {
                fa::Desc d; d.q0 = QKV + row0 * 3072 + 128 * hd + 64 * mm; d.q1 = nullptr; d.qstride = 3072;
                d.k0 = QKV + (long)b * SEQ * 3072 + 1024 + 128 * hd + 64 * mm; d.kstride = 3072; d.k1 = nullptr; d.k1stride = 0;
                d.v = QKV + (long)b * SEQ * 3072 + 2048 + 128 * hd; d.vstride = 3072; d.qpos0 = qb * 256; d.t_lo = 0; d.t_hi = 4 * qb + 3; d.W = 1 << 29; d.sl2 = exp2f(-(float)(hd + 1)) * LOG2E;
                LAS float* pm = (LAS float*)(F.lds + RING_OFF + 2 * fa::Geo<64, 0, 128>::BUF + NWAVES * 4096); LAS unsigned* ecnt = (LAS unsigned*)(pm + 64);
                if (F.wave == 0) { int ln = F.lane; asm volatile("" : "+v"(ln)); float kv = (ln <= d.t_hi) ? KN[((size_t)b * 16 + 2 * hd + mm) * 64 + ln] * 1.01f : 0.f;
#pragma unroll
                    for (int o_ = 1; o_ < 64; o_ <<= 1) { const float u = __shfl_up(kv, o_); if (F.lane >= o_) kv = fmaxf(kv, u); }
                    pm[F.lane] = kv; if (F.lane < 2) ecnt[F.lane] = 0u; }
                d.pm = pm; d.ecnt = ecnt; d.ropetab = nullptr;
                fa::flash_unit<64, 0, 128, true, true, (B_EXIT != 0)>(F.lds + RING_OFF, d, F.tid, o, m, l);
                const float rl = 1.0f / (l + __shfl_xor(l, 32));
                if (mm == 0) { store_rows_own<4>(orow, 1024, F.wave, F.lane, o, rl); }
                else {
                    int l2 = F.lane; asm volatile("" : "+v"(l2)); const int r = l2 & 31, h = l2 >> 5;
                    float ss = 0.f; const bf16* rowp = orow + (unsigned)((F.wave * 32 + r) * 1024 + 4 * h);
#pragma unroll
                    for (int c = 0; c < 4; ++c) {
#pragma unroll
                        for (int g = 0; g < 4; ++g) { const unsigned long long w = *(const GAS unsigned long long*)(rowp + 32 * c + 8 * g); const unsigned lo = (unsigned)w, hi = (unsigned)(w >> 32);
                            const float a0 = bf_lo(lo) - lam * o[c][4 * g] * rl, a1 = bf_hi(lo) - lam * o[c][4 * g + 1] * rl, a2 = bf_lo(hi) - lam * o[c][4 * g + 2] * rl, a3 = bf_hi(hi) - lam * o[c][4 * g + 3] * rl;
                            o[c][4 * g] = a0; o[c][4 * g + 1] = a1; o[c][4 * g + 2] = a2; o[c][4 * g + 3] = a3; ss += (a0 * a0 + a1 * a1) + (a2 * a2 + a3 * a3); }
                        asm volatile("" ::: "memory"); }
                    ss += __shfl_xor(ss, 32);
                    const float rs = (1.0f - lam_init) / sqrtf(ss * (1.0f / 128.0f) + SUBLN_EPS);
#pragma unroll
                    for (int c = 0; c < 4; ++c) {
#pragma unroll
                        for (int g = 0; g < 4; ++g) { const f32x4 sg = *(const GAS f32x4*)(subln + 32 * c + 8 * g + 4 * h);
                            o[c][4 * g] *= sg[0]; o[c][4 * g + 1] *= sg[1]; o[c][4 * g + 2] *= sg[2]; o[c][4 * g + 3] *= sg[3]; }
                        asm volatile("" ::: "memory"); }
                    store_rows_own<4>(orow, 1024, F.wave, F.lane, o, rs);
                }
            }
        }
    }
}
__device__ __forceinline__ void fast_attn_a(Frame& F, const bf16* QKV, bf16* OG, float* LSE) {
    const int v = vcu_of(F);
    for (int U = v; U < 3 * BATCH * 8 * 16; U += F.G) {
        const int j = U & 15, hd = (U >> 4) & 7, b = (U >> 7) & 7, g = U >> 10; const int dil = 1 << (2 * g), res = j & (dil - 1), qblk = j >> (2 * g);
        const long tok0 = (long)b * SEQ + res;
        fa::Desc d; d.qstride = dil * 4608; d.q0 = QKV + (tok0 + (long)qblk * 256 * dil) * 4608 + g * 512 + hd * 64; d.q1 = nullptr;
        d.k0 = QKV + tok0 * 4608 + 1536 + g * 512 + hd * 64; d.kstride = d.qstride; d.k1 = nullptr; d.k1stride = 0;
        d.v = QKV + tok0 * 4608 + 3072 + g * 512 + hd * 64; d.vstride = d.qstride; d.qpos0 = qblk * 256;
        d.t_lo = (qblk * 256 - 128) < 0 ? 0 : (qblk * 256 - 128) / 64; d.t_hi = 4 * qblk + 3; d.W = 128; d.sl2 = exp2f(-(float)(g * 8 + hd + 1) / 3.0f) * LOG2E * (float)dil; d.pm = nullptr; d.ecnt = nullptr; d.ropetab = nullptr;
        fa::f32x16 o[2]; float m, l;
        fa::flash_unit<64, 0, 64, true, false>(F.lds + RING_OFF, d, F.tid, o, m, l);
        const float lt = l + __shfl_xor(l, 32);
        bf16* og = OG + (size_t)g * NTOK * 512;
        store_rows<2>(og + (tok0 + (long)qblk * 256 * dil) * 512 + hd * 64, dil * 512, F.wave, F.lane, o, 1.0f / lt);
        if (F.lane < 32) LSE[(size_t)g * NTOK * 8 + (tok0 + ((long)qblk * 256 + F.wave * 32 + F.lane) * dil) * 8 + hd] = m + log2f(lt);
    }
}
__device__ __forceinline__ void merge_a(Frame& F, const bf16* OG, const float* LSE, bf16* OUT) {
    const long stride = (long)F.G * NWAVES * 64, NI = (long)NTOK * 64;
    for (long i = (long)F.bid * NWAVES * 64 + F.tid; i < NI; i += 2 * stride) {
        const bool has2 = i + stride < NI; const long i2 = has2 ? i + stride : i;
        const long tokA = i >> 6, tokB = i2 >> 6; const int cA = (int)(i & 63), cB = (int)(i2 & 63), hA = cA >> 3, hB = cB >> 3;
        const float lA0 = LSE[tokA * 8 + hA], lA1 = LSE[(size_t)NTOK * 8 + tokA * 8 + hA], lA2 = LSE[(size_t)2 * NTOK * 8 + tokA * 8 + hA];
        const float lB0 = LSE[tokB * 8 + hB], lB1 = LSE[(size_t)NTOK * 8 + tokB * 8 + hB], lB2 = LSE[(size_t)2 * NTOK * 8 + tokB * 8 + hB];
        float a0[8], a1[8], a2[8], b0[8], b1[8], b2[8];
        ld8(OG + tokA * 512 + cA * 8, a0); ld8(OG + (size_t)NTOK * 512 + tokA * 512 + cA * 8, a1); ld8(OG + (size_t)2 * NTOK * 512 + tokA * 512 + cA * 8, a2);
        ld8(OG + tokB * 512 + cB * 8, b0); ld8(OG + (size_t)NTOK * 512 + tokB * 512 + cB * 8, b1); ld8(OG + (size_t)2 * NTOK * 512 + tokB * 512 + cB * 8, b2);
        { const float mx = fmaxf(lA0, fmaxf(lA1, lA2)); const float w0 = ex2(lA0 - mx), w1 = ex2(lA1 - mx), w2 = ex2(lA2 - mx), rw = 1.0f / (w0 + w1 + w2);
          float y[8];
#pragma unroll
          for (int e = 0; e < 8; ++e) y[e] = (w0 * a0[e] + w1 * a1[e] + w2 * a2[e]) * rw;
          v4u w; w.x = pk2(y[0], y[1]); w.y = pk2(y[2], y[3]); w.z = pk2(y[4], y[5]); w.w = pk2(y[6], y[7]);
          *(GAS v4u*)(OUT + tokA * 512 + cA * 8) = w; }
        if (has2) { const float mx = fmaxf(lB0, fmaxf(lB1, lB2)); const float w0 = ex2(lB0 - mx), w1 = ex2(lB1 - mx), w2 = ex2(lB2 - mx), rw = 1.0f / (w0 + w1 + w2);
          float y[8];
#pragma unroll
          for (int e = 0; e < 8; ++e) y[e] = (w0 * b0[e] + w1 * b1[e] + w2 * b2[e]) * rw;
          v4u w; w.x = pk2(y[0], y[1]); w.y = pk2(y[2], y[3]); w.z = pk2(y[4], y[5]); w.w = pk2(y[6], y[7]);
          *(GAS v4u*)(OUT + tokB * 512 + cB * 8) = w; }
    }
}

__device__ __forceinline__ void knorm_phase(Frame& F, const bf16* QKV, float* KN) {
    const int gw = F.bid * NWAVES + F.wave, NGW = F.G * NWAVES;
    for (int it = gw; it < BATCH * 64 * 16; it += NGW) {
        const int hm = it & 15, tile = (it >> 4) & 63, b = it >> 10;
        const bf16* row = QKV + ((size_t)b * SEQ + tile * 64 + F.lane) * 3072 + 1024 + hm * 64;
        float s = 0.f;
#pragma unroll
        for (int c = 0; c < 8; ++c) { float f[8]; ld8(row + 8 * c, f);
#pragma unroll
            for (int e = 0; e < 8; ++e) s += f[e] * f[e]; }
        float mx = sqrtf(s);
#pragma unroll
        for (int o_ = 1; o_ < 64; o_ <<= 1) mx = fmaxf(mx, __shfl_xor(mx, o_));
        if (F.lane == 0) KN[((size_t)b * 16 + hm) * 64 + tile] = mx;
    }
}

__device__ __forceinline__ int wave_sum_i(int v) {
#pragma unroll
    for (int o = 1; o < 64; o <<= 1) v += __shfl_xor(v, o);
    return v;
}
__device__ __forceinline__ void moe_layout(Frame& F, const int* wgcnt, LAS int* tot) {
    int t = 0, bfr = 0;
    for (int w = F.lane; w < F.G; w += 64) { const int c = wgcnt[w * 8 + F.wave]; t += c; bfr += (w < F.bid) ? c : 0; }
    t = wave_sum_i(t); bfr = wave_sum_i(bfr);
    if (F.lane == 0) { tot[F.wave] = t; tot[8 + F.wave] = bfr; }
    __syncthreads();
    if (F.tid == 0) { int ps = 0; for (int e = 0; e < 8; ++e) { tot[16 + e] = ps + tot[8 + e]; ps += ((tot[e] + 255) >> 8) << 8; F.MISC[16 + e] = (unsigned)(ps >> 8); } F.MISC[24] = (unsigned)(ps >> 8); }
    __syncthreads();
}

__device__ __forceinline__ void ropeq_phase(Frame& F, bf16* Q, const float* tab) {
    const int gw = F.bid * NWAVES + F.wave, NGW = F.G * NWAVES;
    for (int r = gw; r < NTOK; r += NGW) {
        GAS v4u* p = (GAS v4u*)(Q + (size_t)r * 1536 + 1024) + F.lane; v4u w = *p;
        const float* t = tab + (size_t)(r % SEQ) * 32 + 8 * (F.lane & 3); const f32x4 c0 = *(const GAS f32x4*)t, c1 = *(const GAS f32x4*)(t + 4);
        float a, b;
        a = bf_lo(w.x); b = bf_hi(w.x); w.x = pk2(a * c0[0] - b * c0[1], a * c0[1] + b * c0[0]);
        a = bf_lo(w.y); b = bf_hi(w.y); w.y = pk2(a * c0[2] - b * c0[3], a * c0[3] + b * c0[2]);
        a = bf_lo(w.z); b = bf_hi(w.z); w.z = pk2(a * c1[0] - b * c1[1], a * c1[1] + b * c1[0]);
        a = bf_lo(w.w); b = bf_hi(w.w); w.w = pk2(a * c1[2] - b * c1[3], a * c1[3] + b * c1[2]);
        *p = w;
    }
}

#ifndef MK_SPLIT
#define MK_SPLIT 0
#endif
#ifndef NAIVE_A
#define NAIVE_A 0
#endif
#ifndef NAIVE_B
#define NAIVE_B 0
#endif
#ifndef NAIVE_C
#define NAIVE_C 0
#endif
#ifndef NAIVE_D
#define NAIVE_D 0
#endif
#ifndef QKVD_F8
#define QKVD_F8 1
#endif
#ifndef FFN2_F8
#define FFN2_F8 1
#endif
constexpr int N_PHASES = 32;
struct Args { const float* in[N_IN]; float* out; unsigned char* ws; int ph_lo, ph_hi; };
static_assert(sizeof(Args) == N_IN * 8 + 8 + 8 + 8, "Args has no padding holes");

__global__ void __launch_bounds__(NWAVES * 64, 2) fwd_kernel(Args args) {
    extern __shared__ __attribute__((aligned(16))) unsigned char lds[];
    Frame F;
    F.lds = (LAS unsigned char*)lds;
    F.MISC = (volatile LAS unsigned*)(F.lds + MISC_OFF);
    F.tid = threadIdx.x; F.lane = F.tid & 63; F.wave = __builtin_amdgcn_readfirstlane(F.tid >> 6);
    F.G = gridDim.x; F.bid = blockIdx.x;
    unsigned char* ws = args.ws;
    F.ctl = (gu32*)(ws + WS_CTL);
    if (F.tid < 64) F.MISC[F.tid] = 0u;
    __syncthreads();
    XcdBarrier bar; bar.bar = (unsigned*)(F.ctl + CW_BAR); bar.x = 0; bar.st = nullptr;
    if (!MK_SPLIT) bar = xcd_barrier_post((unsigned*)(F.ctl + CW_BAR), F.MISC + 8);
    const int lo = args.ph_lo, hi = args.ph_hi;
#ifndef CT_LO
#define CT_LO 0
#endif
#ifndef CT_HI
#define CT_HI 1000
#endif
#define IN(k) ((k) >= CT_LO && (k) < CT_HI && lo <= (k) && (k) < hi)
#ifndef PROBE_MASK
#define PROBE_MASK 0ull
#endif
#define NREP(k) ((((unsigned long long)(PROBE_MASK) >> (k)) & 1ull) ? 2 : 1)
#define SEAM(k) do { if (!MK_SPLIT && IN(k) && IN((k) + 1)) xcd_barrier(bar); } while (0)
#define WSP(T, off) ((T*)(ws + (off)))
#define GEMM_STATIC(EPI_T, Ap, Bp, M_, N_, K_, ...) do { pg8::Gemm g{(const pg8::bf16_t*)(Ap), (const pg8::bf16_t*)(Bp), M_, N_, K_, 0}; pg8::StaticOrder S; S.init(M_, N_, F.G, F.bid); \
        EPI_T E{__VA_ARGS__}; pg8::gemm_phase<EPI_T, pg8::StaticOrder, PG8_ALIGN, PG8_SP2>(F.lds + RING_OFF, g, S, E); } while (0)
#define GEMM_STATIC_LDA(EPI_T, Ap, lda_, Bp, M_, N_, K_, ...) do { pg8::Gemm g{(const pg8::bf16_t*)(Ap), (const pg8::bf16_t*)(Bp), M_, N_, K_, 0, lda_}; pg8::StaticOrder S; S.init(M_, N_, F.G, F.bid); \
        EPI_T E{__VA_ARGS__}; pg8::gemm_phase<EPI_T, pg8::StaticOrder, PG8_ALIGN, PG8_SP2>(F.lds + RING_OFF, g, S, E); } while (0)
#define GEMM_STATIC_F8(EPI_T, Ap, Bp, M_, N_, K_, ...) do { pg8::Gemm g{(const pg8::bf16_t*)(Ap), (const pg8::bf16_t*)(Bp), M_, N_, K_, 0}; pg8::StaticOrder S; S.init(M_, N_, F.G, F.bid); \
        EPI_T E{__VA_ARGS__}; pg8::gemm_phase<EPI_T, pg8::StaticOrder, PG8_ALIGN, PG8_SP2, true>(F.lds + RING_OFF, g, S, E); } while (0)
#define GEMM_MOE(EPI_T, Ap, Bp, N_, K_, ...) do { if (MK_SPLIT) moe_layout(F, WSP(int, WS_WGCNT), (LAS int*)(F.lds + RING_OFF));     \
        pg8::Gemm g{(const pg8::bf16_t*)(Ap), (const pg8::bf16_t*)(Bp), 0, N_, K_, (size_t)(N_) * (K_) * 2}; pg8::MoeOrder S; const int nblk_ = (int)F.MISC[24]; S.so.init(nblk_ * 256, N_, F.G, F.bid); \
        _Pragma("unroll") for (int j_ = 0; j_ < 8; ++j_) S.pend[j_] = __builtin_amdgcn_readfirstlane((int)F.MISC[16 + j_]); \
        __syncthreads(); EPI_T E{__VA_ARGS__}; pg8::gemm_phase<EPI_T, pg8::MoeOrder, PG8_ALIGN, PG8_SP2, true>(F.lds + RING_OFF, g, S, E); } while (0)
    const float* const* in = args.in;
    const bool M3_SPLIT = (F.G == 256) && !MK_SPLIT && lo == 0 && hi >= N_PHASES;
    bf16* H = WSP(bf16, WS_H); bf16* XB = WSP(bf16, WS_XB); bf16* BIG = WSP(bf16, WS_BIG); bf16* XR = WSP(bf16, WS_XR);
    float* SS = WSP(float, WS_SS);
#define SSQ(s) (SS + (size_t)(s) * NTOK * pg8::SSW)
    const float QS = 0.125f * LOG2E;
    const int gw = F.bid * NWAVES + F.wave, NGW = F.G * NWAVES;
    LAS float* scr = (LAS float*)(F.lds + RING_OFF + F.wave * 16384);
#define PH(k) if (IN(k)) for (int rep_ = 0; rep_ < NREP(k); ++rep_)

    PH(0) {
        int base = 0;
        conv_matrix(in[I_A_WQKV], DM, 4608, WSP(bf16, W_QKV_A), MAP_ID, 1536, QS, in[I_A_NORM], scr, gw, NGW, base, F.lane);
        conv_matrix(in[I_A_WO], 512, DM, WSP(bf16, W_O_A), MAP_ID, 0, 1.f, nullptr, scr, gw, NGW, base, F.lane);
        conv_matrix(in[I_F0_WG], DM, FFD, WSP(bf16, W_GU0), MAP_GATE, 0, 1.f, in[I_F0_NORM], scr, gw, NGW, base, F.lane);
        conv_matrix(in[I_F0_WU], DM, FFD, WSP(bf16, W_GU0), MAP_UP, 0, 1.f, in[I_F0_NORM], scr, gw, NGW, base, F.lane);
        conv_matrix(in[I_F0_WD], FFD, DM, WSP(bf16, W_D0), MAP_ID, 0, 1.f, nullptr, scr, gw, NGW, base, F.lane);
        conv_matrix(in[I_B_WQKV], DM, 3072, WSP(bf16, W_QKV_B), MAP_ID, 1024, QS, in[I_B_NORM], scr, gw, NGW, base, F.lane);
        conv_matrix(in[I_B_WO], DM, DM, WSP(bf16, W_O_B), MAP_ID, 0, 1.f, nullptr, scr, gw, NGW, base, F.lane);
        conv_matrix(in[I_C_WIN], DM, 672, WSP(bf16, W_IN_C), MAP_CIN, 0, 1.f, in[I_C_NORM], scr, gw, NGW, base, F.lane);
        conv_matrix(in[I_C_WQUP], 384, 1536, WSP(bf16, W_QUP_C), MAP_CQUP, 1536, 0.10206207261596575f * LOG2E, in[I_C_QNORM], scr, gw, NGW, base, F.lane);
        conv_matrix(in[I_C_WKVUP], 256, 2048, WSP(bf16, W_KVUP_C), MAP_CKVUP, 0, 1.f, in[I_C_KVNORM], scr, gw, NGW, base, F.lane);
        conv_matrix(in[I_C_WO], DM, DM, WSP(bf16, W_O_C), MAP_ID, 0, 1.f, nullptr, scr, gw, NGW, base, F.lane);
        if (FFN2_F8) { conv_matrix_f8(in[I_F2_WG], DM, FFD, ws + W_GU2, MAP_GATE, F8_SW1, in[I_F2_NORM], scr, gw, NGW, base, F.lane); conv_matrix_f8(in[I_F2_WU], DM, FFD, ws + W_GU2, MAP_UP, F8_SW1, in[I_F2_NORM], scr, gw, NGW, base, F.lane);
                       conv_matrix_f8(in[I_F2_WD], FFD, DM, ws + W_D2, MAP_ID, F8_SW2, nullptr, scr, gw, NGW, base, F.lane); }
        else { conv_matrix(in[I_F2_WG], DM, FFD, WSP(bf16, W_GU2), MAP_GATE, 0, 1.f, in[I_F2_NORM], scr, gw, NGW, base, F.lane); conv_matrix(in[I_F2_WU], DM, FFD, WSP(bf16, W_GU2), MAP_UP, 0, 1.f, in[I_F2_NORM], scr, gw, NGW, base, F.lane);
               conv_matrix(in[I_F2_WD], FFD, DM, WSP(bf16, W_D2), MAP_ID, 0, 1.f, nullptr, scr, gw, NGW, base, F.lane); }
        if (QKVD_F8) conv_matrix_f8q(in[I_D_WQKV], DM, 3072, ws + W_QKV_D, MAP_ID, F8_SW1, 1024, QS, in[I_D_NORM], scr, gw, NGW, base, F.lane);
        else conv_matrix(in[I_D_WQKV], DM, 3072, WSP(bf16, W_QKV_D), MAP_ID, 1024, QS, in[I_D_NORM], scr, gw, NGW, base, F.lane);
        conv_matrix(in[I_D_WO], DM, DM, WSP(bf16, W_O_D), MAP_ID, 0, 1.f, nullptr, scr, gw, NGW, base, F.lane);
        conv_moe(in[I_M1_WG], in[I_M1_WU], in[I_M1_WD], in[I_M1_NORM], ws + W_MOE_GU, ws + W_MOE_D, scr, gw, NGW, F.lane);
        conv_moe(in[I_M3_WG], in[I_M3_WU], in[I_M3_WD], in[I_M3_NORM], ws + W_MOE_GU + W_MOE_L2, ws + W_MOE_D + W_MOE_L2, scr, gw, NGW, F.lane, 0, M3_SPLIT ? 4 : NEXP);
        { GAS v4u* z = (GAS v4u*)(ws + W_IN_C + (size_t)672 * DM * 2); const v4u zz = {0u, 0u, 0u, 0u};
          for (int i = F.bid * NWAVES * 64 + F.tid; i < 96 * DM * 2 / 16; i += F.G * NWAVES * 64) z[i] = zz; }
        { float* tab = WSP(float, WS_ROPE);
          for (int i = F.bid * NWAVES * 64 + F.tid; i < SEQ * 16; i += F.G * NWAVES * 64) { const int pos = i >> 4, fi = i & 15;
              const float inv = exp2f(-(float)fi * (13.287712379549449f / 16.0f)); const float ang = (float)pos * inv;
              const double rev = (double)ang * 0.15915494309189535; const float fr = (float)(rev - floor(rev + 0.5));
              tab[2 * i] = __builtin_amdgcn_cosf(fr); tab[2 * i + 1] = __builtin_amdgcn_sinf(fr); } }
        { float* gwr = WSP(float, WS_GWR);
          for (int i = F.bid * NWAVES * 64 + F.tid; i < 2 * DM * 8; i += F.G * NWAVES * 64) { const int l = i >> 13, j = i & 8191;
              gwr[i] = (l ? in[I_M3_WR] : in[I_M1_WR])[j] * (l ? in[I_M3_NORM] : in[I_M1_NORM])[j >> 3]; } }
        row_phase<0>(F, in[I_X], XR, SSQ(0), nullptr, nullptr, nullptr, nullptr, nullptr, nullptr, nullptr, nullptr);
    }
    SEAM(0);
    PH(1) GEMM_STATIC(pg8::EpiBf16, XR, ws + W_QKV_A, NTOK, 4608, DM, BIG, 4608, SSQ(0), 1.0f);
    SEAM(1);
    PH(2) { fast_attn_a(F, BIG, XB, WSP(float, WS_XB + 96 * MiB)); }
    SEAM(2);
    PH(3) { merge_a(F, XB, WSP(float, WS_XB + 96 * MiB), H); }
    SEAM(3);
    PH(4) GEMM_STATIC(pg8::EpiResidB, H, ws + W_O_A, NTOK, DM, 512, XR, DM, 1.0f, SSQ(1), (PG8_LAS float*)(F.lds + RESTAB_OFF), nullptr, 0.0f);
    SEAM(4);
    PH(5) GEMM_STATIC(pg8::EpiSwiglu, XR, ws + W_GU0, NTOK, 2 * FFD, DM, BIG, FFD, SSQ(1));
    SEAM(5);
    PH(6) GEMM_STATIC(pg8::EpiResidB, BIG, ws + W_D0, NTOK, DM, FFD, XR, DM, 1.0f, SSQ(2), (PG8_LAS float*)(F.lds + RESTAB_OFF), nullptr, 0.0f);
    SEAM(6);
    PH(7) GEMM_STATIC(pg8::EpiBf16, XR, ws + W_QKV_B, NTOK, 3072, DM, BIG, 3072, SSQ(2), 1.0f);
    SEAM(7);
    PH(8) { knorm_phase(F, BIG, WSP(float, WS_KN)); }
    SEAM(8);
    PH(9) { fast_attn_b(F, BIG, WSP(float, WS_KN), (unsigned*)(F.ctl + CW_QB), H, in[I_B_LQ1], in[I_B_LK1], in[I_B_LQ2], in[I_B_LK2], in[I_B_SUBLN]); }
    SEAM(9);
    PH(10) GEMM_STATIC(pg8::EpiResidB, H, ws + W_O_B, NTOK, DM, DM, XR, DM, 1.0f, SSQ(3), (PG8_LAS float*)(F.lds + RESTAB_OFF), nullptr, 0.0f);
    SEAM(10);
    PH(11) row_phase<1>(F, nullptr, XR, SSQ(3), nullptr, nullptr, nullptr, nullptr, WSP(float, WS_GWR), WSP(int, WS_TOKE), WSP(float, WS_TOKG), WSP(int, WS_WGCNT));
    SEAM(11);
    PH(12) { LAS int* tot = (LAS int*)(F.lds + RING_OFF); moe_layout(F, WSP(int, WS_WGCNT), tot); slot_phase(F, tot, WSP(int, WS_TOKE), WSP(float, WS_TOKG), WSP(int, WS_TOKS), WSP(float, WS_SGATE), WSP(float, WS_SSS), SSQ(3), XR, (unsigned char*)XB); }
    SEAM(12);
    PH(13) GEMM_MOE(pg8::EpiSwigluF8, XB, ws + W_MOE_GU, 2 * FFE, DM / 2, (unsigned char*)BIG, FFE, 1.0f / (F8_SA * F8_SW1), F8_SACT, WSP(float, WS_SSS), nullptr);
    SEAM(13);
    PH(14) { GEMM_MOE(pg8::EpiMoeDown, BIG, ws + W_MOE_D, DM, FFE / 2, XB, DM, WSP(float, WS_SGATE), 1.0f / (F8_SACT * F8_SW2));
             if (M3_SPLIT && F.bid >= 32) conv_moe(in[I_M3_WG], in[I_M3_WU], in[I_M3_WD], in[I_M3_NORM], ws + W_MOE_GU + W_MOE_L2, ws + W_MOE_D + W_MOE_L2, scr, (F.bid - 32) * NWAVES + F.wave, (F.G - 32) * NWAVES, F.lane, 5, 8); }
    SEAM(14);
    PH(15) row_phase<2>(F, nullptr, XR, SSQ(4), nullptr, nullptr, XB, WSP(int, WS_TOKS), nullptr, nullptr, nullptr, nullptr);
    SEAM(15);
    PH(16) { GEMM_STATIC(pg8::EpiLat, XR, ws + W_IN_C, NTOK, 768, DM, WSP(bf16, C_LAT), SSQ(4), SSQ(8), SSQ(9), (PG8_LAS float*)(F.lds + RESTAB_OFF));
             if (M3_SPLIT && F.bid >= 128) conv_moe(in[I_M3_WG], in[I_M3_WU], in[I_M3_WD], in[I_M3_NORM], ws + W_MOE_GU + W_MOE_L2, ws + W_MOE_D + W_MOE_L2, scr, (F.bid - 128) * NWAVES + F.wave, (F.G - 128) * NWAVES, F.lane, 4, 5); }
    SEAM(16);
    PH(17) { kpe_phase(F, WSP(bf16, C_LAT), WSP(float, WS_ROPE), WSP(bf16, C_KPE));
             GEMM_STATIC_LDA(pg8::EpiBf16, ws + C_LAT, 768, ws + W_QUP_C, NTOK, 1536, 384, WSP(bf16, C_Q), 1536, SSQ(8), 1.0f);
             GEMM_STATIC_LDA(pg8::EpiBf16, ws + C_LAT + 384 * 2, 768, ws + W_KVUP_C, NTOK, 2048, 256, WSP(bf16, C_KV), 2048, SSQ(9), 1.0f); }
    SEAM(19);
    PH(20) { fast_attn_c(F, WSP(bf16, C_Q), WSP(bf16, C_KV), WSP(bf16, C_KPE), WSP(float, WS_ROPE), H); }
    SEAM(20);
    PH(21) { if (FFN2_F8) GEMM_STATIC(pg8::EpiResidB8, H, ws + W_O_C, NTOK, DM, DM, XR, DM, 1.0f, SSQ(5), (PG8_LAS float*)(F.lds + RESTAB_OFF), (unsigned char*)XB, F8_SA); else GEMM_STATIC(pg8::EpiResidB, H, ws + W_O_C, NTOK, DM, DM, XR, DM, 1.0f, SSQ(5), (PG8_LAS float*)(F.lds + RESTAB_OFF), nullptr, 0.0f); }
    SEAM(21);
    PH(22) { if (FFN2_F8) GEMM_STATIC_F8(pg8::EpiSwigluF8, XB, ws + W_GU2, NTOK, 2 * FFD, DM / 2, (unsigned char*)BIG, FFD, 1.0f / (F8_SA * F8_SW1), F8_SACT, nullptr, SSQ(5)); else GEMM_STATIC(pg8::EpiSwiglu, XR, ws + W_GU2, NTOK, 2 * FFD, DM, BIG, FFD, SSQ(5)); }
    SEAM(22);
    PH(23) { if (FFN2_F8 && QKVD_F8) GEMM_STATIC_F8(pg8::EpiResidB8, BIG, ws + W_D2, NTOK, DM, FFD / 2, XR, DM, 1.0f / (F8_SACT * F8_SW2), SSQ(6), (PG8_LAS float*)(F.lds + RESTAB_OFF), (unsigned char*)XB, F8_SA);
             else if (FFN2_F8) GEMM_STATIC_F8(pg8::EpiResidB, BIG, ws + W_D2, NTOK, DM, FFD / 2, XR, DM, 1.0f / (F8_SACT * F8_SW2), SSQ(6), (PG8_LAS float*)(F.lds + RESTAB_OFF), nullptr, 0.0f);
             else GEMM_STATIC(pg8::EpiResidB, BIG, ws + W_D2, NTOK, DM, FFD, XR, DM, 1.0f, SSQ(6), (PG8_LAS float*)(F.lds + RESTAB_OFF), nullptr, 0.0f); }
    SEAM(23);
    PH(24) { if (QKVD_F8) GEMM_STATIC_F8(pg8::EpiBf16, XB, ws + W_QKV_D, NTOK, 3072, DM / 2, BIG, 3072, SSQ(6), 1.0f / (F8_SA * F8_SW1)); else GEMM_STATIC(pg8::EpiBf16, XR, ws + W_QKV_D, NTOK, 3072, DM, BIG, 3072, SSQ(6), 1.0f); }
    SEAM(24);
    PH(25) { fast_attn_d(F, BIG, H); }
    SEAM(25);
    PH(26) GEMM_STATIC(pg8::EpiResidB, H, ws + W_O_D, NTOK, DM, DM, XR, DM, 1.0f, SSQ(7), (PG8_LAS float*)(F.lds + RESTAB_OFF), nullptr, 0.0f);
    SEAM(26);
    PH(27) row_phase<1>(F, nullptr, XR, SSQ(7), nullptr, nullptr, nullptr, nullptr, WSP(float, WS_GWR) + DM * 8, WSP(int, WS_TOKE), WSP(float, WS_TOKG), WSP(int, WS_WGCNT));
    SEAM(27);
    PH(28) { LAS int* tot = (LAS int*)(F.lds + RING_OFF); moe_layout(F, WSP(int, WS_WGCNT), tot); slot_phase(F, tot, WSP(int, WS_TOKE), WSP(float, WS_TOKG), WSP(int, WS_TOKS), WSP(float, WS_SGATE), WSP(float, WS_SSS), SSQ(7), XR, (unsigned char*)XB); }
    SEAM(28);
    PH(29) GEMM_MOE(pg8::EpiSwigluF8, XB, ws + W_MOE_GU + W_MOE_L2, 2 * FFE, DM / 2, (unsigned char*)BIG, FFE, 1.0f / (F8_SA * F8_SW1), F8_SACT, WSP(float, WS_SSS), nullptr);
    SEAM(29);
    PH(30) GEMM_MOE(pg8::EpiMoeDown, BIG, ws + W_MOE_D + W_MOE_L2, DM, FFE / 2, XB, DM, WSP(float, WS_SGATE), 1.0f / (F8_SACT * F8_SW2));
    SEAM(30);
    PH(31) row_phase<3>(F, nullptr, XR, nullptr, in[I_FINAL_NORM], args.out, XB, WSP(int, WS_TOKS), nullptr, nullptr, nullptr, nullptr);
#undef IN
#undef SEAM
}

extern "C" void kernel_launch(void* const* d_in, const int* in_sizes, int n_in, void* d_out, int out_size, void* d_ws, size_t ws_size, hipStream_t stream) {
    static int grid = 0;
    if (grid == 0) {
        if (n_in != N_IN || out_size != NTOK * DM || ws_size < WS_SSS + 5 * MiB) { fprintf(stderr, "kernel_launch: unexpected problem shape (n_in %d, out %d, ws %zu)\n", n_in, out_size, ws_size); grid = -1; return; }
        int dev = 0, cus = 0, per_cu = 0;
        if (hipGetDevice(&dev) != hipSuccess || hipDeviceGetAttribute(&cus, hipDeviceAttributeMultiprocessorCount, dev) != hipSuccess) { grid = -1; return; }
        if (hipFuncSetAttribute((const void*)fwd_kernel, hipFuncAttributeMaxDynamicSharedMemorySize, LDS_BYTES) != hipSuccess) { fprintf(stderr, "kernel_launch: hipFuncSetAttribute failed\n"); grid = -1; return; }
        if (hipOccupancyMaxActiveBlocksPerMultiprocessor(&per_cu, (const void*)fwd_kernel, NWAVES * 64, LDS_BYTES) != hipSuccess || per_cu < 1) { fprintf(stderr, "kernel_launch: occupancy query reports %d\n", per_cu); }
        (void)hipGetLastError();
        grid = cus;
    }
    if (grid < 0) return;
    (void)hipMemsetAsync((char*)d_ws + WS_CTL, 0, CTL_ZERO_BYTES, stream);
    Args a{};
    for (int i = 0; i < N_IN; ++i) a.in[i] = (const float*)d_in[i];
    a.out = (float*)d_out; a.ws = (unsigned char*)d_ws;
#if MK_SPLIT
    for (int p = 0; p < N_PHASES; ++p) { a.ph_lo = p; a.ph_hi = p + 1; hipLaunchKernelGGL(fwd_kernel, dim3(grid), dim3(NWAVES * 64), LDS_BYTES, stream, a); }
#else
    a.ph_lo = 0; a.ph_hi = N_PHASES;
    hipLaunchKernelGGL(fwd_kernel, dim3(grid), dim3(NWAVES * 64), LDS_BYTES, stream, a);
#endif
}
```

```cpp
#include <hip/hip_runtime.h>
#include <cstdio>
#include <cstdint>
#include <cmath>

namespace pg8 {
#define PG8_LAS __attribute__((address_space(3)))
typedef unsigned short bf16_t;
typedef short bf16x8 __attribute__((ext_vector_type(8)));
typedef float f32x4 __attribute__((ext_vector_type(4)));
typedef unsigned u32x4 __attribute__((ext_vector_type(4)));
constexpr int BM = 256, BK = 64, HALF = 128, HTB = HALF * BK * 2  , STAGE_BYTES = 8 * HTB, NXCD = 8, WGM = 8;

__host__ __device__ __forceinline__ int lds_byte(int r, int c) { const int st = (r >> 4) * 2 + (c >> 5), rr = r & 15, cc = c & 31, ob = rr * 64 + cc * 2; return st * 1024 + (ob ^ (((ob >> 9) & 1) << 5)); }
__host__ __device__ __forceinline__ void stage_rc(int b, int& R, int& C) { const int st = b / 1024, sb = b % 1024, swz = sb ^ (((sb >> 9) & 1) << 5); R = (st >> 1) * 16 + swz / 64; C = (st & 1) * 32 + (swz % 64) / 2; }
__host__ __device__ __forceinline__ int perm32(int rho) { const int n = rho >> 4, i = rho & 15; return 8 * (i >> 2) + 4 * n + (i & 3); }

struct Unit { int pm, pn, e; };
struct Gemm { const bf16_t* A; const bf16_t* Bt; int M, N, K; size_t estride; int lda; };

struct StaticOrder {
    int nM, nN, nwg, G, c;
    __host__ __device__ void init(int M, int N, int G_, int c_) { nM = M / BM; nN = N / BM; nwg = nM * nN; G = G_; c = c_; }
    __host__ __device__ bool next(int i, Unit& u) const {
        const long L = (long)i * G + c; if (L >= nwg) return false;
        int wgid = (int)L; { const int q = nwg / NXCD, r = nwg % NXCD, xcd = wgid % NXCD, off = wgid / NXCD; wgid = (xcd < r ? xcd * (q + 1) : r * (q + 1) + (xcd - r) * q) + off; }
        const int nig = WGM * nN, gid = wgid / nig, fm = gid * WGM, gsz = (nM - fm) < WGM ? (nM - fm) : WGM;
        u.pm = fm + ((wgid % nig) % gsz); u.pn = (wgid % nig) / gsz; u.e = 0; return true;
    }
    __device__ __forceinline__ void a_ready(const Unit&) const {}
    __device__ __forceinline__ void done(const Unit&) const {}
};
struct MoeOrder {
    StaticOrder so; int pend[8];
    __device__ __forceinline__ bool next(int i, Unit& u) const {
        if (!so.next(i, u)) return false;
        int e = 0;
#pragma unroll
        for (int j = 0; j < 7; ++j) e += (u.pm >= pend[j]) ? 1 : 0;
        u.e = e; return true;
    }
    __device__ __forceinline__ void a_ready(const Unit&) const {}
    __device__ __forceinline__ void done(const Unit&) const {}
};

__device__ __forceinline__ unsigned cvt_pk_bf16(float lo, float hi) { unsigned r; asm volatile("v_cvt_pk_bf16_f32 %0, %1, %2" : "=v"(r) : "v"(lo), "v"(hi)); return r; }

constexpr int SSW = 4;
__device__ __forceinline__ float rstd_of(const float* ss, int row) {
    const f32x4 a = *(const f32x4*)(ss + (size_t)row * SSW);
    return __builtin_amdgcn_rsqf(((a[0] + a[1]) + (a[2] + a[3])) * (1.0f / 1024.0f) + 1e-6f); }
__device__ __forceinline__ void row_scales8(const float* ss, int row0, float (&rs)[8]) {
    f32x4 t[8];
#pragma unroll
    for (int i = 0; i < 8; ++i) t[i] = *(const f32x4*)(ss + (size_t)(row0 + (i >> 2) * HALF + (i & 3) * 16) * SSW);
#pragma unroll
    for (int i = 0; i < 8; ++i) rs[i] = __builtin_amdgcn_rsqf(((t[i][0] + t[i][1]) + (t[i][2] + t[i][3])) * (1.0f / 1024.0f) + 1e-6f);
}
constexpr int PRE_OFF = 131072 + 9216, PRE_SLOT = 4096;
__device__ __forceinline__ void row_scales8_pre(const PG8_LAS float* pre, int mode, int rl0, float (&rs)[8]) {
    if (mode == 1) {
#pragma unroll
        for (int i = 0; i < 8; ++i) { const f32x4 t = *(const PG8_LAS f32x4*)(pre + (rl0 + (i >> 2) * HALF + (i & 3) * 16) * 4); rs[i] = __builtin_amdgcn_rsqf(((t[0] + t[1]) + (t[2] + t[3])) * (1.0f / 1024.0f) + 1e-6f); }
    } else if (mode == 2) {
#pragma unroll
        for (int i = 0; i < 8; ++i) rs[i] = pre[rl0 + (i >> 2) * HALF + (i & 3) * 16];
    } else {
#pragma unroll
        for (int i = 0; i < 8; ++i) rs[i] = 1.0f; }
}
__device__ __forceinline__ float bflo(unsigned w) { return __builtin_bit_cast(float, w << 16); }
__device__ __forceinline__ float bfhi(unsigned w) { return __builtin_bit_cast(float, w & 0xffff0000u); }
struct EpiBf16 {
    static constexpr bool PERM = true, AFTER_DRAIN = false;
    bf16_t* O; int ldc; const float* ss; float cin;
    __device__ __forceinline__ int pre_desc(const Unit& u, const char*& src) const { src = (const char*)(ss + (size_t)u.pm * BM * SSW); return ss ? 1 : 0; }
    __device__ __forceinline__ void operator()(const f32x4 (&acc)[2][2][4][2], const Unit& u, int wr, int wc, int fr, int fq, const PG8_LAS float* pre) const {
        const int row0 = u.pm * BM + wr * 64 + fr, col0 = u.pn * BM + wc * 32 + 8 * fq;
        float rs8[8];
        row_scales8_pre(pre, ss ? 1 : 0, wr * 64 + fr, rs8);
#pragma unroll
        for (int i = 0; i < 8; ++i) rs8[i] *= cin;
#pragma unroll
        for (int ai = 0; ai < 2; ++ai)
#pragma unroll
            for (int m = 0; m < 4; ++m) { const int row = row0 + ai * HALF + m * 16; bf16_t* rowp = O + (size_t)row * ldc + col0; const float rs = rs8[ai * 4 + m];
#pragma unroll
                for (int bj = 0; bj < 2; ++bj) { const f32x4 v0 = acc[ai][bj][m][0] * rs, v1 = acc[ai][bj][m][1] * rs;
                    u32x4 w; w.x = cvt_pk_bf16(v0[0], v0[1]); w.y = cvt_pk_bf16(v0[2], v0[3]); w.z = cvt_pk_bf16(v1[0], v1[1]); w.w = cvt_pk_bf16(v1[2], v1[3]);
                    *(u32x4*)(rowp + bj * HALF) = w; } }
    }
};
struct EpiLat {
    static constexpr bool PERM = true, AFTER_DRAIN = false;
    bf16_t* O; const float* ss; float* ssq; float* sskv; PG8_LAS float* tab;
    __device__ __forceinline__ int pre_desc(const Unit& u, const char*& src) const { src = (const char*)(ss + (size_t)u.pm * BM * SSW); return 1; }
    __device__ __forceinline__ void operator()(const f32x4 (&acc)[2][2][4][2], const Unit& u, int wr, int wc, int fr, int fq, const PG8_LAS float* pre) const {
        const int row0 = u.pm * BM + wr * 64 + fr, col0 = u.pn * BM + wc * 32 + 8 * fq;
        float rs8[8];
        row_scales8_pre(pre, 1, wr * 64 + fr, rs8);
#pragma unroll
        for (int ai = 0; ai < 2; ++ai)
#pragma unroll
            for (int m = 0; m < 4; ++m) { const int row = row0 + ai * HALF + m * 16; bf16_t* rowp = O + (size_t)row * 768 + col0; const float rs = rs8[ai * 4 + m]; float part[2];
#pragma unroll
                for (int bj = 0; bj < 2; ++bj) { const f32x4 v0 = acc[ai][bj][m][0] * rs, v1 = acc[ai][bj][m][1] * rs;
                    u32x4 w; w.x = cvt_pk_bf16(v0[0], v0[1]); w.y = cvt_pk_bf16(v0[2], v0[3]); w.z = cvt_pk_bf16(v1[0], v1[1]); w.w = cvt_pk_bf16(v1[2], v1[3]);
                    *(u32x4*)(rowp + bj * HALF) = w;
                    part[bj] = (bflo(w.x) * bflo(w.x) + bfhi(w.x) * bfhi(w.x)) + (bflo(w.y) * bflo(w.y) + bfhi(w.y) * bfhi(w.y)) + (bflo(w.z) * bflo(w.z) + bfhi(w.z) * bfhi(w.z)) + (bflo(w.w) * bflo(w.w) + bfhi(w.w) * bfhi(w.w)); }
#pragma unroll
                for (int bj = 0; bj < 2; ++bj) { part[bj] += __shfl_xor(part[bj], 16); part[bj] += __shfl_xor(part[bj], 32); }
                if (fq == 0) { PG8_LAS float* t = tab + (ai * HALF + wr * 64 + m * 16 + fr) * 8 + wc; t[0] = part[0]; t[4] = part[1]; } }
        asm volatile("s_waitcnt lgkmcnt(0)" ::: "memory"); __builtin_amdgcn_s_barrier(); asm volatile("" ::: "memory");
        { const int t = wr * 256 + wc * 64 + fq * 16 + fr;
          if (t < 256) { const f32x4 q0 = *(const PG8_LAS f32x4*)(tab + t * 8), q1 = *(const PG8_LAS f32x4*)(tab + t * 8 + 4);
              const float p0 = (q0[0] + q0[1]) + (q0[2] + q0[3]), p1 = (q1[0] + q1[1]) + (q1[2] + q1[3]); const size_t o = (size_t)(u.pm * BM + t) * SSW;
              const float cq = 1024.0f / 384.0f, ckv = 4.0f;
              if (u.pn == 0) { ssq[o] = (p0 + p1) * cq; ssq[o + 2] = 0.f; ssq[o + 3] = 0.f; }
              else if (u.pn == 1) { ssq[o + 1] = p0 * cq; sskv[o] = p1 * ckv; sskv[o + 2] = 0.f; sskv[o + 3] = 0.f; }
              else { sskv[o + 1] = p0 * ckv; } } }
    }
};
__device__ __forceinline__ float silu_mul(float g, float u) { return g * u * __builtin_amdgcn_rcpf(1.0f + __builtin_amdgcn_exp2f(-1.4426950408889634f * g)); }
__device__ __forceinline__ f32x4 swiglu4(const f32x4 a, const f32x4 b, float kx, float kk) {
    const f32x4 t = a * kx; f32x4 r;
#pragma unroll
    for (int i = 0; i < 4; ++i) r[i] = __builtin_amdgcn_rcpf(1.0f + __builtin_amdgcn_exp2f(t[i]));
    return ((a * b) * r) * kk;
}
struct EpiSwiglu {
    static constexpr bool PERM = true, AFTER_DRAIN = false;
    bf16_t* O; int ldc; const float* ss;
    __device__ __forceinline__ int pre_desc(const Unit& u, const char*& src) const { src = (const char*)(ss + (size_t)u.pm * BM * SSW); return ss ? 1 : 0; }
    __device__ __forceinline__ void operator()(const f32x4 (&acc)[2][2][4][2], const Unit& u, int wr, int wc, int fr, int fq, const PG8_LAS float* pre) const {
        const int row0 = u.pm * BM + wr * 64 + fr, col0 = u.pn * HALF + wc * 32 + 8 * fq;
        float rs8[8];
        row_scales8_pre(pre, ss ? 1 : 0, wr * 64 + fr, rs8);
#pragma unroll
        for (int ai = 0; ai < 2; ++ai)
#pragma unroll
            for (int m = 0; m < 4; ++m) { const int row = row0 + ai * HALF + m * 16; bf16_t* rowp = O + (size_t)row * ldc + col0; const float rs = rs8[ai * 4 + m];
                const float kx = -1.4426950408889634f * rs, kk = rs * rs;
                const f32x4 s0 = swiglu4(acc[ai][0][m][0], acc[ai][1][m][0], kx, kk), s1 = swiglu4(acc[ai][0][m][1], acc[ai][1][m][1], kx, kk);
                u32x4 w; w.x = cvt_pk_bf16(s0[0], s0[1]); w.y = cvt_pk_bf16(s0[2], s0[3]); w.z = cvt_pk_bf16(s1[0], s1[1]); w.w = cvt_pk_bf16(s1[2], s1[3]);
                *(u32x4*)rowp = w; }
    }
};
__device__ __forceinline__ float clamp448(float x) { return __builtin_fminf(__builtin_fmaxf(x, -448.0f), 448.0f); }
__device__ __forceinline__ unsigned pk4_fp8(float a, float b, float c, float d) {
    int w = 0; w = __builtin_amdgcn_cvt_pk_fp8_f32(clamp448(a), clamp448(b), w, false); w = __builtin_amdgcn_cvt_pk_fp8_f32(clamp448(c), clamp448(d), w, true); return (unsigned)w; }
struct EpiSwigluF8 {
    static constexpr bool PERM = true, AFTER_DRAIN = false;
    unsigned char* O; int ldc; float cin, so; const float* rs; const float* ssp;
    __device__ __forceinline__ int pre_desc(const Unit& u, const char*& src) const { src = ssp ? (const char*)(ssp + (size_t)u.pm * BM * SSW) : (const char*)(rs + (size_t)u.pm * BM); return ssp ? 1 : (rs ? 2 : 0); }
    __device__ __forceinline__ void operator()(const f32x4 (&acc)[2][2][4][2], const Unit& u, int wr, int wc, int fr, int fq, const PG8_LAS float* pre) const {
        const int row0 = u.pm * BM + wr * 64 + fr, col0 = u.pn * HALF + wc * 32 + 16 * (fq >> 1);
        float cr[8];
        row_scales8_pre(pre, ssp ? 1 : (rs ? 2 : 0), wr * 64 + fr, cr);
#pragma unroll
        for (int i = 0; i < 8; ++i) cr[i] *= cin;
#pragma unroll
        for (int ai = 0; ai < 2; ++ai)
#pragma unroll
            for (int mp = 0; mp < 2; ++mp) { unsigned lo[2], hi[2];
#pragma unroll
                for (int q = 0; q < 2; ++q) { const int m = 2 * mp + q; const float c = cr[ai * 4 + m];
                    const float kx = -1.4426950408889634f * c, kk = c * c * so;
                    const f32x4 s0 = swiglu4(acc[ai][0][m][0], acc[ai][1][m][0], kx, kk), s1 = swiglu4(acc[ai][0][m][1], acc[ai][1][m][1], kx, kk);
                    lo[q] = pk4_fp8(s0[0], s0[1], s0[2], s0[3]); hi[q] = pk4_fp8(s1[0], s1[1], s1[2], s1[3]); }
                const auto s0 = __builtin_amdgcn_permlane16_swap(lo[0], lo[1], false, false); const auto s1 = __builtin_amdgcn_permlane16_swap(hi[0], hi[1], false, false);
                u32x4 w; w.x = s0[0]; w.y = s1[0]; w.z = s0[1]; w.w = s1[1];
                const int row = row0 + ai * HALF + (2 * mp + (fq & 1)) * 16;
                *(u32x4*)(O + (size_t)row * ldc + col0) = w; }
    }
};
struct EpiResid {
    static constexpr bool PERM = false, AFTER_DRAIN = false;
    const float* base; float* out; int ldc; float cin;
    __device__ __forceinline__ void operator()(const f32x4 (&acc)[2][2][4][2], const Unit& u, int wr, int wc, int fr, int fq) const {
        const int row0 = u.pm * BM + wr * 64 + fr, col0 = u.pn * BM + wc * 32 + 4 * fq;
#pragma unroll
        for (int ai = 0; ai < 2; ++ai)
#pragma unroll
            for (int m = 0; m < 4; ++m) { const size_t off = (size_t)(row0 + ai * HALF + m * 16) * ldc + col0;
#pragma unroll
                for (int bj = 0; bj < 2; ++bj)
#pragma unroll
                    for (int n = 0; n < 2; ++n) { const f32x4 b = *(const f32x4*)(base + off + bj * HALF + n * 16); *(f32x4*)(out + off + bj * HALF + n * 16) = b + acc[ai][bj][m][n] * cin; } }
    }
};
template <bool COPY8> struct EpiResidBT {
    static constexpr bool PERM = true, AFTER_DRAIN = false;
    bf16_t* x; int ldc; float cin; float* ssq; PG8_LAS float* tab; unsigned char* x8; float s8;
    __device__ __forceinline__ int pre_desc(const Unit&, const char*& src) const { src = nullptr; return 0; }
    __device__ __forceinline__ void operator()(const f32x4 (&acc)[2][2][4][2], const Unit& u, int wr, int wc, int fr, int fq, const PG8_LAS float*) const {
        const int row0 = u.pm * BM + wr * 64 + fr, col0 = u.pn * BM + wc * 32 + 8 * fq;
#pragma unroll
        for (int ai = 0; ai < 2; ++ai) { u32x4 b[4][2];
#pragma unroll
            for (int m = 0; m < 4; ++m)
#pragma unroll
                for (int bj = 0; bj < 2; ++bj) b[m][bj] = *(const u32x4*)(x + (size_t)(row0 + ai * HALF + m * 16) * ldc + col0 + bj * HALF);
#pragma unroll
            for (int m = 0; m < 4; ++m) { const int row = row0 + ai * HALF + m * 16; bf16_t* rowp = x + (size_t)row * ldc + col0; float part = 0.f;
#pragma unroll
                for (int bj = 0; bj < 2; ++bj) { const u32x4 bb = b[m][bj]; const f32x4 a0 = acc[ai][bj][m][0], a1 = acc[ai][bj][m][1];
                    const float y0 = __builtin_fmaf(a0[0], cin, bflo(bb.x)), y1 = __builtin_fmaf(a0[1], cin, bfhi(bb.x)), y2 = __builtin_fmaf(a0[2], cin, bflo(bb.y)), y3 = __builtin_fmaf(a0[3], cin, bfhi(bb.y));
                    const float y4 = __builtin_fmaf(a1[0], cin, bflo(bb.z)), y5 = __builtin_fmaf(a1[1], cin, bfhi(bb.z)), y6 = __builtin_fmaf(a1[2], cin, bflo(bb.w)), y7 = __builtin_fmaf(a1[3], cin, bfhi(bb.w));
                    u32x4 w; w.x = cvt_pk_bf16(y0, y1); w.y = cvt_pk_bf16(y2, y3); w.z = cvt_pk_bf16(y4, y5); w.w = cvt_pk_bf16(y6, y7);
                    *(u32x4*)(rowp + bj * HALF) = w;
                    if (COPY8) { const unsigned lo8 = pk4_fp8(y0 * s8, y1 * s8, y2 * s8, y3 * s8), hi8 = pk4_fp8(y4 * s8, y5 * s8, y6 * s8, y7 * s8);
                        *(unsigned long long*)(x8 + (size_t)row * ldc + col0 + bj * HALF) = (unsigned long long)lo8 | ((unsigned long long)hi8 << 32); }
                    part += (y0 * y0 + y1 * y1) + (y2 * y2 + y3 * y3) + (y4 * y4 + y5 * y5) + (y6 * y6 + y7 * y7); }
                part += __shfl_xor(part, 16); part += __shfl_xor(part, 32);
                if (fq == 0) tab[(ai * HALF + wr * 64 + m * 16 + fr) * 4 + wc] = part; } }
        asm volatile("s_waitcnt lgkmcnt(0)" ::: "memory"); __builtin_amdgcn_s_barrier(); asm volatile("" ::: "memory");
        { const int t = wr * 256 + wc * 64 + fq * 16 + fr;
          if (t < 256) { const f32x4 q = *(const PG8_LAS f32x4*)(tab + t * 4); ssq[(size_t)(u.pm * BM + t) * SSW + u.pn] = (q[0] + q[1]) + (q[2] + q[3]); } }
    }
};
typedef EpiResidBT<false> EpiResidB; typedef EpiResidBT<true> EpiResidB8;
struct EpiMoeDown {
    static constexpr bool PERM = true, AFTER_DRAIN = false;
    bf16_t* O; int ldc; const float* gate; float cin;
    __device__ __forceinline__ int pre_desc(const Unit& u, const char*& src) const { src = (const char*)(gate + (size_t)u.pm * BM); return 2; }
    __device__ __forceinline__ void operator()(const f32x4 (&acc)[2][2][4][2], const Unit& u, int wr, int wc, int fr, int fq, const PG8_LAS float* pre) const {
        const int row0 = u.pm * BM + wr * 64 + fr, col0 = u.pn * BM + wc * 32 + 8 * fq;
#pragma unroll
        for (int ai = 0; ai < 2; ++ai)
#pragma unroll
            for (int m = 0; m < 4; ++m) { const int row = row0 + ai * HALF + m * 16; const float gt = pre[wr * 64 + fr + ai * HALF + m * 16] * cin; bf16_t* rowp = O + (size_t)row * ldc + col0;
#pragma unroll
                for (int bj = 0; bj < 2; ++bj) { const f32x4 v0 = acc[ai][bj][m][0] * gt, v1 = acc[ai][bj][m][1] * gt;
                    u32x4 w; w.x = cvt_pk_bf16(v0[0], v0[1]); w.y = cvt_pk_bf16(v0[2], v0[3]); w.z = cvt_pk_bf16(v1[0], v1[1]); w.w = cvt_pk_bf16(v1[2], v1[3]);
                    *(u32x4*)(rowp + bj * HALF) = w; } }
    }
};
struct EpiRope {
    static constexpr bool PERM = true, AFTER_DRAIN = false;
    bf16_t* O; int ldc; const float* tab; int rope_pn0, seq;
    __device__ __forceinline__ void operator()(const f32x4 (&acc)[2][2][4][2], const Unit& u, int wr, int wc, int fr, int fq) const {
        const int row0 = u.pm * BM + wr * 64 + fr, col0 = u.pn * BM + wc * 32 + 8 * fq;
        if (u.pn < rope_pn0) {
#pragma unroll
            for (int ai = 0; ai < 2; ++ai)
#pragma unroll
                for (int m = 0; m < 4; ++m) { bf16_t* rowp = O + (size_t)(row0 + ai * HALF + m * 16) * ldc + col0;
#pragma unroll
                    for (int bj = 0; bj < 2; ++bj) { const f32x4 v0 = acc[ai][bj][m][0], v1 = acc[ai][bj][m][1];
                        u32x4 w; w.x = cvt_pk_bf16(v0[0], v0[1]); w.y = cvt_pk_bf16(v0[2], v0[3]); w.z = cvt_pk_bf16(v1[0], v1[1]); w.w = cvt_pk_bf16(v1[2], v1[3]);
                        *(u32x4*)(rowp + bj * HALF) = w; } }
        } else {
#pragma unroll
            for (int ai = 0; ai < 2; ++ai)
#pragma unroll
                for (int m = 0; m < 4; ++m) { const int row = row0 + ai * HALF + m * 16; bf16_t* rowp = O + (size_t)row * ldc + col0;
                    const float* t = tab + (size_t)(row % seq) * 32 + 8 * fq; const f32x4 c0 = *(const f32x4*)t, c1 = *(const f32x4*)(t + 4);
#pragma unroll
                    for (int bj = 0; bj < 2; ++bj) { const f32x4 v0 = acc[ai][bj][m][0], v1 = acc[ai][bj][m][1];
                        u32x4 w; w.x = cvt_pk_bf16(v0[0] * c0[0] - v0[1] * c0[1], v0[0] * c0[1] + v0[1] * c0[0]); w.y = cvt_pk_bf16(v0[2] * c0[2] - v0[3] * c0[3], v0[2] * c0[3] + v0[3] * c0[2]);
                        w.z = cvt_pk_bf16(v1[0] * c1[0] - v1[1] * c1[1], v1[0] * c1[1] + v1[1] * c1[0]); w.w = cvt_pk_bf16(v1[2] * c1[2] - v1[3] * c1[3], v1[2] * c1[3] + v1[3] * c1[2]);
                        *(u32x4*)(rowp + bj * HALF) = w; }
                    asm volatile("" ::: "memory"); }
        }
    }
};

typedef int v4i_t __attribute__((ext_vector_type(4)));
typedef int v8i_t __attribute__((ext_vector_type(8)));
template <bool FP8> __device__ __forceinline__ void mma_block(f32x4 (&acc)[4][2], const bf16x8 (&At)[4][2], const bf16x8 (&Bt)[2][2]) {
    __builtin_amdgcn_s_setprio(1);
#pragma unroll
    for (int m = 0; m < 4; ++m)
#pragma unroll
        for (int n = 0; n < 2; ++n) {
            if constexpr (FP8) {
                const v8i_t b = __builtin_shufflevector(__builtin_bit_cast(v4i_t, Bt[n][0]), __builtin_bit_cast(v4i_t, Bt[n][1]), 0, 1, 2, 3, 4, 5, 6, 7);
                const v8i_t a = __builtin_shufflevector(__builtin_bit_cast(v4i_t, At[m][0]), __builtin_bit_cast(v4i_t, At[m][1]), 0, 1, 2, 3, 4, 5, 6, 7);
                asm volatile("v_mfma_f32_16x16x128_f8f6f4 %0, %1, %2, %0" : "+v"(acc[m][n]) : "v"(b), "v"(a));
            } else {
#pragma unroll
                for (int k = 0; k < 2; ++k) acc[m][n] = __builtin_amdgcn_mfma_f32_16x16x32_bf16(Bt[n][k], At[m][k], acc[m][n], 0, 0, 0);
            }
        }
    __builtin_amdgcn_s_setprio(0);
}
typedef double f64x2_t __attribute__((ext_vector_type(2)));
__device__ __forceinline__ f32x4 zero4() { double a, b; asm volatile("v_mov_b64 %0, 0" : "=v"(a)); asm volatile("v_mov_b64 %0, 0" : "=v"(b)); const f64x2_t d = {a, b}; return __builtin_bit_cast(f32x4, d); }
template <class Epi, class Sched, bool ALIGN_EPI = false, bool SP2 = false, bool FP8 = false>
__device__ __forceinline__ void gemm_phase(PG8_LAS unsigned char* lds, const Gemm g, const Sched& S, const Epi& E) {
    const int tid = threadIdx.x, wid = __builtin_amdgcn_readfirstlane(tid >> 6), lane = tid & 63, wr = wid >> 2, wc = wid & 3, fr = lane & 15, fq = lane >> 4;
    const int K = g.K, nt = K / BK, lda = g.lda ? g.lda : K;
    unsigned voffA[2], voffB[2];
#pragma unroll
    for (int i = 0; i < 2; ++i) { int R, C; stage_rc(tid * 16 + i * 8192, R, C); const int Rb = Epi::PERM ? ((R & ~31) + perm32(R & 31)) : R;
        voffA[i] = (unsigned)(R * lda + C) * 2u; voffB[i] = (unsigned)(Rb * K + C) * 2u; }
    const size_t kstep = (size_t)(BK * 2);
    const size_t hstep = (size_t)HALF * K * 2;
    const size_t tstep = 2 * hstep;
    const size_t hstepA = (size_t)HALF * lda * 2, tstepA = 2 * hstepA;
    const unsigned ldsw = (unsigned)wid * 1024u;
    const int aoff = lds_byte(wr * 64 + fr, fq * 8), boff = lds_byte(wc * 32 + fr, fq * 8);
#define PG8_SA(b, h) (((b) * 2 + (h)) * HTB)
#define PG8_SB(b, h) ((4 + (b) * 2 + (h)) * HTB)
#define PG8_STAGE(bufoff, gbase, voff) do { _Pragma("unroll") for (int _i = 0; _i < 2; ++_i) \
        __builtin_amdgcn_global_load_lds((const unsigned*)((const char*)(gbase) + (voff)[_i]), (PG8_LAS unsigned*)(lds + (bufoff) + ldsw + _i * 8192), 16, 0, 0); } while (0)
#define PG8_LDA(dst, b, h) do { _Pragma("unroll") for (int m = 0; m < 4; ++m) _Pragma("unroll") for (int k = 0; k < 2; ++k) dst[m][k] = *(const PG8_LAS bf16x8*)(lds + PG8_SA(b, h) + aoff + m * 2048 + k * 1024); } while (0)
#define PG8_LDB(dst, b, h) do { _Pragma("unroll") for (int n = 0; n < 2; ++n) _Pragma("unroll") for (int k = 0; k < 2; ++k) dst[n][k] = *(const PG8_LAS bf16x8*)(lds + PG8_SB(b, h) + boff + n * 2048 + k * 1024); } while (0)
#define PG8_MMA(ai, bj, At, Bt) mma_block<FP8>(acc[ai][bj], At, Bt)
#define PG8_WAIT_V(n) asm volatile("s_waitcnt vmcnt(" #n ")" ::: "memory")
#define PG8_WAIT_L(n) asm volatile("s_waitcnt lgkmcnt(" #n ")" ::: "memory")
#define PG8_BAR __builtin_amdgcn_s_barrier()
#define PG8_SCHED __builtin_amdgcn_sched_barrier(0)
    Unit cur, nxt; int ui = 0;
    if (!S.next(0, cur)) return;
    f32x4 acc[2][2][4][2];
#pragma unroll
    for (int a = 0; a < 2; ++a)
#pragma unroll
        for (int b = 0; b < 2; ++b)
#pragma unroll
            for (int m = 0; m < 4; ++m)
#pragma unroll
                for (int n = 0; n < 2; ++n) acc[a][b][m][n] = zero4();
    bf16x8 At[4][2], B0[2][2], B1[2][2];
    const char* cA = (const char*)g.A + (size_t)cur.pm * tstepA; const char* cB = (const char*)g.Bt + (size_t)cur.e * g.estride + (size_t)cur.pn * tstep;
    S.a_ready(cur);
#define PG8_PRE(unit_, slot_) do { const char* src_; const int md_ = E.pre_desc(unit_, src_); \
        if (md_ == 1) { if (wid < 4) __builtin_amdgcn_global_load_lds((const unsigned*)(src_ + (size_t)(wid * 64 + lane) * 16), (PG8_LAS unsigned*)(lds + PRE_OFF + (slot_) * PRE_SLOT + wid * 1024), 16, 0, 0); } \
        else if (md_ == 2) { if (wid == 0) __builtin_amdgcn_global_load_lds((const unsigned*)(src_ + (size_t)lane * 16), (PG8_LAS unsigned*)(lds + PRE_OFF + (slot_) * PRE_SLOT), 16, 0, 0); } } while (0)
    PG8_PRE(cur, 0);
    if constexpr (SP2) {
        PG8_STAGE(PG8_SB(0, 0), cB, voffB); PG8_STAGE(PG8_SB(0, 1), cB + hstep, voffB); PG8_STAGE(PG8_SA(0, 0), cA, voffA); PG8_STAGE(PG8_SA(0, 1), cA + hstepA, voffA);
        PG8_STAGE(PG8_SB(1, 0), cB + kstep, voffB); PG8_STAGE(PG8_SA(1, 0), cA + kstep, voffA); PG8_STAGE(PG8_SB(1, 1), cB + hstep + kstep, voffB);
        if (wr == 1) PG8_BAR;
        PG8_WAIT_V(8); PG8_BAR;
        PG8_WAIT_V(6); PG8_BAR;
    } else {
        PG8_STAGE(PG8_SB(0, 0), cB, voffB); PG8_STAGE(PG8_SA(0, 0), cA, voffA); PG8_STAGE(PG8_SB(0, 1), cB + hstep, voffB); PG8_STAGE(PG8_SA(0, 1), cA + hstepA, voffA);
        if (wr == 1) PG8_BAR;
        PG8_WAIT_V(4); PG8_BAR;
        PG8_STAGE(PG8_SB(1, 0), cB + kstep, voffB); PG8_STAGE(PG8_SA(1, 0), cA + kstep, voffA); PG8_STAGE(PG8_SB(1, 1), cB + hstep + kstep, voffB);
        PG8_WAIT_V(6); PG8_BAR;
    }
    for (;;) {
        const bool has_next = S.next(ui + 1, nxt);
        const char* nA = has_next ? (const char*)g.A + (size_t)nxt.pm * tstepA : cA; const char* nB = has_next ? (const char*)g.Bt + (size_t)nxt.e * g.estride + (size_t)nxt.pn * tstep : cB;
#pragma nounroll
        for (int t = 0; t < nt; t += 2) {
            const bool last = (t == nt - 2);
            const char* a1 = cA + (size_t)(t + 1) * kstep;
            const char* a2 = last ? nA : cA + (size_t)(t + 2) * kstep; const char* b2 = last ? nB : cB + (size_t)(t + 2) * kstep;
            const char* a3 = a2 + kstep; const char* b3 = b2 + kstep;
            if (last && has_next) S.a_ready(nxt);
            if constexpr (SP2) {
            PG8_LDB(B0, 0, 0); PG8_LDB(B1, 0, 1); PG8_SCHED; PG8_LDA(At, 0, 0); PG8_STAGE(PG8_SA(1, 1), a1 + hstepA, voffA);
            PG8_WAIT_V(8); PG8_WAIT_L(0); PG8_BAR; PG8_MMA(0, 0, At, B0); PG8_MMA(0, 1, At, B1); PG8_BAR; PG8_SCHED;
            PG8_LDA(At, 0, 1); PG8_STAGE(PG8_SB(0, 0), b2, voffB); PG8_STAGE(PG8_SB(0, 1), b2 + hstep, voffB); PG8_STAGE(PG8_SA(0, 0), a2, voffA);
            PG8_WAIT_V(8); PG8_WAIT_L(0); PG8_BAR; PG8_MMA(1, 0, At, B0); PG8_MMA(1, 1, At, B1); PG8_BAR; PG8_SCHED;
            PG8_LDB(B0, 1, 0); PG8_LDB(B1, 1, 1); PG8_SCHED; PG8_LDA(At, 1, 0); PG8_STAGE(PG8_SA(0, 1), a2 + hstepA, voffA);
            PG8_WAIT_V(8); PG8_WAIT_L(0); PG8_BAR; PG8_MMA(0, 0, At, B0); PG8_MMA(0, 1, At, B1); PG8_BAR; PG8_SCHED;
            PG8_LDA(At, 1, 1); PG8_STAGE(PG8_SB(1, 0), b3, voffB); PG8_STAGE(PG8_SB(1, 1), b3 + hstep, voffB); PG8_STAGE(PG8_SA(1, 0), a3, voffA);
            PG8_WAIT_V(8); PG8_WAIT_L(0); PG8_BAR; PG8_MMA(1, 0, At, B0); PG8_MMA(1, 1, At, B1); PG8_BAR; PG8_SCHED;
            } else {
            PG8_LDB(B0, 0, 0); PG8_SCHED; PG8_LDA(At, 0, 0); PG8_STAGE(PG8_SA(1, 1), a1 + hstepA, voffA);
            PG8_WAIT_L(8); PG8_BAR; PG8_WAIT_L(0); PG8_MMA(0, 0, At, B0); PG8_BAR; PG8_SCHED;
            PG8_LDB(B1, 0, 1); PG8_STAGE(PG8_SB(0, 0), b2, voffB);
            PG8_BAR; PG8_WAIT_L(0); PG8_MMA(0, 1, At, B1); PG8_BAR;
            PG8_LDA(At, 0, 1); PG8_STAGE(PG8_SA(0, 0), a2, voffA);
            PG8_BAR; PG8_WAIT_L(0); PG8_MMA(1, 0, At, B0); PG8_BAR; PG8_SCHED;
            PG8_STAGE(PG8_SB(0, 1), b2 + hstep, voffB);
            PG8_WAIT_V(6); PG8_BAR; PG8_MMA(1, 1, At, B1); PG8_BAR;
            PG8_LDB(B0, 1, 0); PG8_SCHED; PG8_LDA(At, 1, 0); PG8_STAGE(PG8_SA(0, 1), a2 + hstepA, voffA);
            PG8_WAIT_L(8); PG8_BAR; PG8_WAIT_L(0); PG8_MMA(0, 0, At, B0); PG8_BAR; PG8_SCHED;
            PG8_LDB(B1, 1, 1); PG8_STAGE(PG8_SB(1, 0), b3, voffB);
            PG8_BAR; PG8_WAIT_L(0); PG8_MMA(0, 1, At, B1); PG8_BAR;
            PG8_LDA(At, 1, 1); PG8_STAGE(PG8_SA(1, 0), a3, voffA);
            PG8_BAR; PG8_WAIT_L(0); PG8_MMA(1, 0, At, B0); PG8_BAR; PG8_SCHED;
            PG8_STAGE(PG8_SB(1, 1), b3 + hstep, voffB);
            PG8_WAIT_V(6); PG8_BAR; PG8_MMA(1, 1, At, B1); PG8_BAR;
            }
        }
        if constexpr (ALIGN_EPI) { if (wr == 0) PG8_BAR; }
        if constexpr (FP8) {
#pragma unroll
            for (int a = 0; a < 2; ++a)
#pragma unroll
                for (int b = 0; b < 2; ++b) asm volatile("s_nop 15\n\ts_nop 15" : "+v"(acc[a][b][0][0]), "+v"(acc[a][b][0][1]), "+v"(acc[a][b][1][0]), "+v"(acc[a][b][1][1]), "+v"(acc[a][b][2][0]), "+v"(acc[a][b][2][1]), "+v"(acc[a][b][3][0]), "+v"(acc[a][b][3][1]));
        }
        if constexpr (!Epi::AFTER_DRAIN) { if (has_next) PG8_PRE(nxt, (ui + 1) & 1);
            E(acc, cur, wr, wc, fr, fq, (const PG8_LAS float*)(lds + PRE_OFF + (ui & 1) * PRE_SLOT)); S.done(cur); }
        if (!has_next) break;
#pragma unroll
        for (int a = 0; a < 2; ++a)
#pragma unroll
            for (int b = 0; b < 2; ++b)
#pragma unroll
                for (int m = 0; m < 4; ++m)
#pragma unroll
                    for (int n = 0; n < 2; ++n) acc[a][b][m][n] = zero4();
        cur = nxt; cA = nA; cB = nB; ++ui;
        if constexpr (ALIGN_EPI) { if (wr == 1) PG8_BAR; }
    }
    PG8_WAIT_V(0);
    if constexpr (!ALIGN_EPI) { if (wr == 0) PG8_BAR; }
    PG8_BAR;
    if constexpr (Epi::AFTER_DRAIN) { E.fused(acc, cur, wr, wc, fr, fq, lds, wid, lane); S.done(cur); }
#undef PG8_PRE
#undef PG8_SA
#undef PG8_SB
#undef PG8_STAGE
#undef PG8_LDA
#undef PG8_LDB
#undef PG8_MMA
#undef PG8_WAIT_V
#undef PG8_WAIT_L
#undef PG8_BAR
#undef PG8_SCHED
}
}
#ifndef PG8_SP2
#define PG8_SP2 true
#endif
#ifndef PG8_ALIGN
#define PG8_ALIGN true
#endif

constexpr int NWAVES = 8;
constexpr int BATCH = 8, SEQ = 4096, DM = 1024, NTOK = BATCH * SEQ;
constexpr int FFD = 2816, FFE = 3584, NEXP = 8;
constexpr int NSLOT = (NTOK * 2 / 256 + NEXP) * 256;
constexpr float NORM_EPS = 1e-6f, SUBLN_EPS = 1e-5f, LOG2E = 1.4426950408889634f;
constexpr int N_IN = 41;
enum { I_X = 0, I_A_NORM, I_A_WQKV, I_A_WO, I_F0_NORM, I_F0_WG, I_F0_WU, I_F0_WD, I_B_NORM, I_B_WQKV, I_B_LQ1, I_B_LK1, I_B_LQ2, I_B_LK2, I_B_SUBLN, I_B_WO,
       I_M1_NORM, I_M1_WR, I_M1_WG, I_M1_WU, I_M1_WD, I_C_NORM, I_C_WIN, I_C_QNORM, I_C_WQUP, I_C_KVNORM, I_C_WKVUP, I_C_WO, I_F2_NORM, I_F2_WG, I_F2_WU, I_F2_WD,
       I_D_NORM, I_D_WQKV, I_D_WO, I_M3_NORM, I_M3_WR, I_M3_WG, I_M3_WU, I_M3_WD, I_FINAL_NORM };

constexpr size_t MiB = 1ull << 20, KiB = 1024;
constexpr size_t WS_CTL = 0, CTL_ZERO_BYTES = 64 * KiB;
constexpr size_t WS_ROPE = 1 * MiB;
constexpr size_t WS_WGCNT = 1 * MiB + 512 * KiB;
constexpr size_t WS_KN = 1 * MiB + 576 * KiB;
constexpr size_t WS_TOKE = 2 * MiB, WS_TOKG = WS_TOKE + 256 * KiB, WS_TOKS = WS_TOKG + 256 * KiB;
constexpr size_t WS_SGATE = 3 * MiB;
constexpr size_t WS_W = 4 * MiB;
constexpr size_t W_QKV_A = WS_W, W_O_A = WS_W + 9 * MiB, W_GU0 = WS_W + 10 * MiB, W_D0 = WS_W + 21 * MiB, W_QKV_B = WS_W + 27 * MiB, W_O_B = WS_W + 33 * MiB,
                 W_IN_C = WS_W + 35 * MiB, W_QUP_C = WS_W + 37 * MiB, W_KVUP_C = WS_W + 39 * MiB, W_O_C = WS_W + 40 * MiB, W_GU2 = WS_W + 42 * MiB, W_D2 = WS_W + 53 * MiB,
                 W_QKV_D = WS_W + 59 * MiB, W_O_D = WS_W + 65 * MiB;
constexpr size_t W_MOE_GU = 72 * MiB, W_MOE_D = 128 * MiB, W_MOE_L2 = 84 * MiB;
constexpr size_t WS_H = 240 * MiB;
constexpr size_t WS_XB = 304 * MiB;
constexpr size_t WS_BIG = 436 * MiB;
constexpr size_t WS_END = 898 * MiB;
constexpr size_t WS_XR = WS_BIG + 288 * MiB;
constexpr size_t WS_SS = WS_END, SS_BYTES = 16 * MiB;
constexpr size_t WS_SSS = WS_END + 16 * MiB;
constexpr size_t WS_GWR = 1 * MiB + 640 * KiB;
static_assert(WS_BIG + (size_t)NSLOT * FFE * 2 <= WS_END && WS_XB + (size_t)NSLOT * DM * 2 <= WS_BIG && WS_H + (size_t)NTOK * DM * 2 <= WS_XB && W_MOE_D + W_MOE_L2 + 8ull * 1024 * 3584 <= WS_H, "d_ws map");
constexpr size_t C_LAT = WS_BIG, C_Q = WS_BIG + 48 * MiB, C_KV = WS_BIG + 144 * MiB;
constexpr size_t C_QN = WS_XB, C_KVN = WS_XB + 24 * MiB, C_KPE = WS_XB + 40 * MiB;
constexpr int CW_TMO = 0, CW_QB = 64, CW_BAR = 4096;

constexpr int RING_OFF = 0, RING_BYTES = 131072;
constexpr int MISC_OFF = RING_BYTES + 320;
constexpr int RESTAB_OFF = RING_BYTES + 1024;
constexpr int LDS_BYTES = 149504;
static_assert(RESTAB_OFF + 8192 <= pg8::PRE_OFF && pg8::PRE_OFF + 2 * pg8::PRE_SLOT <= LDS_BYTES, "LDS map");
#define GAS __attribute__((address_space(1)))
#define LAS __attribute__((address_space(3)))
typedef unsigned short bf16;
typedef unsigned v4u __attribute__((ext_vector_type(4)));
typedef float f32x4 __attribute__((ext_vector_type(4)));
typedef short bf16x8 __attribute__((ext_vector_type(8)));
typedef GAS unsigned gu32;
typedef GAS unsigned long long gu64;
#define RLX_AGENT __ATOMIC_RELAXED, __HIP_MEMORY_SCOPE_AGENT
#define LDS_WAIT() asm volatile("s_waitcnt lgkmcnt(0)" ::: "memory")
#define VM_WAIT() asm volatile("s_waitcnt vmcnt(0)" ::: "memory")
__device__ __forceinline__ unsigned long long rt() { return __builtin_amdgcn_s_memrealtime(); }
__device__ __forceinline__ unsigned f2bf(float f) { unsigned u = __builtin_bit_cast(unsigned, f); return (u + 0x7fffu + ((u >> 16) & 1u)) >> 16; }
__device__ __forceinline__ unsigned pk2(float lo, float hi) { return f2bf(lo) | (f2bf(hi) << 16); }

#define XB_TMO      128
#define XB_XCNT(j)  (256  + 64 * (j))
#define XB_XSUB(j)  (1280 + 64 * (j))
#define XB_XGEN(j)  (2304 + 64 * (j))
#define XB_TOP      3328
#define XB_TOPGEN   3392
#define XCD_BAR_WORDS 3456
#define XB_SPIN_CAP (1u << 18)

__device__ __forceinline__ unsigned xb_ld(unsigned* p)              { return __hip_atomic_load(p, __ATOMIC_RELAXED, __HIP_MEMORY_SCOPE_AGENT); }
__device__ __forceinline__ unsigned xb_add(unsigned* p, unsigned v) { return __hip_atomic_fetch_add(p, v, __ATOMIC_RELAXED, __HIP_MEMORY_SCOPE_AGENT); }
__device__ __forceinline__ unsigned xb_xcc_id() { return (unsigned)__builtin_amdgcn_s_getreg((3 << 11) | 20) & 0xFu; }
#define XB_SPIN(cond, bar) do { unsigned _sp = 0; while (cond) { __builtin_amdgcn_s_sleep(1); \
    if ((++_sp & 255u) == 0u) { if (xb_ld(&(bar)[XB_TMO])) break; if (_sp > XB_SPIN_CAP) { atomicAdd(&(bar)[XB_TMO], 1u); break; } } } } while (0)

struct XcdBarrier {
    unsigned* bar; unsigned x;
    volatile LAS unsigned* st;
};

__device__ __forceinline__ XcdBarrier xcd_barrier_post(unsigned* bar, volatile LAS unsigned* st) {
    XcdBarrier b; b.bar = bar; b.x = xb_xcc_id(); b.st = st;
    if (threadIdx.x == 0) (void)xb_add(&bar[XB_XCNT(b.x)], 1u);
    return b;
}
__device__ __forceinline__ void xcd_barrier_complete(unsigned* bar, unsigned x, unsigned& nloc, unsigned& nx) {
    const unsigned G = gridDim.x * gridDim.y * gridDim.z;
    unsigned sum, cnt, mine, sp = 0u;
    for (;;) {
        sum = 0u; cnt = 0u; mine = 0u;
#pragma unroll
        for (unsigned j = 0; j < 16; ++j) { const unsigned c = xb_ld(&bar[XB_XCNT(j)]); sum += c; cnt += (c > 0u) ? 1u : 0u; mine = (j == x) ? c : mine; }
        if (sum == G) break;
        __builtin_amdgcn_s_sleep(1);
        if ((++sp & 255u) == 0u) { if (xb_ld(&bar[XB_TMO])) break; if (sp > XB_SPIN_CAP) { atomicAdd(&bar[XB_TMO], 1u); break; } }
    }
    nloc = mine > 0u ? mine : 1u; nx = cnt > 0u ? cnt : 1u;
}

__device__ __forceinline__ void xcd_barrier(const XcdBarrier& b) {
    asm volatile("s_waitcnt vmcnt(0)" ::: "memory");
    __syncthreads();
    if (threadIdx.x == 0) {
        unsigned* bar = b.bar;
        __builtin_amdgcn_s_waitcnt(0);
        unsigned nloc = b.st[0], nx = b.st[1];
        if (nloc == 0u) { xcd_barrier_complete(bar, b.x, nloc, nx); b.st[0] = nloc; b.st[1] = nx; }
        const unsigned old = xb_add(&bar[XB_XSUB(b.x)], 1u);
        const unsigned gen = old / nloc;
        if (old + 1u == (gen + 1u) * nloc) {
            __builtin_amdgcn_fence(__ATOMIC_RELEASE, "agent");
            asm volatile("s_waitcnt vmcnt(0)" ::: "memory");
            const unsigned og = xb_add(&bar[XB_TOP], 1u);
            const unsigned tg = og / nx;
            if (og + 1u == (tg + 1u) * nx) xb_add(&bar[XB_TOPGEN], 1u);
            else XB_SPIN(xb_ld(&bar[XB_TOPGEN]) == tg, bar);
            __builtin_amdgcn_fence(__ATOMIC_ACQUIRE, "agent");
            xb_add(&bar[XB_XGEN(b.x)], 1u);
            asm volatile("s_waitcnt vmcnt(0)" ::: "memory");
        } else {
            XB_SPIN(xb_ld(&bar[XB_XGEN(b.x)]) == gen, bar);
            __builtin_amdgcn_fence(__ATOMIC_ACQUIRE, "agent");
            asm volatile("s_waitcnt vmcnt(0)" ::: "memory");
        }
    }
    __syncthreads();
}

__device__ __forceinline__ float wave_sum(float v) {
#pragma unroll
    for (int o = 1; o < 64; o <<= 1) v += __shfl_xor(v, o);
    return v;
}
__device__ __forceinline__ float bf_lo(unsigned w) { return __builtin_bit_cast(float, w << 16); }
__device__ __forceinline__ float bf_hi(unsigned w) { return __builtin_bit_cast(float, w & 0xffff0000u); }
__device__ __forceinline__ void ld8(const bf16* p, float* f) {
    const v4u w = *(const GAS v4u*)p;
    f[0] = bf_lo(w.x); f[1] = bf_hi(w.x); f[2] = bf_lo(w.y); f[3] = bf_hi(w.y); f[4] = bf_lo(w.z); f[5] = bf_hi(w.z); f[6] = bf_lo(w.w); f[7] = bf_hi(w.w);
}
__device__ __forceinline__ float ex2(float x) { return __builtin_amdgcn_exp2f(x); }

struct Frame {
    LAS unsigned char* lds;
    volatile LAS unsigned* MISC;
    gu32* ctl;
    int tid, lane, wave, G, bid;
    const float* const* in;
};

enum { MAP_ID = 0, MAP_GATE, MAP_UP, MAP_CIN, MAP_CQUP, MAP_CKVUP };
__device__ __forceinline__ int map_row(int map, int n) {
    if (map == MAP_GATE) return ((n >> 7) << 8) + (n & 127);
    if (map == MAP_UP) return ((n >> 7) << 8) + 128 + (n & 127);
    if (map == MAP_CIN) { if (n < 640) return n; const int i = n - 640; return 640 + ((i & 15) << 1) + (i >> 4); }
    if (map == MAP_CQUP) { const int h = n / 96, j = n - 96 * h; if (j < 64) return 64 * h + j; const int i = j - 64; return 1024 + 32 * h + ((i & 15) << 1) + (i >> 4); }
    if (map == MAP_CKVUP) { const int h = n >> 7, j = n & 127; return j < 64 ? 64 * h + j : 1024 + 64 * h + (j - 64); }
    return n;
}
__device__ __forceinline__ void conv_item(const float* W, int K, int N, bf16* WT, int map, int nscale, float scale, const float* gain, LAS float* scr, int item, int lane) {
    const int nblk = N / 32, kb = item / nblk, nb = item - kb * nblk, k0 = 64 * kb, n0 = 32 * nb;
#pragma unroll
    for (int i = 0; i < 8; ++i) { const int kk = 8 * i + (lane >> 3); const f32x4 w = *(const GAS f32x4*)(W + (size_t)(k0 + kk) * N + n0 + 4 * (lane & 7));
        const float gk = gain ? gain[k0 + kk] : 1.0f;
        LAS float* dd = scr + kk * 33 + 4 * (lane & 7); dd[0] = w.x * gk; dd[1] = w.y * gk; dd[2] = w.z * gk; dd[3] = w.w * gk; }
    LDS_WAIT(); asm volatile("" ::: "memory");
    const int c = lane & 7;
#pragma unroll
    for (int j = 0; j < 4; ++j) { const int n = (lane >> 3) + 8 * j; const LAS float* s = scr + (8 * c) * 33 + n; const int nn = n0 + n; const float sc = nn < nscale ? scale : 1.0f;
        v4u o; o.x = pk2(s[0 * 33] * sc, s[1 * 33] * sc); o.y = pk2(s[2 * 33] * sc, s[3 * 33] * sc); o.z = pk2(s[4 * 33] * sc, s[5 * 33] * sc); o.w = pk2(s[6 * 33] * sc, s[7 * 33] * sc);
        *(GAS v4u*)(WT + (size_t)map_row(map, nn) * K + k0 + 8 * c) = o; }
    LDS_WAIT(); asm volatile("" ::: "memory");
}
__device__ __forceinline__ void conv_matrix(const float* W, int K, int N, bf16* WT, int map, int nscale, float scale, const float* gain, LAS float* scr, int gw, int NGW, int& base, int lane) {
    const int nit = (K / 64) * (N / 32);
    int first = gw - base; if (first < 0) first += NGW;
    for (int it = first; it < nit; it += NGW) conv_item(W, K, N, WT, map, nscale, scale, gain, scr, it, lane);
    base = (base + nit) % NGW;
}
__device__ __forceinline__ void conv_item_f8(const float* W, int K, int N, unsigned char* WT, int map, float scale, const float* gain, LAS float* scr, int item, int lane) {
    const int nblk = N / 32, kb = item / nblk, nb = item - kb * nblk, k0 = 64 * kb, n0 = 32 * nb;
#pragma unroll
    for (int i = 0; i < 8; ++i) { const int kk = 8 * i + (lane >> 3); const f32x4 w = *(const GAS f32x4*)(W + (size_t)(k0 + kk) * N + n0 + 4 * (lane & 7));
        const float gk = gain ? gain[k0 + kk] : 1.0f;
        LAS float* dd = scr + kk * 33 + 4 * (lane & 7); dd[0] = w.x * gk; dd[1] = w.y * gk; dd[2] = w.z * gk; dd[3] = w.w * gk; }
    LDS_WAIT(); asm volatile("" ::: "memory");
    const int c = lane & 3;
#pragma unroll
    for (int j = 0; j < 2; ++j) { const int n = (lane >> 2) + 16 * j; const LAS float* s = scr + (16 * c) * 33 + n;
        v4u o; o.x = pg8::pk4_fp8(s[0 * 33] * scale, s[1 * 33] * scale, s[2 * 33] * scale, s[3 * 33] * scale); o.y = pg8::pk4_fp8(s[4 * 33] * scale, s[5 * 33] * scale, s[6 * 33] * scale, s[7 * 33] * scale);
        o.z = pg8::pk4_fp8(s[8 * 33] * scale, s[9 * 33] * scale, s[10 * 33] * scale, s[11 * 33] * scale); o.w = pg8::pk4_fp8(s[12 * 33] * scale, s[13 * 33] * scale, s[14 * 33] * scale, s[15 * 33] * scale);
        *(GAS v4u*)(WT + (size_t)map_row(map, n0 + n) * K + k0 + 16 * c) = o; }
    LDS_WAIT(); asm volatile("" ::: "memory");
}
__device__ __forceinline__ void conv_item_f8q(const float* W, int K, int N, unsigned char* WT, int map, float scale, int nscale, float qscale, const float* gain, LAS float* scr, int item, int lane) {
    const int nblk = N / 32, kb = item / nblk, nb = item - kb * nblk, k0 = 64 * kb, n0 = 32 * nb;
#pragma unroll
    for (int i = 0; i < 8; ++i) { const int kk = 8 * i + (lane >> 3); const f32x4 w = *(const GAS f32x4*)(W + (size_t)(k0 + kk) * N + n0 + 4 * (lane & 7));
        const float gk = (gain ? gain[k0 + kk] : 1.0f) * scale * ((n0 < nscale) ? qscale : 1.0f);
        LAS float* dd = scr + kk * 33 + 4 * (lane & 7); dd[0] = w.x * gk; dd[1] = w.y * gk; dd[2] = w.z * gk; dd[3] = w.w * gk; }
    LDS_WAIT(); asm volatile("" ::: "memory");
    const int c = lane & 3;
#pragma unroll
    for (int j = 0; j < 2; ++j) { const int n = (lane >> 2) + 16 * j; const LAS float* s = scr + (16 * c) * 33 + n;
        v4u o; o.x = pg8::pk4_fp8(s[0 * 33], s[1 * 33], s[2 * 33], s[3 * 33]); o.y = pg8::pk4_fp8(s[4 * 33], s[5 * 33], s[6 * 33], s[7 * 33]);
        o.z = pg8::pk4_fp8(s[8 * 33], s[9 * 33], s[10 * 33], s[11 * 33]); o.w = pg8::pk4_fp8(s[12 * 33], s[13 * 33], s[14 * 33], s[15 * 33]);
        *(GAS v4u*)(WT + (size_t)map_row(map, n0 + n) * K + k0 + 16 * c) = o; }
    LDS_WAIT(); asm volatile("" ::: "memory");
}
__device__ __forceinline__ void conv_matrix_f8q(const float* W, int K, int N, unsigned char* WT, int map, float scale, int nscale, float qscale, const float* gain, LAS float* scr, int gw, int NGW, int& base, int lane) {
    const int nit = (K / 64) * (N / 32);
    int first = gw - base; if (first < 0) first += NGW;
    for (int it = first; it < nit; it += NGW) conv_item_f8q(W, K, N, WT, map, scale, nscale, qscale, gain, scr, it, lane);
    base = (base + nit) % NGW;
}
__device__ __forceinline__ void conv_matrix_f8(const float* W, int K, int N, unsigned char* WT, int map, float scale, const float* gain, LAS float* scr, int gw, int NGW, int& base, int lane) {
    const int nit = (K / 64) * (N / 32);
    int first = gw - base; if (first < 0) first += NGW;
    for (int it = first; it < nit; it += NGW) conv_item_f8(W, K, N, WT, map, scale, gain, scr, it, lane);
    base = (base + nit) % NGW;
}
constexpr float F8_SA = 16.0f, F8_SW1 = 512.0f, F8_SACT = 8.0f, F8_SW2 = 1024.0f;
__device__ __forceinline__ void conv_moe(const float* Wg, const float* Wu, const float* Wd, const float* gain, unsigned char* wgu, unsigned char* wd, LAS float* scr, int gw, int NGW, int lane, int e_lo = 0, int e_hi = NEXP) {
    int base = 0;
    for (int e = e_lo; e < e_hi; ++e) {
        unsigned char* gu = wgu + (size_t)e * 2 * FFE * DM;
        conv_matrix_f8(Wg + (size_t)e * DM * FFE, DM, FFE, gu, MAP_GATE, F8_SW1, gain, scr, gw, NGW, base, lane);
        conv_matrix_f8(Wu + (size_t)e * DM * FFE, DM, FFE, gu, MAP_UP, F8_SW1, gain, scr, gw, NGW, base, lane);
        conv_matrix_f8(Wd + (size_t)e * FFE * DM, FFE, DM, wd + (size_t)e * DM * FFE, MAP_ID, F8_SW2, nullptr, scr, gw, NGW, base, lane);
    }
}

__device__ __forceinline__ void rowb_load(const bf16* xrow, int lane, float (&v)[16]) { ld8(xrow + 8 * lane, v); ld8(xrow + 512 + 8 * lane, v + 8); }
__device__ __forceinline__ void rowb_add(const bf16* yrow, int lane, float (&v)[16]) { float t[16]; ld8(yrow + 8 * lane, t); ld8(yrow + 512 + 8 * lane, t + 8);
#pragma unroll
    for (int i = 0; i < 16; ++i) v[i] += t[i]; }
__device__ __forceinline__ float rowb_store_ss(bf16* xrow, int lane, const float (&v)[16]) {
    unsigned w[8]; float s = 0.f;
#pragma unroll
    for (int i = 0; i < 8; ++i) { w[i] = pk2(v[2 * i], v[2 * i + 1]); const float a = bf_lo(w[i]), b = bf_hi(w[i]); s += a * a + b * b; }
    v4u o0 = {w[0], w[1], w[2], w[3]}, o1 = {w[4], w[5], w[6], w[7]};
    *(GAS v4u*)(xrow + 8 * lane) = o0; *(GAS v4u*)(xrow + 512 + 8 * lane) = o1;
    return wave_sum(s);
}
__device__ __forceinline__ float ss_total(const float* ss, int row) { const f32x4 a = *(const GAS f32x4*)(ss + (size_t)row * pg8::SSW); return (a[0] + a[1]) + (a[2] + a[3]); }
__device__ __forceinline__ void ss_store(float* ss, int row, float s, int lane) { if (lane == 0) *(GAS f32x4*)(ss + (size_t)row * pg8::SSW) = (f32x4){s, 0.f, 0.f, 0.f}; }
template <int MODE>
__device__ __forceinline__ void row_phase(Frame& F, const float* xin, bf16* XR, float* ss, const float* g, float* out, const bf16* Y, const int* toks,
                                          const float* gWr, int* toke, float* tokg, int* wgcnt) {
    const int RPW = (NTOK + F.G - 1) / F.G; const int r0 = F.bid * RPW, r1 = (r0 + RPW < NTOK) ? r0 + RPW : NTOK;
    LAS int* cnt = (LAS int*)(F.lds + RING_OFF);
    if (MODE == 1) { if (F.tid < 8) cnt[F.tid] = 0; __syncthreads(); }
    f32x4 wr[16][2];
    if (MODE == 1) {
#pragma unroll
        for (int i = 0; i < 16; ++i) { const int k = (i < 8) ? 8 * F.lane + i : 512 + 8 * F.lane + (i - 8); wr[i][0] = *(const GAS f32x4*)(gWr + (size_t)k * 8); wr[i][1] = *(const GAS f32x4*)(gWr + (size_t)k * 8 + 4); } }
    if (MODE == 0) {
        for (int rA = r0 + F.wave; rA < r1; rA += 2 * NWAVES) {
            const bool hasB = rA + NWAVES < r1; const int rB = hasB ? rA + NWAVES : rA;
            const GAS f32x4* xa = (const GAS f32x4*)(xin + (size_t)rA * DM); const GAS f32x4* xb = (const GAS f32x4*)(xin + (size_t)rB * DM);
            const f32x4 a0 = xa[2 * F.lane], a1 = xa[2 * F.lane + 1], a2 = xa[128 + 2 * F.lane], a3 = xa[128 + 2 * F.lane + 1];
            const f32x4 c0 = xb[2 * F.lane], c1 = xb[2 * F.lane + 1], c2 = xb[128 + 2 * F.lane], c3 = xb[128 + 2 * F.lane + 1];
            { float v[16] = {a0.x, a0.y, a0.z, a0.w, a1.x, a1.y, a1.z, a1.w, a2.x, a2.y, a2.z, a2.w, a3.x, a3.y, a3.z, a3.w};
              const float s = rowb_store_ss(XR + (size_t)rA * DM, F.lane, v); ss_store(ss, rA, s, F.lane); }
            if (hasB) { float v[16] = {c0.x, c0.y, c0.z, c0.w, c1.x, c1.y, c1.z, c1.w, c2.x, c2.y, c2.z, c2.w, c3.x, c3.y, c3.z, c3.w};
              const float s = rowb_store_ss(XR + (size_t)rB * DM, F.lane, v); ss_store(ss, rB, s, F.lane); } }
    } else {
        for (int rA = r0 + F.wave; rA < r1; rA += 2 * NWAVES) {
            const bool hasB = rA + NWAVES < r1; const int rB = hasB ? rA + NWAVES : rA;
            float vA[16], vB[16]; int sA0 = 0, sA1 = 0, sB0 = 0, sB1 = 0; float tA = 0.f, tB = 0.f;
            if (MODE == 2 || MODE == 3) { sA0 = toks[2 * rA]; sA1 = toks[2 * rA + 1]; sB0 = toks[2 * rB]; sB1 = toks[2 * rB + 1]; }
            rowb_load(XR + (size_t)rA * DM, F.lane, vA); rowb_load(XR + (size_t)rB * DM, F.lane, vB);
            if (MODE == 1) { tA = ss_total(ss, rA); tB = ss_total(ss, rB); }
            if (MODE == 2 || MODE == 3) { float yA0[16], yA1[16], yB0[16], yB1[16];
                rowb_load(Y + (size_t)sA0 * DM, F.lane, yA0); rowb_load(Y + (size_t)sA1 * DM, F.lane, yA1); rowb_load(Y + (size_t)sB0 * DM, F.lane, yB0); rowb_load(Y + (size_t)sB1 * DM, F.lane, yB1);
#pragma unroll
                for (int i = 0; i < 16; ++i) { vA[i] = (vA[i] + yA0[i]) + yA1[i]; vB[i] = (vB[i] + yB0[i]) + yB1[i]; } }
#pragma unroll
            for (int half = 0; half < 2; ++half) {
                if (half == 1 && !hasB) break;
                const int r = half ? rB : rA; float (&v)[16] = half ? vB : vA;
                if (MODE == 2) { const float s = rowb_store_ss(XR + (size_t)r * DM, F.lane, v); ss_store(ss, r, s, F.lane); }
                if (MODE == 3) { float s = 0.f;
#pragma unroll
                    for (int i = 0; i < 16; ++i) s += v[i] * v[i];
                    const float rstd = 1.0f / sqrtf(wave_sum(s) * (1.0f / DM) + NORM_EPS);
                    const GAS f32x4* gr = (const GAS f32x4*)g; const f32x4 g0 = gr[2 * F.lane], g1 = gr[2 * F.lane + 1], g2 = gr[128 + 2 * F.lane], g3 = gr[128 + 2 * F.lane + 1];
                    GAS f32x4* orow = (GAS f32x4*)(out + (size_t)r * DM);
                    orow[2 * F.lane] = (f32x4){v[0], v[1], v[2], v[3]} * rstd * g0; orow[2 * F.lane + 1] = (f32x4){v[4], v[5], v[6], v[7]} * rstd * g1;
                    orow[128 + 2 * F.lane] = (f32x4){v[8], v[9], v[10], v[11]} * rstd * g2; orow[128 + 2 * F.lane + 1] = (f32x4){v[12], v[13], v[14], v[15]} * rstd * g3; }
                if (MODE == 1) {
                    const float rstd = 1.0f / sqrtf((half ? tB : tA) * (1.0f / DM) + NORM_EPS);
                    float lg[8];
#pragma unroll
                    for (int e = 0; e < 8; ++e) lg[e] = 0.f;
#pragma unroll
                    for (int i = 0; i < 16; ++i) { const f32x4 w0 = wr[i][0], w1 = wr[i][1]; const float hv = v[i];
                        lg[0] += hv * w0.x; lg[1] += hv * w0.y; lg[2] += hv * w0.z; lg[3] += hv * w0.w; lg[4] += hv * w1.x; lg[5] += hv * w1.y; lg[6] += hv * w1.z; lg[7] += hv * w1.w; }
                    {
                        const bool b5 = (F.lane & 32) != 0, b4 = (F.lane & 16) != 0, b3 = (F.lane & 8) != 0;
                        float a4[4], a2[2];
#pragma unroll
                        for (int i = 0; i < 4; ++i) { const float keep = b5 ? lg[4 + i] : lg[i], send = b5 ? lg[i] : lg[4 + i]; a4[i] = keep + __shfl_xor(send, 32); }
#pragma unroll
                        for (int i = 0; i < 2; ++i) { const float keep = b4 ? a4[2 + i] : a4[i], send = b4 ? a4[i] : a4[2 + i]; a2[i] = keep + __shfl_xor(send, 16); }
                        float c = (b3 ? a2[1] : a2[0]) + __shfl_xor(b3 ? a2[0] : a2[1], 8);
                        c += __shfl_xor(c, 4); c += __shfl_xor(c, 2); c += __shfl_xor(c, 1);
                        c *= rstd;
#pragma unroll
                        for (int e = 0; e < 8; ++e) lg[e] = __builtin_bit_cast(float, __builtin_amdgcn_readlane(__builtin_bit_cast(int, c), 8 * e));
                    }
                    int e0 = 0; float l0 = lg[0];
#pragma unroll
                    for (int e = 1; e < 8; ++e) if (lg[e] > l0) { l0 = lg[e]; e0 = e; }
                    int e1 = -1; float l1 = -INFINITY;
#pragma unroll
                    for (int e = 0; e < 8; ++e) if (e != e0 && lg[e] > l1) { l1 = lg[e]; e1 = e; }
                    const float g0 = 1.0f / (1.0f + __expf(l1 - l0)), g1 = 1.0f - g0;
                    if (F.lane == 0) { toke[2 * r] = e0; toke[2 * r + 1] = e1; tokg[2 * r] = g0; tokg[2 * r + 1] = g1; __hip_atomic_fetch_add(&cnt[e0], 1, __ATOMIC_RELAXED, __HIP_MEMORY_SCOPE_WORKGROUP); __hip_atomic_fetch_add(&cnt[e1], 1, __ATOMIC_RELAXED, __HIP_MEMORY_SCOPE_WORKGROUP); }
                }
            }
        }
    }
    if (MODE == 1) { __syncthreads(); if (F.tid < 8) wgcnt[F.bid * 8 + F.tid] = cnt[F.tid]; __syncthreads(); }
}

__device__ __forceinline__ void slot_phase(Frame& F, LAS int* tot, const int* toke, const float* tokg, int* toks, float* sgate, float* sss, const float* ss, const bf16* XR, unsigned char* XB) {
    const int RPW = (NTOK + F.G - 1) / F.G; const int r0 = F.bid * RPW, r1 = (r0 + RPW < NTOK) ? r0 + RPW : NTOK;
    LAS int* slotof = tot + 64;
    const int np = 2 * (r1 - r0);
    for (int p = F.tid; p < np; p += NWAVES * 64) { const int idx = 2 * r0 + p; const int e = toke[idx]; const int slot = __hip_atomic_fetch_add(&tot[16 + e], 1, __ATOMIC_RELAXED, __HIP_MEMORY_SCOPE_WORKGROUP);
        toks[idx] = slot; sgate[slot] = tokg[idx]; slotof[p] = slot; }
    __syncthreads();
    for (int p = F.wave; p < np; p += NWAVES) { const int tok = r0 + (p >> 1); const int slot = slotof[p];
        float v[16]; rowb_load(XR + (size_t)tok * DM, F.lane, v);
        if (F.lane == 0) sss[slot] = __builtin_amdgcn_rsqf(ss_total(ss, tok) * (1.0f / DM) + NORM_EPS);
        GAS unsigned long long* d = (GAS unsigned long long*)(XB + (size_t)slot * DM);
        d[F.lane] = (unsigned long long)pg8::pk4_fp8(v[0] * F8_SA, v[1] * F8_SA, v[2] * F8_SA, v[3] * F8_SA) | ((unsigned long long)pg8::pk4_fp8(v[4] * F8_SA, v[5] * F8_SA, v[6] * F8_SA, v[7] * F8_SA) << 32);
        d[64 + F.lane] = (unsigned long long)pg8::pk4_fp8(v[8] * F8_SA, v[9] * F8_SA, v[10] * F8_SA, v[11] * F8_SA) | ((unsigned long long)pg8::pk4_fp8(v[12] * F8_SA, v[13] * F8_SA, v[14] * F8_SA, v[15] * F8_SA) << 32); }
    __syncthreads();
}

__device__ __forceinline__ void kpe_phase(Frame& F, const bf16* LAT, const float* tab, bf16* KPE) {
    for (int i = F.bid * NWAVES * 64 + F.tid; i < NTOK * 16; i += F.G * NWAVES * 64) { const int r = i >> 4, p = i & 15;
        const unsigned w = *(const GAS unsigned*)(LAT + (size_t)r * 768 + 640 + 2 * p); const float x1 = bf_lo(w), x2 = bf_hi(w);
        const float c = tab[(size_t)(r % SEQ) * 32 + 2 * p], sn = tab[(size_t)(r % SEQ) * 32 + 2 * p + 1];
        *(GAS unsigned*)(KPE + (size_t)r * 32 + 2 * p) = pk2(x1 * c - x2 * sn, x1 * sn + x2 * c); }
}
__device__ __forceinline__ void latpost_phase(Frame& F, const bf16* LAT, const float* qg, const float* kvg, const float* tab, bf16* QN, bf16* KVN, bf16* KPE) {
    const int gw = F.bid * NWAVES + F.wave, NGW = F.G * NWAVES;
    for (int r = gw; r < NTOK; r += NGW) {
        const bf16* row = LAT + (size_t)r * 768;
        float q[6]; float s = 0.f;
#pragma unroll
        for (int i = 0; i < 6; ++i) { q[i] = bf_lo((unsigned)row[F.lane + 64 * i]); s += q[i] * q[i]; }
        const float rq = 1.0f / sqrtf(wave_sum(s) * (1.0f / 384.0f) + NORM_EPS);
#pragma unroll
        for (int i = 0; i < 6; ++i) QN[(size_t)r * 384 + F.lane + 64 * i] = (bf16)f2bf(q[i] * rq * qg[F.lane + 64 * i]);
        float k[4]; s = 0.f;
#pragma unroll
        for (int i = 0; i < 4; ++i) { k[i] = bf_lo((unsigned)row[384 + F.lane + 64 * i]); s += k[i] * k[i]; }
        const float rk = 1.0f / sqrtf(wave_sum(s) * (1.0f / 256.0f) + NORM_EPS);
#pragma unroll
        for (int i = 0; i < 4; ++i) KVN[(size_t)r * 256 + F.lane + 64 * i] = (bf16)f2bf(k[i] * rk * kvg[F.lane + 64 * i]);
        if (F.lane < 16) { const float x1 = bf_lo((unsigned)row[640 + 2 * F.lane]), x2 = bf_lo((unsigned)row[640 + 2 * F.lane + 1]);
            const float c = tab[(size_t)(r % SEQ) * 32 + 2 * F.lane], sn = tab[(size_t)(r % SEQ) * 32 + 2 * F.lane + 1];
            *(GAS unsigned*)(KPE + (size_t)r * 32 + 2 * F.lane) = pk2(x1 * c - x2 * sn, x1 * sn + x2 * c); }
    }
}

namespace fa {
typedef float f32x16 __attribute__((ext_vector_type(16)));
typedef short s16x4 __attribute__((ext_vector_type(4)));
typedef short v4i16_t __attribute__((ext_vector_type(4)));
typedef float f32x2_t __attribute__((ext_vector_type(2)));
typedef __bf16 bf16x2_t __attribute__((ext_vector_type(2)));
__device__ __forceinline__ unsigned cvtpk(float lo, float hi) { f32x2_t v = {lo, hi}; bf16x2_t b = __builtin_convertvector(v, bf16x2_t); return __builtin_bit_cast(unsigned, b); }
__device__ __forceinline__ float fsub1(float a, float b) { float r; asm("v_sub_f32_e32 %0, %1, %2" : "=v"(r) : "v"(a), "v"(b)); return r; }
__device__ __forceinline__ float fadd1(float a, float b) { float r; asm("v_add_f32_e32 %0, %1, %2" : "=v"(r) : "v"(a), "v"(b)); return r; }
__device__ __forceinline__ bf16x8 pack8(const f32x16& x, int s) {
    v4u p; p.x = cvtpk(x[8 * s], x[8 * s + 1]); p.y = cvtpk(x[8 * s + 2], x[8 * s + 3]); p.z = cvtpk(x[8 * s + 4], x[8 * s + 5]); p.w = cvtpk(x[8 * s + 6], x[8 * s + 7]);
    return __builtin_bit_cast(bf16x8, p);
}
__device__ __forceinline__ s16x4 vtr(const LAS unsigned char* p) { return __builtin_bit_cast(s16x4, __builtin_amdgcn_ds_read_tr16_b64_v4i16((LAS v4i16_t*)p)); }
#define FA_MFMA(a, b, c) __builtin_amdgcn_mfma_f32_32x32x16_bf16((a), (b), (c), 0, 0, 0)
#define FA_CI(i) (((i) & 3) + 8 * ((i) >> 2))

struct Desc {
    const bf16* q0; const bf16* q1; int qstride;
    const bf16* k0; int kstride; const bf16* k1; int k1stride;
    const bf16* v; int vstride;
    int qpos0;
    int t_lo, t_hi;
    int W;
    float sl2;
    const LAS float* pm; LAS unsigned* ecnt;
    const float* ropetab;
};
template <int DQK0, int DQK1, int DV> struct Geo {
    static constexpr int DQK = DQK0 + DQK1, RSK = DQK * 2 + 16, RSV = DV * 2 + 64, KBYTES = 64 * RSK, VBYTES = 64 * RSV, BUF = KBYTES + VBYTES;
    static constexpr int C0 = DQK0 / 8, C1 = DQK1 / 8, CV = DV / 8, NV = DV / 64;
};
#define FA_OFFSETS() unsigned koff, k1off = 0u, voff[G::NV], klds, k1lds = 0u, vlds[G::NV]; \
        { const int row_ = tid / G::C0, ch_ = tid % G::C0; koff = (unsigned)(row_ * d.kstride + ch_ * 8) * 2u; klds = (unsigned)(row_ * G::RSK + ch_ * 16); } \
        if (G::C1 > 0) { const int row_ = tid / (G::C1 > 0 ? G::C1 : 1), ch_ = tid % (G::C1 > 0 ? G::C1 : 1); k1off = (unsigned)(row_ * d.k1stride + ch_ * 8) * 2u; k1lds = (unsigned)(row_ * G::RSK + DQK0 * 2 + ch_ * 16); } \
        _Pragma("unroll") for (int i_ = 0; i_ < G::NV; ++i_) { const int c_ = tid + 512 * i_, row_ = c_ / G::CV, ch_ = c_ % G::CV; voff[i_] = (unsigned)(row_ * d.vstride + ch_ * 8) * 2u; vlds[i_] = (unsigned)(G::KBYTES + row_ * G::RSV + ch_ * 16); }
#define FA_RSRC() const __amdgpu_buffer_rsrc_t rk0 = __builtin_amdgcn_make_buffer_rsrc((void*)d.k0, 0, 0x7fffffff, 0x00020000), rv = __builtin_amdgcn_make_buffer_rsrc((void*)d.v, 0, 0x7fffffff, 0x00020000), \
        rk1 = __builtin_amdgcn_make_buffer_rsrc((void*)(G::C1 > 0 ? d.k1 : d.k0), 0, 0x7fffffff, 0x00020000)
#define FA_GLOAD(t_) do { const int key0_ = (t_) * 64;     \
        sk0 = __builtin_bit_cast(v4u, __builtin_amdgcn_raw_buffer_load_b128(rk0, (int)koff, key0_ * d.kstride * 2, 0)); \
        if (G::C1 > 0) { if (tid < 64 * G::C1) sk1 = __builtin_bit_cast(v4u, __builtin_amdgcn_raw_buffer_load_b128(rk1, (int)k1off, key0_ * d.k1stride * 2, 0)); } \
        _Pragma("unroll") for (int i_ = 0; i_ < G::NV; ++i_) sv[i_] = __builtin_bit_cast(v4u, __builtin_amdgcn_raw_buffer_load_b128(rv, (int)voff[i_], key0_ * d.vstride * 2, 0)); } while (0)
#define FA_LSTORE(buf_) do { LAS unsigned char* kb_ = lds + (buf_) * G::BUF; \
        *(LAS v4u*)(kb_ + klds) = sk0; \
        if (G::C1 > 0) { if (tid < 64 * G::C1) *(LAS v4u*)(kb_ + k1lds) = sk1; } \
        _Pragma("unroll") for (int i_ = 0; i_ < G::NV; ++i_) *(LAS v4u*)(kb_ + vlds[i_]) = sv[i_]; } while (0)
#define FA_QK1(kbuf_, kb_, P_) do { const LAS unsigned char* kp_ = (kbuf_) + (32 * (kb_) + r) * G::RSK + h * 16; \
        _Pragma("unroll") for (int s_ = 0; s_ < G::DQK / 16; ++s_) { bf16x8 qv_; if (QLDS) qv_ = *(const LAS bf16x8*)(qs + s_ * 1024); else qv_ = qf[s_]; \
            const bf16x8 kf_ = *(const LAS bf16x8*)(kp_ + s_ * 32); P_ = FA_MFMA(kf_, qv_, s_ == 0 ? zero : P_); } } while (0)
#define FA_PV(vbuf_) do { const LAS unsigned char* vp_ = (vbuf_) + (4 * h + ((lane & 15) >> 2)) * G::RSV + ((lane >> 4) & 1) * 32 + (lane & 3) * 8; \
        _Pragma("unroll") for (int ks_ = 0; ks_ < 4; ++ks_) _Pragma("unroll") for (int c_ = 0; c_ < DV / 32; ++c_) { \
            const s16x4 lo_ = vtr(vp_ + (16 * ks_) * G::RSV + c_ * 64), hi_ = vtr(vp_ + (16 * ks_ + 8) * G::RSV + c_ * 64); \
            const bf16x8 vf_ = {lo_[0], lo_[1], lo_[2], lo_[3], hi_[0], hi_[1], hi_[2], hi_[3]}; o[c_] = FA_MFMA(vf_, pf[ks_], o[c_]); } } while (0)

#define FA_QK2(kbuf_, P0_, P1_) do { const LAS unsigned char* kp0_ = (kbuf_) + r * G::RSK + h * 16; const LAS unsigned char* kp1_ = kp0_ + 32 * G::RSK; \
        bf16x8 ka_[G::DQK / 16], kb_[G::DQK / 16]; \
        _Pragma("unroll") for (int s_ = 0; s_ < G::DQK / 16; ++s_) ka_[s_] = *(const LAS bf16x8*)(kp0_ + s_ * 32); \
        _Pragma("unroll") for (int s_ = 0; s_ < G::DQK / 16; ++s_) kb_[s_] = *(const LAS bf16x8*)(kp1_ + s_ * 32); \
        __builtin_amdgcn_sched_barrier(0); \
        _Pragma("unroll") for (int s_ = 0; s_ < G::DQK / 16; ++s_) P0_ = FA_MFMA(ka_[s_], qf[s_], s_ == 0 ? zero : P0_); \
        _Pragma("unroll") for (int s_ = 0; s_ < G::DQK / 16; ++s_) P1_ = FA_MFMA(kb_[s_], qf[s_], s_ == 0 ? zero : P1_); \
        __builtin_amdgcn_sched_barrier(0); } while (0)
#define FA_PV2(vbuf_) do { const LAS unsigned char* vp_ = (vbuf_) + (4 * h + ((lane & 15) >> 2)) * G::RSV + ((lane >> 4) & 1) * 32 + (lane & 3) * 8; \
        s16x4 vl_[4][DV / 32], vh_[4][DV / 32]; \
        _Pragma("unroll") for (int ks_ = 0; ks_ < 4; ++ks_) _Pragma("unroll") for (int c_ = 0; c_ < DV / 32; ++c_) { vl_[ks_][c_] = vtr(vp_ + (16 * ks_) * G::RSV + c_ * 64); vh_[ks_][c_] = vtr(vp_ + (16 * ks_ + 8) * G::RSV + c_ * 64); } \
        __builtin_amdgcn_sched_barrier(0); \
        _Pragma("unroll") for (int ks_ = 0; ks_ < 4; ++ks_) _Pragma("unroll") for (int c_ = 0; c_ < DV / 32; ++c_) { \
            const bf16x8 vf_ = {vl_[ks_][c_][0], vl_[ks_][c_][1], vl_[ks_][c_][2], vl_[ks_][c_][3], vh_[ks_][c_][0], vh_[ks_][c_][1], vh_[ks_][c_][2], vh_[ks_][c_][3]}; o[c_] = FA_MFMA(vf_, pf[ks_], o[c_]); } \
        __builtin_amdgcn_sched_barrier(0); } while (0)

template <int DQK0, int DQK1, int DV, bool BIAS, bool QLDS, bool EXIT = false>
__device__ __forceinline__ void flash_unit(LAS unsigned char* lds, const Desc& d, int tid, f32x16 (&o)[DV / 32], float& m_out, float& l_out) {
    typedef Geo<DQK0, DQK1, DV> G;
    const int lane = tid & 63, wave = __builtin_amdgcn_readfirstlane(tid >> 6), r = lane & 31, h = lane >> 5;
    bf16x8 qf[G::DQK / 16];
    LAS unsigned char* qs = lds + 2 * G::BUF + wave * (G::DQK / 16) * 1024 + lane * 16;
    { const unsigned qoff = (unsigned)((wave * 32 + r) * d.qstride);
#pragma unroll
      for (int s = 0; s < DQK0 / 16; ++s) qf[s] = *(const GAS bf16x8*)(d.q0 + qoff + s * 16 + h * 8);
#pragma unroll
      for (int s = 0; s < DQK1 / 16; ++s) qf[DQK0 / 16 + s] = *(const GAS bf16x8*)(d.q1 + qoff + s * 16 + h * 8);
      if (DQK1 > 0) { if (d.ropetab) {
#pragma unroll
          for (int s = 0; s < DQK1 / 16; ++s) { const float* t = d.ropetab + (size_t)(d.qpos0 + wave * 32 + r) * 32 + 16 * s + 8 * h; const f32x4 c0 = *(const GAS f32x4*)t, c1 = *(const GAS f32x4*)(t + 4);
              const v4u w = __builtin_bit_cast(v4u, qf[DQK0 / 16 + s]); v4u o_; float a, b;
              a = bf_lo(w.x); b = bf_hi(w.x); o_.x = pk2(a * c0[0] - b * c0[1], a * c0[1] + b * c0[0]);
              a = bf_lo(w.y); b = bf_hi(w.y); o_.y = pk2(a * c0[2] - b * c0[3], a * c0[3] + b * c0[2]);
              a = bf_lo(w.z); b = bf_hi(w.z); o_.z = pk2(a * c1[0] - b * c1[1], a * c1[1] + b * c1[0]);
              a = bf_lo(w.w); b = bf_hi(w.w); o_.w = pk2(a * c1[2] - b * c1[3], a * c1[3] + b * c1[2]);
              qf[DQK0 / 16 + s] = __builtin_bit_cast(bf16x8, o_); } } }
      if (QLDS) {
#pragma unroll
          for (int s = 0; s < G::DQK / 16; ++s) *(LAS bf16x8*)(qs + s * 1024) = qf[s]; } }
    float qn = 0.f;
    if (EXIT) {
#pragma unroll
        for (int s = 0; s < G::DQK / 16; ++s)
#pragma unroll
            for (int j = 0; j < 8; ++j) { const float f = bf_lo((unsigned)(unsigned short)qf[s][j]); qn += f * f; }
        qn += __shfl_xor(qn, 32); qn = sqrtf(qn) * 1.01f;
    }
    f32x16 zero;
#pragma unroll
    for (int i = 0; i < 16; ++i) zero[i] = 0.f;
#pragma unroll
    for (int c = 0; c < DV / 32; ++c)
#pragma unroll
        for (int i = 0; i < 16; ++i) o[c][i] = 0.f;
    float m = -1e30f, l = 0.f;
    const int qmin = d.qpos0 + wave * 32, qpos = qmin + r;
    if (__builtin_amdgcn_readfirstlane(tid) >= 256) __builtin_amdgcn_s_setprio(1);
    v4u sk0, sk1, sv[G::NV];
    FA_OFFSETS();
    FA_RSRC();
    FA_GLOAD(d.t_hi); FA_LSTORE(0); __syncthreads();
    int buf = 0; unsigned prev0 = 0u, prev1 = 0u; bool done_w = false;
    for (int t = d.t_hi; t >= d.t_lo; --t) {
        if (QLDS) { int tl = tid; asm volatile("" : "+v"(tl));
            { const int row_ = tl / G::C0, ch_ = tl % G::C0; koff = (unsigned)(row_ * d.kstride + ch_ * 8) * 2u; klds = (unsigned)(row_ * G::RSK + ch_ * 16); }
#pragma unroll
            for (int i_ = 0; i_ < G::NV; ++i_) { const int c_ = tl + 512 * i_, row_ = c_ / G::CV, ch_ = c_ % G::CV; voff[i_] = (unsigned)(row_ * d.vstride + ch_ * 8) * 2u; vlds[i_] = (unsigned)(G::KBYTES + row_ * G::RSV + ch_ * 16); } }
        if (t > d.t_lo) FA_GLOAD(t - 1);
        const int k0 = t * 64;
        const bool act = (k0 <= qmin + 31 && k0 + 63 >= qmin - d.W) && !done_w;
        const LAS unsigned char* kbuf = lds + buf * G::BUF; const LAS unsigned char* vbuf = kbuf + G::KBYTES;
        bf16x8 pf[4];
        if (act) {
            f32x16 p[2];
            if (QLDS) { FA_QK1(kbuf, 0, p[0]); FA_QK1(kbuf, 1, p[1]); } else { FA_QK2(kbuf, p[0], p[1]); }
            if (BIAS) {
#pragma unroll
                for (int i = 0; i < 16; ++i) { p[0][i] = __builtin_fmaf(d.sl2, (float)FA_CI(i), p[0][i]); p[1][i] = __builtin_fmaf(d.sl2, (float)FA_CI(i), p[1][i]); } }
            const int dq0 = qpos - k0 - 4 * h;
            const float off0 = BIAS ? d.sl2 * (float)dq0 : 0.f, off1 = BIAS ? d.sl2 * (float)(dq0 - 32) : 0.f;
            if (k0 + 63 > qmin || k0 < qmin + 31 - d.W) {
#pragma unroll
                for (int kb = 0; kb < 2; ++kb) { const int dq = dq0 - 32 * kb;
#pragma unroll
                    for (int i = 0; i < 16; ++i) { const bool ok = (FA_CI(i) <= dq) && (FA_CI(i) >= dq - d.W); p[kb][i] = ok ? p[kb][i] : -INFINITY; } }
            }
            float mx0 = p[0][0], mx1 = p[1][0];
#pragma unroll
            for (int i = 1; i < 16; ++i) { mx0 = fmaxf(mx0, p[0][i]); mx1 = fmaxf(mx1, p[1][i]); }
            float tm = fmaxf(mx0 - off0, mx1 - off1);
            tm = fmaxf(tm, __shfl_xor(tm, 32));
            if (__any(tm > m + 8.0f)) {
                const float mn = fmaxf(m, tm), al = ex2(m - mn); m = mn; l *= al;
#pragma unroll
                for (int c = 0; c < DV / 32; ++c)
#pragma unroll
                    for (int i = 0; i < 16; ++i) o[c][i] *= al;
            }
            const float mk0 = m + off0, mk1 = m + off1; float ps = 0.f;
#pragma unroll
            for (int i = 0; i < 16; ++i) { p[0][i] = ex2(p[0][i] - mk0); p[1][i] = ex2(p[1][i] - mk1); ps += p[0][i] + p[1][i]; }
            l += ps;
            pf[0] = pack8(p[0], 0); pf[1] = pack8(p[0], 1); pf[2] = pack8(p[1], 0); pf[3] = pack8(p[1], 1);
        }
        if (EXIT) {
            if (!done_w && t > d.t_lo) { const float bound = qn * d.pm[t - 1] + d.sl2 * (float)(k0 - 1 - qpos); done_w = __all(bound - m < -40.0f); }
            if (!done_w && lane == 0) __hip_atomic_fetch_add(&d.ecnt[t & 1], 1u, __ATOMIC_RELAXED, __HIP_MEMORY_SCOPE_WORKGROUP);
        }
        if (t > d.t_lo) FA_LSTORE(buf ^ 1);
        if (act) { if (QLDS) { FA_PV(vbuf); } else { FA_PV2(vbuf); } }
        __syncthreads();
        buf ^= 1;
        if (EXIT) { const unsigned c = d.ecnt[t & 1]; if (t & 1) { if (c == prev1) break; prev1 = c; } else { if (c == prev0) break; prev0 = c; } }
    }
    if (EXIT) __syncthreads();
    __builtin_amdgcn_s_setprio(0);
    m_out = m; l_out = l;
}
__device__ __forceinline__ void sb_unit(LAS unsigned char* lds, const Desc& d, int tid, f32x16 (&o)[2], LAS unsigned* ecnt) {
    typedef Geo<64, 0, 64> G; constexpr int DQK0 = 64, DV = 64; constexpr bool QLDS = false; LAS unsigned char* qs = nullptr;
    const int lane = tid & 63, wave = __builtin_amdgcn_readfirstlane(tid >> 6), r = lane & 31, h = lane >> 5;
    bf16x8 qf[4];
    { const unsigned qoff = (unsigned)((wave * 32 + r) * d.qstride);
#pragma unroll
      for (int s = 0; s < 4; ++s) qf[s] = *(const GAS bf16x8*)(d.q0 + qoff + s * 16 + h * 8); }
    f32x16 zero;
#pragma unroll
    for (int i = 0; i < 16; ++i) { zero[i] = 0.f; o[0][i] = 0.f; o[1][i] = 0.f; }
    float carry = 1.0f;
    const int qmin = d.qpos0 + wave * 32, qpos = qmin + r;
    v4u sk0, sk1, sv[G::NV];
    FA_OFFSETS();
    FA_RSRC();
    if (tid < 2) ecnt[tid] = 0u;
    FA_GLOAD(d.t_hi); FA_LSTORE(0); __syncthreads();
    int buf = 0; unsigned prev0 = 0u, prev1 = 0u; bool done_w = false;
    for (int t = d.t_hi; t >= d.t_lo; --t) {
        if (t > d.t_lo) FA_GLOAD(t - 1);
        const int k0 = t * 64;
        if (k0 < qmin + 31 && !done_w) {
            const LAS unsigned char* kbuf = lds + buf * G::BUF; const LAS unsigned char* vbuf = kbuf + G::KBYTES;
            f32x16 p[2];
            FA_QK2(kbuf, p[0], p[1]);
            const int dq0 = qpos - k0 - 4 * h;
            if (k0 + 63 >= qmin) {
#pragma unroll
                for (int kb = 0; kb < 2; ++kb) { const int dq = dq0 - 32 * kb;
#pragma unroll
                    for (int i = 0; i < 16; ++i) p[kb][i] = (FA_CI(i) < dq) ? p[kb][i] : -INFINITY; }
            }
#pragma unroll
            for (int kk = 0; kk < 2; ++kk) { const int kb = 1 - kk;
                float T[4];
#pragma unroll
                for (int g = 0; g < 4; ++g) {
                    float kp[4], bt[4];
#pragma unroll
                    for (int j = 0; j < 4; ++j) { const float ez = ex2(p[kb][4 * g + j]); kp[j] = __builtin_amdgcn_rcpf(1.0f + ez); bt[j] = ez * kp[j]; }
                    const float e2 = kp[3], e1 = e2 * kp[2], e0 = e1 * kp[1]; T[g] = e0 * kp[0];
                    p[kb][4 * g + 3] = bt[3]; p[kb][4 * g + 2] = bt[2] * e2; p[kb][4 * g + 1] = bt[1] * e1; p[kb][4 * g] = bt[0] * e0;
                }
                float PT[4];
#pragma unroll
                for (int g = 0; g < 4; ++g) PT[g] = __shfl_xor(T[g], 32);
                const float S3 = carry * (h ? 1.0f : PT[3]);
                const float S2 = S3 * T[3] * (h ? PT[3] : PT[2]);
                const float S1 = S2 * T[2] * (h ? PT[2] : PT[1]);
                const float S0 = S1 * T[1] * (h ? PT[1] : PT[0]);
                carry = S0 * T[0] * (h ? PT[0] : 1.0f);
#pragma unroll
                for (int j = 0; j < 4; ++j) { p[kb][12 + j] *= S3; p[kb][8 + j] *= S2; p[kb][4 + j] *= S1; p[kb][j] *= S0; }
            }
            bf16x8 pf[4]; pf[0] = pack8(p[0], 0); pf[1] = pack8(p[0], 1); pf[2] = pack8(p[1], 0); pf[3] = pack8(p[1], 1);
            FA_PV2(vbuf);
            done_w = __all(carry <= 1e-30f);
        }
        if (!done_w && lane == 0) __hip_atomic_fetch_add(&ecnt[t & 1], 1u, __ATOMIC_RELAXED, __HIP_MEMORY_SCOPE_WORKGROUP);
        if (t > d.t_lo) FA_LSTORE(buf ^ 1);
        __syncthreads();
        buf ^= 1;
        const unsigned c = ecnt[t & 1];
        if (t & 1) { if (c == prev1) break; prev1 = c; } else { if (c == prev0) break; prev0 = c; }
    }
    __syncthreads();
}
}
#ifndef B_EXIT
#define B_EXIT 1
#endif
__device__ __forceinline__ int vcu_of(const Frame& F) { return (F.G % 8 == 0) ? (F.bid % 8) * (F.G / 8) + F.bid / 8 : F.bid; }
template <int NV> __device__ __forceinline__ void store_rows_own(bf16* out, int rstride, int wave, int lane, const fa::f32x16 (&o)[NV], float scale) {
    const int r = lane & 31, h = lane >> 5; bf16* rowp = out + (unsigned)((wave * 32 + r) * rstride + 4 * h);
#pragma unroll
    for (int c = 0; c < NV; ++c)
#pragma unroll
        for (int g = 0; g < 4; ++g) { const unsigned lo = fa::cvtpk(o[c][4 * g] * scale, o[c][4 * g + 1] * scale), hi = fa::cvtpk(o[c][4 * g + 2] * scale, o[c][4 * g + 3] * scale);
            *(GAS unsigned long long*)(rowp + 32 * c + 8 * g) = (unsigned long long)lo | ((unsigned long long)hi << 32); }
}
template <int NV> __device__ __forceinline__ void store_rows(bf16* out, int rstride, int wave, int lane, const fa::f32x16 (&o)[NV], float scale) {
    const int r = lane & 31, h = lane >> 5; bf16* rowp = out + (unsigned)((wave * 32 + r) * rstride + 8 * h);
#pragma unroll
    for (int c = 0; c < NV; ++c)
#pragma unroll
        for (int k = 0; k < 4; k += 2) {
            unsigned ax = fa::cvtpk(o[c][4 * k] * scale, o[c][4 * k + 1] * scale), ay = fa::cvtpk(o[c][4 * k + 2] * scale, o[c][4 * k + 3] * scale);
            unsigned bx = fa::cvtpk(o[c][4 * k + 4] * scale, o[c][4 * k + 5] * scale), by = fa::cvtpk(o[c][4 * k + 6] * scale, o[c][4 * k + 7] * scale);
            const auto r0 = __builtin_amdgcn_permlane32_swap(ax, bx, false, false); const auto r1 = __builtin_amdgcn_permlane32_swap(ay, by, false, false);
            const v4u w = {r0[0], r1[0], r0[1], r1[1]};
            *(GAS v4u*)(rowp + 32 * c + 8 * k) = w; }
}
__device__ __forceinline__ void fast_attn_c(Frame& F, const bf16* Q, const bf16* KV, const bf16* KPE, const float* ropetab, bf16* OUT) {
    const int v = vcu_of(F);
    for (int P = v; P < BATCH * 16 * 8; P += F.G) {
        const int bh = P >> 3, pi = P & 7, b = bh >> 4, hd = bh & 15;
        for (int half = 0; half < 2; ++half) { const int qb = half ? pi : 15 - pi; const long row0 = (long)b * SEQ + qb * 256;
            fa::Desc d; d.q0 = Q + row0 * 1536 + 64 * hd; d.q1 = Q + row0 * 1536 + 1024 + 32 * hd; d.qstride = 1536;
            d.k0 = KV + (long)b * SEQ * 2048 + 64 * hd; d.kstride = 2048; d.k1 = KPE + (long)b * SEQ * 32; d.k1stride = 32;
            d.v = KV + (long)b * SEQ * 2048 + 1024 + 64 * hd; d.vstride = 2048; d.qpos0 = qb * 256; d.t_lo = 0; d.t_hi = 4 * qb + 3; d.W = 1 << 29; d.sl2 = 0.f; d.pm = nullptr; d.ecnt = nullptr; d.ropetab = ropetab;
            fa::f32x16 o[2]; float m, l;
            fa::flash_unit<64, 32, 64, false, false>(F.lds + RING_OFF, d, F.tid, o, m, l);
            const float lt = l + __shfl_xor(l, 32);
            store_rows<2>(OUT + row0 * 1024 + 64 * hd, 1024, F.wave, F.lane, o, 1.0f / lt);
        }
    }
}
__device__ __forceinline__ void fast_attn_d(Frame& F, const bf16* QKV, bf16* OUT) {
    const int v = vcu_of(F);
    LAS unsigned* ecnt = (LAS unsigned*)(F.lds + RING_OFF + 2 * fa::Geo<64, 0, 64>::BUF);
    for (int P = v; P < BATCH * 16 * 8; P += F.G) {
        const int bh = P >> 3, pi = P & 7, b = bh >> 4, hd = bh & 15;
        for (int half = 0; half < 2; ++half) { const int qb = half ? pi : 15 - pi; const long row0 = (long)b * SEQ + qb * 256;
            fa::Desc d; d.q0 = QKV + row0 * 3072 + 64 * hd; d.q1 = nullptr; d.qstride = 3072;
            d.k0 = QKV + (long)b * SEQ * 3072 + 1024 + 64 * hd; d.kstride = 3072; d.k1 = nullptr; d.k1stride = 0;
            d.v = QKV + (long)b * SEQ * 3072 + 2048 + 64 * hd; d.vstride = 3072; d.qpos0 = qb * 256; d.t_lo = 0; d.t_hi = 4 * qb + 3; d.W = 1 << 29; d.sl2 = 0.f; d.pm = nullptr; d.ecnt = nullptr; d.ropetab = nullptr;
            fa::f32x16 o[2];
            fa::sb_unit(F.lds + RING_OFF, d, F.tid, o, ecnt);
            store_rows<2>(OUT + row0 * 1024 + 64 * hd, 1024, F.wave, F.lane, o, 1.0f);
        }
    }
}
__device__ __forceinline__ void fast_attn_b(Frame& F, const bf16* QKV, const float* KN, unsigned* queue, bf16* OUT, const float* lq1, const float* lk1, const float* lq2, const float* lk2, const float* subln) {
    float d1 = 0.f, d2 = 0.f;
    for (int i = 0; i < 64; ++i) { d1 += lq1[i] * lk1[i]; d2 += lq2[i] * lk2[i]; }
    const float lam_init = 0.8f - 0.6f * expf(-0.3f * 1.0f), lam = __builtin_bit_cast(float, __builtin_amdgcn_readfirstlane(__builtin_bit_cast(int, expf(d1) - expf(d2) + lam_init)));
    LAS int* qslot = (LAS int*)(F.lds + RING_OFF + 2 * fa::Geo<64, 0, 128>::BUF + NWAVES * 4096 + 512);
    for (;;) {
        if (F.tid == 0) *qslot = (int)__hip_atomic_fetch_add(queue, 1u, __ATOMIC_RELAXED, __HIP_MEMORY_SCOPE_AGENT);
        __syncthreads();
        const int P = *qslot;
        __syncthreads();
        if (P >= BATCH * 8 * 8) break;
        const int hd = 7 - (P >> 6), b = (P >> 3) & 7, pi = P & 7;
        for (int half = 0; half < 2; ++half) { const int qb = half ? pi : 15 - pi; const long row0 = (long)b * SEQ + qb * 256;
            fa::f32x16 o[4]; float m, l;
            bf16* orow = OUT + row0 * 1024 + 128 * hd;
            for (int mm = 0; mm < 2; ++mm) {
                fa::Desc d; d.q0 = QKV + row0 * 3072 + 128 * hd + 64 * mm; d.q1 = nullptr; d.qstride = 3072;
                d.k0 = QKV + (long)b * SEQ * 3072 + 1024 + 128 * hd + 64 * mm; d.kstride = 3072; d.k1 = nullptr; d.k1stride = 0;
                d.v = QKV + (long)b * SEQ * 3072 + 2048 + 128 * hd; d.vstride = 3072; d.qpos0 = qb * 256; d.t_lo = 0; d.t_hi = 4 * qb + 3; d.W = 1 << 29; d.sl2 = exp2f(-(float)(hd + 1)) * LOG2E;
                LAS float* pm = (LAS float*)(F.lds + RING_OFF + 2 * fa::Geo<64, 0, 128>::BUF + NWAVES * 4096); LAS unsigned* ecnt = (LAS unsigned*)(pm + 64);
                if (F.wave == 0) { int ln = F.lane; asm volatile("" : "+v"(ln)); float kv = (ln <= d.t_hi) ? KN[((size_t)b * 16 + 2 * hd + mm) * 64 + ln] * 1.01f : 0.f;
#pragma unroll
                    for (int o_ = 1; o_ < 64; o_ <<= 1) { const float u = __shfl_up(kv, o_); if (F.lane >= o_) kv = fmaxf(kv, u); }
                    pm[F.lane] = kv; if (F.lane < 2) ecnt[F.lane] = 0u; }
                d.pm = pm; d.ecnt = ecnt; d.ropetab = nullptr;
                fa::flash_unit<64, 0, 128, true, true, (B_EXIT != 0)>(F.lds + RING_OFF, d, F.tid, o, m, l);
                const float rl = 1.0f / (l + __shfl_xor(l, 32));
                if (mm == 0) { store_rows_own<4>(orow, 1024, F.wave, F.lane, o, rl); }
                else {
                    int l2 = F.lane; asm volatile("" : "+v"(l2)); const int r = l2 & 31, h = l2 >> 5;
                    float ss = 0.f; const bf16* rowp = orow + (unsigned)((F.wave * 32 + r) * 1024 + 4 * h);
#pragma unroll
                    for (int c = 0; c < 4; ++c) {
#pragma unroll
                        for (int g = 0; g < 4; ++g) { const unsigned long long w = *(const GAS unsigned long long*)(rowp + 32 * c + 8 * g); const unsigned lo = (unsigned)w, hi = (unsigned)(w >> 32);
                            const float a0 = bf_lo(lo) - lam * o[c][4 * g] * rl, a1 = bf_hi(lo) - lam * o[c][4 * g + 1] * rl, a2 = bf_lo(hi) - lam * o[c][4 * g + 2] * rl, a3 = bf_hi(hi) - lam * o[c][4 * g + 3] * rl;
                            o[c][4 * g] = a0; o[c][4 * g + 1] = a1; o[c][4 * g + 2] = a2; o[c][4 * g + 3] = a3; ss += (a0 * a0 + a1 * a1) + (a2 * a2 + a3 * a3); }
                        asm volatile("" ::: "memory"); }
                    ss += __shfl_xor(ss, 32);
                    const float rs = (1.0f - lam_init) / sqrtf(ss * (1.0f / 128.0f) + SUBLN_EPS);
#pragma unroll
                    for (int c = 0; c < 4; ++c) {
#pragma unroll
                        for (int g = 0; g < 4; ++g) { const f32x4 sg = *(const GAS f32x4*)(subln + 32 * c + 8 * g + 4 * h);
                            o[c][4 * g] *= sg[0]; o[c][4 * g + 1] *= sg[1]; o[c][4 * g + 2] *= sg[2]; o[c][4 * g + 3] *= sg[3]; }
                        asm volatile("" ::: "memory"); }
                    store_rows_own<4>(orow, 1024, F.wave, F.lane, o, rs);
                }
            }
        }
    }
}
__device__ __forceinline__ void fast_attn_a(Frame& F, const bf16* QKV, bf16* OG, float* LSE) {
    const int v = vcu_of(F);
    for (int U = v; U < 3 * BATCH * 8 * 16; U += F.G) {
        const int j = U & 15, hd = (U >> 4) & 7, b = (U >> 7) & 7, g = U >> 10; const int dil = 1 << (2 * g), res = j & (dil - 1), qblk = j >> (2 * g);
        const long tok0 = (long)b * SEQ + res;
        fa::Desc d; d.qstride = dil * 4608; d.q0 = QKV + (tok0 + (long)qblk * 256 * dil) * 4608 + g * 512 + hd * 64; d.q1 = nullptr;
        d.k0 = QKV + tok0 * 4608 + 1536 + g * 512 + hd * 64; d.kstride = d.qstride; d.k1 = nullptr; d.k1stride = 0;
        d.v = QKV + tok0 * 4608 + 3072 + g * 512 + hd * 64; d.vstride = d.qstride; d.qpos0 = qblk * 256;
        d.t_lo = (qblk * 256 - 128) < 0 ? 0 : (qblk * 256 - 128) / 64; d.t_hi = 4 * qblk + 3; d.W = 128; d.sl2 = exp2f(-(float)(g * 8 + hd + 1) / 3.0f) * LOG2E * (float)dil; d.pm = nullptr; d.ecnt = nullptr; d.ropetab = nullptr;
        fa::f32x16 o[2]; float m, l;
        fa::flash_unit<64, 0, 64, true, false>(F.lds + RING_OFF, d, F.tid, o, m, l);
        const float lt = l + __shfl_xor(l, 32);
        bf16* og = OG + (size_t)g * NTOK * 512;
        store_rows<2>(og + (tok0 + (long)qblk * 256 * dil) * 512 + hd * 64, dil * 512, F.wave, F.lane, o, 1.0f / lt);
        if (F.lane < 32) LSE[(size_t)g * NTOK * 8 + (tok0 + ((long)qblk * 256 + F.wave * 32 + F.lane) * dil) * 8 + hd] = m + log2f(lt);
    }
}
__device__ __forceinline__ void merge_a(Frame& F, const bf16* OG, const float* LSE, bf16* OUT) {
    const long stride = (long)F.G * NWAVES * 64, NI = (long)NTOK * 64;
    for (long i = (long)F.bid * NWAVES * 64 + F.tid; i < NI; i += 2 * stride) {
        const bool has2 = i + stride < NI; const long i2 = has2 ? i + stride : i;
        const long tokA = i >> 6, tokB = i2 >> 6; const int cA = (int)(i & 63), cB = (int)(i2 & 63), hA = cA >> 3, hB = cB >> 3;
        const float lA0 = LSE[tokA * 8 + hA], lA1 = LSE[(size_t)NTOK * 8 + tokA * 8 + hA], lA2 = LSE[(size_t)2 * NTOK * 8 + tokA * 8 + hA];
        const float lB0 = LSE[tokB * 8 + hB], lB1 = LSE[(size_t)NTOK * 8 + tokB * 8 + hB], lB2 = LSE[(size_t)2 * NTOK * 8 + tokB * 8 + hB];
        float a0[8], a1[8], a2[8], b0[8], b1[8], b2[8];
        ld8(OG + tokA * 512 + cA * 8, a0); ld8(OG + (size_t)NTOK * 512 + tokA * 512 + cA * 8, a1); ld8(OG + (size_t)2 * NTOK * 512 + tokA * 512 + cA * 8, a2);
        ld8(OG + tokB * 512 + cB * 8, b0); ld8(OG + (size_t)NTOK * 512 + tokB * 512 + cB * 8, b1); ld8(OG + (size_t)2 * NTOK * 512 + tokB * 512 + cB * 8, b2);
        { const float mx = fmaxf(lA0, fmaxf(lA1, lA2)); const float w0 = ex2(lA0 - mx), w1 = ex2(lA1 - mx), w2 = ex2(lA2 - mx), rw = 1.0f / (w0 + w1 + w2);
          float y[8];
#pragma unroll
          for (int e = 0; e < 8; ++e) y[e] = (w0 * a0[e] + w1 * a1[e] + w2 * a2[e]) * rw;
          v4u w; w.x = pk2(y[0], y[1]); w.y = pk2(y[2], y[3]); w.z = pk2(y[4], y[5]); w.w = pk2(y[6], y[7]);
          *(GAS v4u*)(OUT + tokA * 512 + cA * 8) = w; }
        if (has2) { const float mx = fmaxf(lB0, fmaxf(lB1, lB2)); const float w0 = ex2(lB0 - mx), w1 = ex2(lB1 - mx), w2 = ex2(lB2 - mx), rw = 1.0f / (w0 + w1 + w2);
          float y[8];
#pragma unroll
          for (int e = 0; e < 8; ++e) y[e] = (w0 * b0[e] + w1 * b1[e] + w2 * b2[e]) * rw;
          v4u w; w.x = pk2(y[0], y[1]); w.y = pk2(y[2], y[3]); w.z = pk2(y[4], y[5]); w.w = pk2(y[6], y[7]);
          *(GAS v4u*)(OUT + tokB * 512 + cB * 8) = w; }
    }
}

__device__ __forceinline__ void knorm_phase(Frame& F, const bf16* QKV, float* KN) {
    const int gw = F.bid * NWAVES + F.wave, NGW = F.G * NWAVES;
    for (int it = gw; it < BATCH * 64 * 16; it += NGW) {
        const int hm = it & 15, tile = (it >> 4) & 63, b = it >> 10;
        const bf16* row = QKV + ((size_t)b * SEQ + tile * 64 + F.lane) * 3072 + 1024 + hm * 64;
        float s = 0.f;
#pragma unroll
        for (int c = 0; c < 8; ++c) { float f[8]; ld8(row + 8 * c, f);
#pragma unroll
            for (int e = 0; e < 8; ++e) s += f[e] * f[e]; }
        float mx = sqrtf(s);
#pragma unroll
        for (int o_ = 1; o_ < 64; o_ <<= 1) mx = fmaxf(mx, __shfl_xor(mx, o_));
        if (F.lane == 0) KN[((size_t)b * 16 + hm) * 64 + tile] = mx;
    }
}

__device__ __forceinline__ int wave_sum_i(int v) {
#pragma unroll
    for (int o = 1; o < 64; o <<= 1) v += __shfl_xor(v, o);
    return v;
}
__device__ __forceinline__ void moe_layout(Frame& F, const int* wgcnt, LAS int* tot) {
    int t = 0, bfr = 0;
    for (int w = F.lane; w < F.G; w += 64) { const int c = wgcnt[w * 8 + F.wave]; t += c; bfr += (w < F.bid) ? c : 0; }
    t = wave_sum_i(t); bfr = wave_sum_i(bfr);
    if (F.lane == 0) { tot[F.wave] = t; tot[8 + F.wave] = bfr; }
    __syncthreads();
    if (F.tid == 0) { int ps = 0; for (int e = 0; e < 8; ++e) { tot[16 + e] = ps + tot[8 + e]; ps += ((tot[e] + 255) >> 8) << 8; F.MISC[16 + e] = (unsigned)(ps >> 8); } F.MISC[24] = (unsigned)(ps >> 8); }
    __syncthreads();
}

__device__ __forceinline__ void ropeq_phase(Frame& F, bf16* Q, const float* tab) {
    const int gw = F.bid * NWAVES + F.wave, NGW = F.G * NWAVES;
    for (int r = gw; r < NTOK; r += NGW) {
        GAS v4u* p = (GAS v4u*)(Q + (size_t)r * 1536 + 1024) + F.lane; v4u w = *p;
        const float* t = tab + (size_t)(r % SEQ) * 32 + 8 * (F.lane & 3); const f32x4 c0 = *(const GAS f32x4*)t, c1 = *(const GAS f32x4*)(t + 4);
        float a, b;
        a = bf_lo(w.x); b = bf_hi(w.x); w.x = pk2(a * c0[0] - b * c0[1], a * c0[1] + b * c0[0]);
        a = bf_lo(w.y); b = bf_hi(w.y); w.y = pk2(a * c0[2] - b * c0[3], a * c0[3] + b * c0[2]);
        a = bf_lo(w.z); b = bf_hi(w.z); w.z = pk2(a * c1[0] - b * c1[1], a * c1[1] + b * c1[0]);
        a = bf_lo(w.w); b = bf_hi(w.w); w.w = pk2(a * c1[2] - b * c1[3], a * c1[3] + b * c1[2]);
        *p = w;
    }
}

#ifndef MK_SPLIT
#define MK_SPLIT 0
#endif
#ifndef NAIVE_A
#define NAIVE_A 0
#endif
#ifndef NAIVE_B
#define NAIVE_B 0
#endif
#ifndef NAIVE_C
#define NAIVE_C 0
#endif
#ifndef NAIVE_D
#define NAIVE_D 0
#endif
#ifndef QKVD_F8
#define QKVD_F8 1
#endif
#ifndef FFN2_F8
#define FFN2_F8 1
#endif
constexpr int N_PHASES = 32;
struct Args { const float* in[N_IN]; float* out; unsigned char* ws; int ph_lo, ph_hi; };
static_assert(sizeof(Args) == N_IN * 8 + 8 + 8 + 8, "Args has no padding holes");

__global__ void __launch_bounds__(NWAVES * 64, 2) fwd_kernel(Args args) {
    extern __shared__ __attribute__((aligned(16))) unsigned char lds[];
    Frame F;
    F.lds = (LAS unsigned char*)lds;
    F.MISC = (volatile LAS unsigned*)(F.lds + MISC_OFF);
    F.tid = threadIdx.x; F.lane = F.tid & 63; F.wave = __builtin_amdgcn_readfirstlane(F.tid >> 6);
    F.G = gridDim.x; F.bid = blockIdx.x;
    unsigned char* ws = args.ws;
    F.ctl = (gu32*)(ws + WS_CTL);
    if (F.tid < 64) F.MISC[F.tid] = 0u;
    __syncthreads();
    XcdBarrier bar; bar.bar = (unsigned*)(F.ctl + CW_BAR); bar.x = 0; bar.st = nullptr;
    if (!MK_SPLIT) bar = xcd_barrier_post((unsigned*)(F.ctl + CW_BAR), F.MISC + 8);
    const int lo = args.ph_lo, hi = args.ph_hi;
#ifndef CT_LO
#define CT_LO 0
#endif
#ifndef CT_HI
#define CT_HI 1000
#endif
#define IN(k) ((k) >= CT_LO && (k) < CT_HI && lo <= (k) && (k) < hi)
#ifndef PROBE_MASK
#define PROBE_MASK 0ull
#endif
#define NREP(k) ((((unsigned long long)(PROBE_MASK) >> (k)) & 1ull) ? 2 : 1)
#define SEAM(k) do { if (!MK_SPLIT && IN(k) && IN((k) + 1)) xcd_barrier(bar); } while (0)
#define WSP(T, off) ((T*)(ws + (off)))
#define GEMM_STATIC(EPI_T, Ap, Bp, M_, N_, K_, ...) do { pg8::Gemm g{(const pg8::bf16_t*)(Ap), (const pg8::bf16_t*)(Bp), M_, N_, K_, 0}; pg8::StaticOrder S; S.init(M_, N_, F.G, F.bid); \
        EPI_T E{__VA_ARGS__}; pg8::gemm_phase<EPI_T, pg8::StaticOrder, PG8_ALIGN, PG8_SP2>(F.lds + RING_OFF, g, S, E); } while (0)
#define GEMM_STATIC_LDA(EPI_T, Ap, lda_, Bp, M_, N_, K_, ...) do { pg8::Gemm g{(const pg8::bf16_t*)(Ap), (const pg8::bf16_t*)(Bp), M_, N_, K_, 0, lda_}; pg8::StaticOrder S; S.init(M_, N_, F.G, F.bid); \
        EPI_T E{__VA_ARGS__}; pg8::gemm_phase<EPI_T, pg8::StaticOrder, PG8_ALIGN, PG8_SP2>(F.lds + RING_OFF, g, S, E); } while (0)
#define GEMM_STATIC_F8(EPI_T, Ap, Bp, M_, N_, K_, ...) do { pg8::Gemm g{(const pg8::bf16_t*)(Ap), (const pg8::bf16_t*)(Bp), M_, N_, K_, 0}; pg8::StaticOrder S; S.init(M_, N_, F.G, F.bid); \
        EPI_T E{__VA_ARGS__}; pg8::gemm_phase<EPI_T, pg8::StaticOrder, PG8_ALIGN, PG8_SP2, true>(F.lds + RING_OFF, g, S, E); } while (0)
#define GEMM_MOE(EPI_T, Ap, Bp, N_, K_, ...) do { if (MK_SPLIT) moe_layout(F, WSP(int, WS_WGCNT), (LAS int*)(F.lds + RING_OFF));     \
        pg8::Gemm g{(const pg8::bf16_t*)(Ap), (const pg8::bf16_t*)(Bp), 0, N_, K_, (size_t)(N_) * (K_) * 2}; pg8::MoeOrder S; const int nblk_ = (int)F.MISC[24]; S.so.init(nblk_ * 256, N_, F.G, F.bid); \
        _Pragma("unroll") for (int j_ = 0; j_ < 8; ++j_) S.pend[j_] = __builtin_amdgcn_readfirstlane((int)F.MISC[16 + j_]); \
        __syncthreads(); EPI_T E{__VA_ARGS__}; pg8::gemm_phase<EPI_T, pg8::MoeOrder, PG8_ALIGN, PG8_SP2, true>(F.lds + RING_OFF, g, S, E); } while (0)
    const float* const* in = args.in;
    const bool M3_SPLIT = (F.G == 256) && !MK_SPLIT && lo == 0 && hi >= N_PHASES;
    bf16* H = WSP(bf16, WS_H); bf16* XB = WSP(bf16, WS_XB); bf16* BIG = WSP(bf16, WS_BIG); bf16* XR = WSP(bf16, WS_XR);
    float* SS = WSP(float, WS_SS);
#define SSQ(s) (SS + (size_t)(s) * NTOK * pg8::SSW)
    const float QS = 0.125f * LOG2E;
    const int gw = F.bid * NWAVES + F.wave, NGW = F.G * NWAVES;
    LAS float* scr = (LAS float*)(F.lds + RING_OFF + F.wave * 16384);
#define PH(k) if (IN(k)) for (int rep_ = 0; rep_ < NREP(k); ++rep_)

    PH(0) {
        int base = 0;
        conv_matrix(in[I_A_WQKV], DM, 4608, WSP(bf16, W_QKV_A), MAP_ID, 1536, QS, in[I_A_NORM], scr, gw, NGW, base, F.lane);
        conv_matrix(in[I_A_WO], 512, DM, WSP(bf16, W_O_A), MAP_ID, 0, 1.f, nullptr, scr, gw, NGW, base, F.lane);
        conv_matrix(in[I_F0_WG], DM, FFD, WSP(bf16, W_GU0), MAP_GATE, 0, 1.f, in[I_F0_NORM], scr, gw, NGW, base, F.lane);
        conv_matrix(in[I_F0_WU], DM, FFD, WSP(bf16, W_GU0), MAP_UP, 0, 1.f, in[I_F0_NORM], scr, gw, NGW, base, F.lane);
        conv_matrix(in[I_F0_WD], FFD, DM, WSP(bf16, W_D0), MAP_ID, 0, 1.f, nullptr, scr, gw, NGW, base, F.lane);
        conv_matrix(in[I_B_WQKV], DM, 3072, WSP(bf16, W_QKV_B), MAP_ID, 1024, QS, in[I_B_NORM], scr, gw, NGW, base, F.lane);
        conv_matrix(in[I_B_WO], DM, DM, WSP(bf16, W_O_B), MAP_ID, 0, 1.f, nullptr, scr, gw, NGW, base, F.lane);
        conv_matrix(in[I_C_WIN], DM, 672, WSP(bf16, W_IN_C), MAP_CIN, 0, 1.f, in[I_C_NORM], scr, gw, NGW, base, F.lane);
        conv_matrix(in[I_C_WQUP], 384, 1536, WSP(bf16, W_QUP_C), MAP_CQUP, 1536, 0.10206207261596575f * LOG2E, in[I_C_QNORM], scr, gw, NGW, base, F.lane);
        conv_matrix(in[I_C_WKVUP], 256, 2048, WSP(bf16, W_KVUP_C), MAP_CKVUP, 0, 1.f, in[I_C_KVNORM], scr, gw, NGW, base, F.lane);
        conv_matrix(in[I_C_WO], DM, DM, WSP(bf16, W_O_C), MAP_ID, 0, 1.f, nullptr, scr, gw, NGW, base, F.lane);
        if (FFN2_F8) { conv_matrix_f8(in[I_F2_WG], DM, FFD, ws + W_GU2, MAP_GATE, F8_SW1, in[I_F2_NORM], scr, gw, NGW, base, F.lane); conv_matrix_f8(in[I_F2_WU], DM, FFD, ws + W_GU2, MAP_UP, F8_SW1, in[I_F2_NORM], scr, gw, NGW, base, F.lane);
                       conv_matrix_f8(in[I_F2_WD], FFD, DM, ws + W_D2, MAP_ID, F8_SW2, nullptr, scr, gw, NGW, base, F.lane); }
        else { conv_matrix(in[I_F2_WG], DM, FFD, WSP(bf16, W_GU2), MAP_GATE, 0, 1.f, in[I_F2_NORM], scr, gw, NGW, base, F.lane); conv_matrix(in[I_F2_WU], DM, FFD, WSP(bf16, W_GU2), MAP_UP, 0, 1.f, in[I_F2_NORM], scr, gw, NGW, base, F.lane);
               conv_matrix(in[I_F2_WD], FFD, DM, WSP(bf16, W_D2), MAP_ID, 0, 1.f, nullptr, scr, gw, NGW, base, F.lane); }
        if (QKVD_F8) conv_matrix_f8q(in[I_D_WQKV], DM, 3072, ws + W_QKV_D, MAP_ID, F8_SW1, 1024, QS, in[I_D_NORM], scr, gw, NGW, base, F.lane);
        else conv_matrix(in[I_D_WQKV], DM, 3072, WSP(bf16, W_QKV_D), MAP_ID, 1024, QS, in[I_D_NORM], scr, gw, NGW, base, F.lane);
        conv_matrix(in[I_D_WO], DM, DM, WSP(bf16, W_O_D), MAP_ID, 0, 1.f, nullptr, scr, gw, NGW, base, F.lane);
        conv_moe(in[I_M1_WG], in[I_M1_WU], in[I_M1_WD], in[I_M1_NORM], ws + W_MOE_GU, ws + W_MOE_D, scr, gw, NGW, F.lane);
        conv_moe(in[I_M3_WG], in[I_M3_WU], in[I_M3_WD], in[I_M3_NORM], ws + W_MOE_GU + W_MOE_L2, ws + W_MOE_D + W_MOE_L2, scr, gw, NGW, F.lane, 0, M3_SPLIT ? 4 : NEXP);
        { GAS v4u* z = (GAS v4u*)(ws + W_IN_C + (size_t)672 * DM * 2); const v4u zz = {0u, 0u, 0u, 0u};
          for (int i = F.bid * NWAVES * 64 + F.tid; i < 96 * DM * 2 / 16; i += F.G * NWAVES * 64) z[i] = zz; }
        { float* tab = WSP(float, WS_ROPE);
          for (int i = F.bid * NWAVES * 64 + F.tid; i < SEQ * 16; i += F.G * NWAVES * 64) { const int pos = i >> 4, fi = i & 15;
              const float inv = exp2f(-(float)fi * (13.287712379549449f / 16.0f)); const float ang = (float)pos * inv;
              const double rev = (double)ang * 0.15915494309189535; const float fr = (float)(rev - floor(rev + 0.5));
              tab[2 * i] = __builtin_amdgcn_cosf(fr); tab[2 * i + 1] = __builtin_amdgcn_sinf(fr); } }
        { float* gwr = WSP(float, WS_GWR);
          for (int i = F.bid * NWAVES * 64 + F.tid; i < 2 * DM * 8; i += F.G * NWAVES * 64) { const int l = i >> 13, j = i & 8191;
              gwr[i] = (l ? in[I_M3_WR] : in[I_M1_WR])[j] * (l ? in[I_M3_NORM] : in[I_M1_NORM])[j >> 3]; } }
        row_phase<0>(F, in[I_X], XR, SSQ(0), nullptr, nullptr, nullptr, nullptr, nullptr, nullptr, nullptr, nullptr);
    }
    SEAM(0);
    PH(1) GEMM_STATIC(pg8::EpiBf16, XR, ws + W_QKV_A, NTOK, 4608, DM, BIG, 4608, SSQ(0), 1.0f);
    SEAM(1);
    PH(2) { fast_attn_a(F, BIG, XB, WSP(float, WS_XB + 96 * MiB)); }
    SEAM(2);
    PH(3) { merge_a(F, XB, WSP(float, WS_XB + 96 * MiB), H); }
    SEAM(3);
    PH(4) GEMM_STATIC(pg8::EpiResidB, H, ws + W_O_A, NTOK, DM, 512, XR, DM, 1.0f, SSQ(1), (PG8_LAS float*)(F.lds + RESTAB_OFF), nullptr, 0.0f);
    SEAM(4);
    PH(5) GEMM_STATIC(pg8::EpiSwiglu, XR, ws + W_GU0, NTOK, 2 * FFD, DM, BIG, FFD, SSQ(1));
    SEAM(5);
    PH(6) GEMM_STATIC(pg8::EpiResidB, BIG, ws + W_D0, NTOK, DM, FFD, XR, DM, 1.0f, SSQ(2), (PG8_LAS float*)(F.lds + RESTAB_OFF), nullptr, 0.0f);
    SEAM(6);
    PH(7) GEMM_STATIC(pg8::EpiBf16, XR, ws + W_QKV_B, NTOK, 3072, DM, BIG, 3072, SSQ(2), 1.0f);
    SEAM(7);
    PH(8) { knorm_phase(F, BIG, WSP(float, WS_KN)); }
    SEAM(8);
    PH(9) { fast_attn_b(F, BIG, WSP(float, WS_KN), (unsigned*)(F.ctl + CW_QB), H, in[I_B_LQ1], in[I_B_LK1], in[I_B_LQ2], in[I_B_LK2], in[I_B_SUBLN]); }
    SEAM(9);
    PH(10) GEMM_STATIC(pg8::EpiResidB, H, ws + W_O_B, NTOK, DM, DM, XR, DM, 1.0f, SSQ(3), (PG8_LAS float*)(F.lds + RESTAB_OFF), nullptr, 0.0f);
    SEAM(10);
    PH(11) row_phase<1>(F, nullptr, XR, SSQ(3), nullptr, nullptr, nullptr, nullptr, WSP(float, WS_GWR), WSP(int, WS_TOKE), WSP(float, WS_TOKG), WSP(int, WS_WGCNT));
    SEAM(11);
    PH(12) { LAS int* tot = (LAS int*)(F.lds + RING_OFF); moe_layout(F, WSP(int, WS_WGCNT), tot); slot_phase(F, tot, WSP(int, WS_TOKE), WSP(float, WS_TOKG), WSP(int, WS_TOKS), WSP(float, WS_SGATE), WSP(float, WS_SSS), SSQ(3), XR, (unsigned char*)XB); }
    SEAM(12);
    PH(13) GEMM_MOE(pg8::EpiSwigluF8, XB, ws + W_MOE_GU, 2 * FFE, DM / 2, (unsigned char*)BIG, FFE, 1.0f / (F8_SA * F8_SW1), F8_SACT, WSP(float, WS_SSS), nullptr);
    SEAM(13);
    PH(14) { GEMM_MOE(pg8::EpiMoeDown, BIG, ws + W_MOE_D, DM, FFE / 2, XB, DM, WSP(float, WS_SGATE), 1.0f / (F8_SACT * F8_SW2));
             if (M3_SPLIT && F.bid >= 32) conv_moe(in[I_M3_WG], in[I_M3_WU], in[I_M3_WD], in[I_M3_NORM], ws + W_MOE_GU + W_MOE_L2, ws + W_MOE_D + W_MOE_L2, scr, (F.bid - 32) * NWAVES + F.wave, (F.G - 32) * NWAVES, F.lane, 5, 8); }
    SEAM(14);
    PH(15) row_phase<2>(F, nullptr, XR, SSQ(4), nullptr, nullptr, XB, WSP(int, WS_TOKS), nullptr, nullptr, nullptr, nullptr);
    SEAM(15);
    PH(16) { GEMM_STATIC(pg8::EpiLat, XR, ws + W_IN_C, NTOK, 768, DM, WSP(bf16, C_LAT), SSQ(4), SSQ(8), SSQ(9), (PG8_LAS float*)(F.lds + RESTAB_OFF));
             if (M3_SPLIT && F.bid >= 128) conv_moe(in[I_M3_WG], in[I_M3_WU], in[I_M3_WD], in[I_M3_NORM], ws + W_MOE_GU + W_MOE_L2, ws + W_MOE_D + W_MOE_L2, scr, (F.bid - 128) * NWAVES + F.wave, (F.G - 128) * NWAVES, F.lane, 4, 5); }
    SEAM(16);
    PH(17) { kpe_phase(F, WSP(bf16, C_LAT), WSP(float, WS_ROPE), WSP(bf16, C_KPE));
             GEMM_STATIC_LDA(pg8::EpiBf16, ws + C_LAT, 768, ws + W_QUP_C, NTOK, 1536, 384, WSP(bf16, C_Q), 1536, SSQ(8), 1.0f);
             GEMM_STATIC_LDA(pg8::EpiBf16, ws + C_LAT + 384 * 2, 768, ws + W_KVUP_C, NTOK, 2048, 256, WSP(bf16, C_KV), 2048, SSQ(9), 1.0f); }
    SEAM(19);
    PH(20) { fast_attn_c(F, WSP(bf16, C_Q), WSP(bf16, C_KV), WSP(bf16, C_KPE), WSP(float, WS_ROPE), H); }
    SEAM(20);
    PH(21) { if (FFN2_F8) GEMM_STATIC(pg8::EpiResidB8, H, ws + W_O_C, NTOK, DM, DM, XR, DM, 1.0f, SSQ(5), (PG8_LAS float*)(F.lds + RESTAB_OFF), (unsigned char*)XB, F8_SA); else GEMM_STATIC(pg8::EpiResidB, H, ws + W_O_C, NTOK, DM, DM, XR, DM, 1.0f, SSQ(5), (PG8_LAS float*)(F.lds + RESTAB_OFF), nullptr, 0.0f); }
    SEAM(21);
    PH(22) { if (FFN2_F8) GEMM_STATIC_F8(pg8::EpiSwigluF8, XB, ws + W_GU2, NTOK, 2 * FFD, DM / 2, (unsigned char*)BIG, FFD, 1.0f / (F8_SA * F8_SW1), F8_SACT, nullptr, SSQ(5)); else GEMM_STATIC(pg8::EpiSwiglu, XR, ws + W_GU2, NTOK, 2 * FFD, DM, BIG, FFD, SSQ(5)); }
    SEAM(22);
    PH(23) { if (FFN2_F8 && QKVD_F8) GEMM_STATIC_F8(pg8::EpiResidB8, BIG, ws + W_D2, NTOK, DM, FFD / 2, XR, DM, 1.0f / (F8_SACT * F8_SW2), SSQ(6), (PG8_LAS float*)(F.lds + RESTAB_OFF), (unsigned char*)XB, F8_SA);
             else if (FFN2_F8) GEMM_STATIC_F8(pg8::EpiResidB, BIG, ws + W_D2, NTOK, DM, FFD / 2, XR, DM, 1.0f / (F8_SACT * F8_SW2), SSQ(6), (PG8_LAS float*)(F.lds + RESTAB_OFF), nullptr, 0.0f);
             else GEMM_STATIC(pg8::EpiResidB, BIG, ws + W_D2, NTOK, DM, FFD, XR, DM, 1.0f, SSQ(6), (PG8_LAS float*)(F.lds + RESTAB_OFF), nullptr, 0.0f); }
    SEAM(23);
    PH(24) { if (QKVD_F8) GEMM_STATIC_F8(pg8::EpiBf16, XB, ws + W_QKV_D, NTOK, 3072, DM / 2, BIG, 3072, SSQ(6), 1.0f / (F8_SA * F8_SW1)); else GEMM_STATIC(pg8::EpiBf16, XR, ws + W_QKV_D, NTOK, 3072, DM, BIG, 3072, SSQ(6), 1.0f); }
    SEAM(24);
    PH(25) { fast_attn_d(F, BIG, H); }
    SEAM(25);
    PH(26) GEMM_STATIC(pg8::EpiResidB, H, ws + W_O_D, NTOK, DM, DM, XR, DM, 1.0f, SSQ(7), (PG8_LAS float*)(F.lds + RESTAB_OFF), nullptr, 0.0f);
    SEAM(26);
    PH(27) row_phase<1>(F, nullptr, XR, SSQ(7), nullptr, nullptr, nullptr, nullptr, WSP(float, WS_GWR) + DM * 8, WSP(int, WS_TOKE), WSP(float, WS_TOKG), WSP(int, WS_WGCNT));
    SEAM(27);
    PH(28) { LAS int* tot = (LAS int*)(F.lds + RING_OFF); moe_layout(F, WSP(int, WS_WGCNT), tot); slot_phase(F, tot, WSP(int, WS_TOKE), WSP(float, WS_TOKG), WSP(int, WS_TOKS), WSP(float, WS_SGATE), WSP(float, WS_SSS), SSQ(7), XR, (unsigned char*)XB); }
    SEAM(28);
    PH(29) GEMM_MOE(pg8::EpiSwigluF8, XB, ws + W_MOE_GU + W_MOE_L2, 2 * FFE, DM / 2, (unsigned char*)BIG, FFE, 1.0f / (F8_SA * F8_SW1), F8_SACT, WSP(float, WS_SSS), nullptr);
    SEAM(29);
    PH(30) GEMM_MOE(pg8::EpiMoeDown, BIG, ws + W_MOE_D + W_MOE_L2, DM, FFE / 2, XB, DM, WSP(float, WS_SGATE), 1.0f / (F8_SACT * F8_SW2));
    SEAM(30);
    PH(31) row_phase<3>(F, nullptr, XR, nullptr, in[I_FINAL_NORM], args.out, XB, WSP(int, WS_TOKS), nullptr, nullptr, nullptr, nullptr);
#undef IN
#undef SEAM
}

extern "C" void kernel_launch(void* const* d_in, const int* in_sizes, int n_in, void* d_out, int out_size, void* d_ws, size_t ws_size, hipStream_t stream) {
    static int grid = 0;
    if (grid == 0) {
        if (n_in != N_IN || out_size != NTOK * DM || ws_size < WS_SSS + 5 * MiB) { fprintf(stderr, "kernel_launch: unexpected problem shape (n_in %d, out %d, ws %zu)\n", n_in, out_size, ws_size); grid = -1; return; }
        int dev = 0, cus = 0, per_cu = 0;
        if (hipGetDevice(&dev) != hipSuccess || hipDeviceGetAttribute(&cus, hipDeviceAttributeMultiprocessorCount, dev) != hipSuccess) { grid = -1; return; }
        if (hipFuncSetAttribute((const void*)fwd_kernel, hipFuncAttributeMaxDynamicSharedMemorySize, LDS_BYTES) != hipSuccess) { fprintf(stderr, "kernel_launch: hipFuncSetAttribute failed\n"); grid = -1; return; }
        if (hipOccupancyMaxActiveBlocksPerMultiprocessor(&per_cu, (const void*)fwd_kernel, NWAVES * 64, LDS_BYTES) != hipSuccess || per_cu < 1) { fprintf(stderr, "kernel_launch: occupancy query reports %d\n", per_cu); }
        (void)hipGetLastError();
        grid = cus;
    }
    if (grid < 0) return;
    (void)hipMemsetAsync((char*)d_ws + WS_CTL, 0, CTL_ZERO_BYTES, stream);
    Args a{};
    for (int i = 0; i < N_IN; ++i) a.in[i] = (const float*)d_in[i];
    a.out = (float*)d_out; a.ws = (unsigned char*)d_ws;
#if MK_SPLIT
    for (int p = 0; p < N_PHASES; ++p) { a.ph_lo = p; a.ph_hi = p + 1; hipLaunchKernelGGL(fwd_kernel, dim3(grid), dim3(NWAVES * 64), LDS_BYTES, stream, a); }
#else
    a.ph_lo = 0; a.ph_hi = N_PHASES;
    hipLaunchKernelGGL(fwd_kernel, dim3(grid), dim3(NWAVES * 64), LDS_BYTES, stream, a);
#endif
}
```

```cpp
#include <hip/hip_runtime.h>
#ifndef MOE_Y8
#define MOE_Y8 1
#endif
#ifndef QKVA_F8
#define QKVA_F8 1
#endif
#ifndef WOC_F8
#define WOC_F8 1
#endif
#ifndef WOD_F8
#define WOD_F8 1
#endif
#include <cstdio>
#include <cstdint>
#include <cmath>

namespace pg8 {
#define PG8_LAS __attribute__((address_space(3)))
typedef unsigned short bf16_t;
typedef short bf16x8 __attribute__((ext_vector_type(8)));
typedef float f32x4 __attribute__((ext_vector_type(4)));
typedef unsigned u32x4 __attribute__((ext_vector_type(4)));
constexpr int BM = 256, BK = 64, HALF = 128, HTB = HALF * BK * 2  , STAGE_BYTES = 8 * HTB, NXCD = 8, WGM = 8;

__host__ __device__ __forceinline__ int lds_byte(int r, int c) { const int st = (r >> 4) * 2 + (c >> 5), rr = r & 15, cc = c & 31, ob = rr * 64 + cc * 2; return st * 1024 + (ob ^ (((ob >> 9) & 1) << 5)); }
__host__ __device__ __forceinline__ void stage_rc(int b, int& R, int& C) { const int st = b / 1024, sb = b % 1024, swz = sb ^ (((sb >> 9) & 1) << 5); R = (st >> 1) * 16 + swz / 64; C = (st & 1) * 32 + (swz % 64) / 2; }
__host__ __device__ __forceinline__ int perm32(int rho) { const int n = rho >> 4, i = rho & 15; return 8 * (i >> 2) + 4 * n + (i & 3); }

struct Unit { int pm, pn, e; };
struct Gemm { const bf16_t* A; const bf16_t* Bt; int M, N, K; size_t estride; int lda; };

struct StaticOrder {
    int nM, nN, nwg, G, c;
    __host__ __device__ void init(int M, int N, int G_, int c_) { nM = M / BM; nN = N / BM; nwg = nM * nN; G = G_; c = c_; }
    __host__ __device__ bool next(int i, Unit& u) const {
        const long L = (long)i * G + c; if (L >= nwg) return false;
        int wgid = (int)L; { const int q = nwg / NXCD, r = nwg % NXCD, xcd = wgid % NXCD, off = wgid / NXCD; wgid = (xcd < r ? xcd * (q + 1) : r * (q + 1) + (xcd - r) * q) + off; }
        const int nig = WGM * nN, gid = wgid / nig, fm = gid * WGM, gsz = (nM - fm) < WGM ? (nM - fm) : WGM;
        u.pm = fm + ((wgid % nig) % gsz); u.pn = (wgid % nig) / gsz; u.e = 0; return true;
    }
    __device__ __forceinline__ void a_ready(const Unit&) const {}
    __device__ __forceinline__ void done(const Unit&) const {}
};
struct MoeOrder {
    StaticOrder so; int pend[8];
    __device__ __forceinline__ bool next(int i, Unit& u) const {
        if (!so.next(i, u)) return false;
        int e = 0;
#pragma unroll
        for (int j = 0; j < 7; ++j) e += (u.pm >= pend[j]) ? 1 : 0;
        u.e = e; return true;
    }
    __device__ __forceinline__ void a_ready(const Unit&) const {}
    __device__ __forceinline__ void done(const Unit&) const {}
};

__device__ __forceinline__ unsigned cvt_pk_bf16(float lo, float hi) { unsigned r; asm volatile("v_cvt_pk_bf16_f32 %0, %1, %2" : "=v"(r) : "v"(lo), "v"(hi)); return r; }

constexpr int SSW = 4;
__device__ __forceinline__ float rstd_of(const float* ss, int row) {
    const f32x4 a = *(const f32x4*)(ss + (size_t)row * SSW);
    return __builtin_amdgcn_rsqf(((a[0] + a[1]) + (a[2] + a[3])) * (1.0f / 1024.0f) + 1e-6f); }
__device__ __forceinline__ void row_scales8(const float* ss, int row0, float (&rs)[8]) {
    f32x4 t[8];
#pragma unroll
    for (int i = 0; i < 8; ++i) t[i] = *(const f32x4*)(ss + (size_t)(row0 + (i >> 2) * HALF + (i & 3) * 16) * SSW);
#pragma unroll
    for (int i = 0; i < 8; ++i) rs[i] = __builtin_amdgcn_rsqf(((t[i][0] + t[i][1]) + (t[i][2] + t[i][3])) * (1.0f / 1024.0f) + 1e-6f);
}
constexpr int PRE_OFF = 131072 + 9216, PRE_SLOT = 4096;
__device__ __forceinline__ void row_scales8_pre(const PG8_LAS float* pre, int mode, int rl0, float (&rs)[8]) {
    if (mode == 1) {
#pragma unroll
        for (int i = 0; i < 8; ++i) { const f32x4 t = *(const PG8_LAS f32x4*)(pre + (rl0 + (i >> 2) * HALF + (i & 3) * 16) * 4); rs[i] = __builtin_amdgcn_rsqf(((t[0] + t[1]) + (t[2] + t[3])) * (1.0f / 1024.0f) + 1e-6f); }
    } else if (mode == 2) {
#pragma unroll
        for (int i = 0; i < 8; ++i) rs[i] = pre[rl0 + (i >> 2) * HALF + (i & 3) * 16];
    } else {
#pragma unroll
        for (int i = 0; i < 8; ++i) rs[i] = 1.0f; }
}
__device__ __forceinline__ float bflo(unsigned w) { return __builtin_bit_cast(float, w << 16); }
__device__ __forceinline__ float bfhi(unsigned w) { return __builtin_bit_cast(float, w & 0xffff0000u); }
__device__ __forceinline__ u32x4 dpp_swap1(const u32x4 v) { u32x4 r;
    r.x = (unsigned)__builtin_amdgcn_update_dpp(0, (int)v.x, 0xB1, 0xF, 0xF, false); r.y = (unsigned)__builtin_amdgcn_update_dpp(0, (int)v.y, 0xB1, 0xF, 0xF, false);
    r.z = (unsigned)__builtin_amdgcn_update_dpp(0, (int)v.z, 0xB1, 0xF, 0xF, false); r.w = (unsigned)__builtin_amdgcn_update_dpp(0, (int)v.w, 0xB1, 0xF, 0xF, false); return r; }
__device__ __forceinline__ void wide_store(bf16_t* pa, int ldc, bool odd, const u32x4 w0, const u32x4 w1) {
    const u32x4 recv = dpp_swap1(odd ? w0 : w1);
    *(u32x4*)pa = odd ? recv : w0; *(u32x4*)(pa + ldc) = odd ? w1 : recv; }
struct EpiBf16 {
    static constexpr bool PERM = true, AFTER_DRAIN = false, WIDE = true;
    bf16_t* O; int ldc; const float* ss; float cin;
    __device__ __forceinline__ int pre_desc(const Unit& u, const char*& src) const { src = (const char*)(ss + (size_t)u.pm * BM * SSW); return ss ? 1 : 0; }
    __device__ __forceinline__ void operator()(const f32x4 (&acc)[2][2][4][2], const Unit& u, int wr, int wc, int fr, int fq, const PG8_LAS float* pre) const {
        const bool odd = (fr & 1) != 0;
        const int rowe = u.pm * BM + wr * 64 + (fr & ~1), colq = u.pn * BM + wc * 64 + 8 * fq + (odd ? 32 : 0);
        float rs8[8];
        row_scales8_pre(pre, ss ? 1 : 0, wr * 64 + fr, rs8);
#pragma unroll
        for (int i = 0; i < 8; ++i) rs8[i] *= cin;
#pragma unroll
        for (int ai = 0; ai < 2; ++ai)
#pragma unroll
            for (int m = 0; m < 4; ++m) { const float rs = rs8[ai * 4 + m]; u32x4 w[2];
#pragma unroll
                for (int bj = 0; bj < 2; ++bj) { const f32x4 v0 = acc[ai][bj][m][0] * rs, v1 = acc[ai][bj][m][1] * rs;
                    w[bj].x = cvt_pk_bf16(v0[0], v0[1]); w[bj].y = cvt_pk_bf16(v0[2], v0[3]); w[bj].z = cvt_pk_bf16(v1[0], v1[1]); w[bj].w = cvt_pk_bf16(v1[2], v1[3]); }
                const u32x4 send = odd ? w[0] : w[1]; u32x4 recv;
                recv.x = (unsigned)__builtin_amdgcn_update_dpp(0, (int)send.x, 0xB1, 0xF, 0xF, false); recv.y = (unsigned)__builtin_amdgcn_update_dpp(0, (int)send.y, 0xB1, 0xF, 0xF, false);
                recv.z = (unsigned)__builtin_amdgcn_update_dpp(0, (int)send.z, 0xB1, 0xF, 0xF, false); recv.w = (unsigned)__builtin_amdgcn_update_dpp(0, (int)send.w, 0xB1, 0xF, 0xF, false);
                bf16_t* pa = O + (size_t)(rowe + ai * HALF + m * 16) * ldc + colq;
                *(u32x4*)pa = odd ? recv : w[0];
                *(u32x4*)(pa + ldc) = odd ? w[1] : recv; }
    }
};
struct EpiLat {
    static constexpr bool PERM = true, AFTER_DRAIN = false, WIDE = false;
    bf16_t* O; const float* ss; float* ssq; float* sskv; PG8_LAS float* tab;
    __device__ __forceinline__ int pre_desc(const Unit& u, const char*& src) const { src = (const char*)(ss + (size_t)u.pm * BM * SSW); return 1; }
    __device__ __forceinline__ void operator()(const f32x4 (&acc)[2][2][4][2], const Unit& u, int wr, int wc, int fr, int fq, const PG8_LAS float* pre) const {
        const int row0 = u.pm * BM + wr * 64 + fr, col0 = u.pn * BM + wc * 32 + 8 * fq;
        float rs8[8];
        row_scales8_pre(pre, 1, wr * 64 + fr, rs8);
#pragma unroll
        for (int ai = 0; ai < 2; ++ai)
#pragma unroll
            for (int m = 0; m < 4; ++m) { const int row = row0 + ai * HALF + m * 16; bf16_t* rowp = O + (size_t)row * 768 + col0; const float rs = rs8[ai * 4 + m]; float part[2];
#pragma unroll
                for (int bj = 0; bj < 2; ++bj) { const f32x4 v0 = acc[ai][bj][m][0] * rs, v1 = acc[ai][bj][m][1] * rs;
                    u32x4 w; w.x = cvt_pk_bf16(v0[0], v0[1]); w.y = cvt_pk_bf16(v0[2], v0[3]); w.z = cvt_pk_bf16(v1[0], v1[1]); w.w = cvt_pk_bf16(v1[2], v1[3]);
                    *(u32x4*)(rowp + bj * HALF) = w;
                    part[bj] = (bflo(w.x) * bflo(w.x) + bfhi(w.x) * bfhi(w.x)) + (bflo(w.y) * bflo(w.y) + bfhi(w.y) * bfhi(w.y)) + (bflo(w.z) * bflo(w.z) + bfhi(w.z) * bfhi(w.z)) + (bflo(w.w) * bflo(w.w) + bfhi(w.w) * bfhi(w.w)); }
#pragma unroll
                for (int bj = 0; bj < 2; ++bj) { part[bj] += __shfl_xor(part[bj], 16); part[bj] += __shfl_xor(part[bj], 32); }
                if (fq == 0) { PG8_LAS float* t = tab + (ai * HALF + wr * 64 + m * 16 + fr) * 8 + wc; t[0] = part[0]; t[4] = part[1]; } }
        asm volatile("s_waitcnt lgkmcnt(0)" ::: "memory"); __builtin_amdgcn_s_barrier(); asm volatile("" ::: "memory");
        { const int t = wr * 256 + wc * 64 + fq * 16 + fr;
          if (t < 256) { const f32x4 q0 = *(const PG8_LAS f32x4*)(tab + t * 8), q1 = *(const PG8_LAS f32x4*)(tab + t * 8 + 4);
              const float p0 = (q0[0] + q0[1]) + (q0[2] + q0[3]), p1 = (q1[0] + q1[1]) + (q1[2] + q1[3]); const size_t o = (size_t)(u.pm * BM + t) * SSW;
              const float cq = 1024.0f / 384.0f, ckv = 4.0f;
              if (u.pn == 0) { ssq[o] = (p0 + p1) * cq; ssq[o + 2] = 0.f; ssq[o + 3] = 0.f; }
              else if (u.pn == 1) { ssq[o + 1] = p0 * cq; sskv[o] = p1 * ckv; sskv[o + 2] = 0.f; sskv[o + 3] = 0.f; }
              else { sskv[o + 1] = p0 * ckv; } } }
    }
};
__device__ __forceinline__ float silu_mul(float g, float u) { return g * u * __builtin_amdgcn_rcpf(1.0f + __builtin_amdgcn_exp2f(-1.4426950408889634f * g)); }
__device__ __forceinline__ f32x4 swiglu4(const f32x4 a, const f32x4 b, float kx, float kk) {
    const f32x4 t = a * kx; f32x4 r;
#pragma unroll
    for (int i = 0; i < 4; ++i) r[i] = __builtin_amdgcn_rcpf(1.0f + __builtin_amdgcn_exp2f(t[i]));
    return ((a * b) * r) * kk;
}
struct EpiSwiglu {
    static constexpr bool PERM = true, AFTER_DRAIN = false, WIDE = false;
    bf16_t* O; int ldc; const float* ss;
    __device__ __forceinline__ int pre_desc(const Unit& u, const char*& src) const { src = (const char*)(ss + (size_t)u.pm * BM * SSW); return ss ? 1 : 0; }
    __device__ __forceinline__ void operator()(const f32x4 (&acc)[2][2][4][2], const Unit& u, int wr, int wc, int fr, int fq, const PG8_LAS float* pre) const {
        const int row0 = u.pm * BM + wr * 64 + fr, col0 = u.pn * HALF + wc * 32 + 8 * fq;
        float rs8[8];
        row_scales8_pre(pre, ss ? 1 : 0, wr * 64 + fr, rs8);
#pragma unroll
        for (int ai = 0; ai < 2; ++ai)
#pragma unroll
            for (int m = 0; m < 4; ++m) { const int row = row0 + ai * HALF + m * 16; bf16_t* rowp = O + (size_t)row * ldc + col0; const float rs = rs8[ai * 4 + m];
                const float kx = -1.4426950408889634f * rs, kk = rs * rs;
                const f32x4 s0 = swiglu4(acc[ai][0][m][0], acc[ai][1][m][0], kx, kk), s1 = swiglu4(acc[ai][0][m][1], acc[ai][1][m][1], kx, kk);
                u32x4 w; w.x = cvt_pk_bf16(s0[0], s0[1]); w.y = cvt_pk_bf16(s0[2], s0[3]); w.z = cvt_pk_bf16(s1[0], s1[1]); w.w = cvt_pk_bf16(s1[2], s1[3]);
                *(u32x4*)rowp = w; }
    }
};
__device__ __forceinline__ float clamp448(float x) { return __builtin_fminf(__builtin_fmaxf(x, -448.0f), 448.0f); }
__device__ __forceinline__ unsigned pk4_fp8(float a, float b, float c, float d) {
    int w = 0; w = __builtin_amdgcn_cvt_pk_fp8_f32(clamp448(a), clamp448(b), w, false); w = __builtin_amdgcn_cvt_pk_fp8_f32(clamp448(c), clamp448(d), w, true); return (unsigned)w; }
struct EpiSwigluF8 {
    static constexpr bool PERM = true, AFTER_DRAIN = false, WIDE = false;
    unsigned char* O; int ldc; float cin, so; const float* rs; const float* ssp;
    __device__ __forceinline__ int pre_desc(const Unit& u, const char*& src) const { src = ssp ? (const char*)(ssp + (size_t)u.pm * BM * SSW) : (const char*)(rs + (size_t)u.pm * BM); return ssp ? 1 : (rs ? 2 : 0); }
    __device__ __forceinline__ void operator()(const f32x4 (&acc)[2][2][4][2], const Unit& u, int wr, int wc, int fr, int fq, const PG8_LAS float* pre) const {
        const int row0 = u.pm * BM + wr * 64 + fr, col0 = u.pn * HALF + wc * 32 + 16 * (fq >> 1);
        float cr[8];
        row_scales8_pre(pre, ssp ? 1 : (rs ? 2 : 0), wr * 64 + fr, cr);
#pragma unroll
        for (int i = 0; i < 8; ++i) cr[i] *= cin;
#pragma unroll
        for (int ai = 0; ai < 2; ++ai)
#pragma unroll
            for (int mp = 0; mp < 2; ++mp) { unsigned lo[2], hi[2];
#pragma unroll
                for (int q = 0; q < 2; ++q) { const int m = 2 * mp + q; const float c = cr[ai * 4 + m];
                    const float kx = -1.4426950408889634f * c, kk = c * c * so;
                    const f32x4 s0 = swiglu4(acc[ai][0][m][0], acc[ai][1][m][0], kx, kk), s1 = swiglu4(acc[ai][0][m][1], acc[ai][1][m][1], kx, kk);
                    lo[q] = pk4_fp8(s0[0], s0[1], s0[2], s0[3]); hi[q] = pk4_fp8(s1[0], s1[1], s1[2], s1[3]); }
                const auto s0 = __builtin_amdgcn_permlane16_swap(lo[0], lo[1], false, false); const auto s1 = __builtin_amdgcn_permlane16_swap(hi[0], hi[1], false, false);
                u32x4 w; w.x = s0[0]; w.y = s1[0]; w.z = s0[1]; w.w = s1[1];
                const int row = row0 + ai * HALF + (2 * mp + (fq & 1)) * 16;
                *(u32x4*)(O + (size_t)row * ldc + col0) = w; }
    }
};
struct EpiResid {
    static constexpr bool PERM = false, AFTER_DRAIN = false;
    const float* base; float* out; int ldc; float cin;
    __device__ __forceinline__ void operator()(const f32x4 (&acc)[2][2][4][2], const Unit& u, int wr, int wc, int fr, int fq) const {
        const int row0 = u.pm * BM + wr * 64 + fr, col0 = u.pn * BM + wc * 32 + 4 * fq;
#pragma unroll
        for (int ai = 0; ai < 2; ++ai)
#pragma unroll
            for (int m = 0; m < 4; ++m) { const size_t off = (size_t)(row0 + ai * HALF + m * 16) * ldc + col0;
#pragma unroll
                for (int bj = 0; bj < 2; ++bj)
#pragma unroll
                    for (int n = 0; n < 2; ++n) { const f32x4 b = *(const f32x4*)(base + off + bj * HALF + n * 16); *(f32x4*)(out + off + bj * HALF + n * 16) = b + acc[ai][bj][m][n] * cin; } }
    }
};
template <bool COPY8> struct EpiResidBT {
    static constexpr bool PERM = true, AFTER_DRAIN = false, WIDE = false;
    bf16_t* x; int ldc; float cin; float* ssq; PG8_LAS float* tab; unsigned char* x8; float s8;
    __device__ __forceinline__ int pre_desc(const Unit&, const char*& src) const { src = nullptr; return 0; }
    __device__ __forceinline__ void operator()(const f32x4 (&acc)[2][2][4][2], const Unit& u, int wr, int wc, int fr, int fq, const PG8_LAS float*) const {
        const int row0 = u.pm * BM + wr * 64 + fr, col0 = u.pn * BM + wc * 32 + 8 * fq;
#pragma unroll
        for (int ai = 0; ai < 2; ++ai) { u32x4 b[4][2];
#pragma unroll
            for (int m = 0; m < 4; ++m)
#pragma unroll
                for (int bj = 0; bj < 2; ++bj) b[m][bj] = *(const u32x4*)(x + (size_t)(row0 + ai * HALF + m * 16) * ldc + col0 + bj * HALF);
#pragma unroll
            for (int m = 0; m < 4; ++m) { const int row = row0 + ai * HALF + m * 16; bf16_t* rowp = x + (size_t)row * ldc + col0; float part = 0.f;
#pragma unroll
                for (int bj = 0; bj < 2; ++bj) { const u32x4 bb = b[m][bj]; const f32x4 a0 = acc[ai][bj][m][0], a1 = acc[ai][bj][m][1];
                    const float y0 = __builtin_fmaf(a0[0], cin, bflo(bb.x)), y1 = __builtin_fmaf(a0[1], cin, bfhi(bb.x)), y2 = __builtin_fmaf(a0[2], cin, bflo(bb.y)), y3 = __builtin_fmaf(a0[3], cin, bfhi(bb.y));
                    const float y4 = __builtin_fmaf(a1[0], cin, bflo(bb.z)), y5 = __builtin_fmaf(a1[1], cin, bfhi(bb.z)), y6 = __builtin_fmaf(a1[2], cin, bflo(bb.w)), y7 = __builtin_fmaf(a1[3], cin, bfhi(bb.w));
                    u32x4 w; w.x = cvt_pk_bf16(y0, y1); w.y = cvt_pk_bf16(y2, y3); w.z = cvt_pk_bf16(y4, y5); w.w = cvt_pk_bf16(y6, y7);
                    *(u32x4*)(rowp + bj * HALF) = w;
                    if (COPY8) { const unsigned lo8 = pk4_fp8(y0 * s8, y1 * s8, y2 * s8, y3 * s8), hi8 = pk4_fp8(y4 * s8, y5 * s8, y6 * s8, y7 * s8);
                        *(unsigned long long*)(x8 + (size_t)row * ldc + col0 + bj * HALF) = (unsigned long long)lo8 | ((unsigned long long)hi8 << 32); }
                    part += (y0 * y0 + y1 * y1) + (y2 * y2 + y3 * y3) + (y4 * y4 + y5 * y5) + (y6 * y6 + y7 * y7); }
                part += __shfl_xor(part, 16); part += __shfl_xor(part, 32);
                if (fq == 0) tab[(ai * HALF + wr * 64 + m * 16 + fr) * 4 + wc] = part; } }
        asm volatile("s_waitcnt lgkmcnt(0)" ::: "memory"); __builtin_amdgcn_s_barrier(); asm volatile("" ::: "memory");
        { const int t = wr * 256 + wc * 64 + fq * 16 + fr;
          if (t < 256) { const f32x4 q = *(const PG8_LAS f32x4*)(tab + t * 4); ssq[(size_t)(u.pm * BM + t) * SSW + u.pn] = (q[0] + q[1]) + (q[2] + q[3]); } }
    }
};
typedef EpiResidBT<false> EpiResidB; typedef EpiResidBT<true> EpiResidB8;
struct EpiMoeDown {
    static constexpr bool PERM = true, AFTER_DRAIN = false, WIDE = true;
    bf16_t* O; int ldc; const float* gate; float cin;
    __device__ __forceinline__ int pre_desc(const Unit& u, const char*& src) const { src = (const char*)(gate + (size_t)u.pm * BM); return 2; }
    __device__ __forceinline__ void operator()(const f32x4 (&acc)[2][2][4][2], const Unit& u, int wr, int wc, int fr, int fq, const PG8_LAS float* pre) const {
        const bool odd = (fr & 1) != 0;
        const int rowe = u.pm * BM + wr * 64 + (fr & ~1), colq = u.pn * BM + wc * 64 + 8 * fq + (odd ? 32 : 0);
#pragma unroll
        for (int ai = 0; ai < 2; ++ai)
#pragma unroll
            for (int m = 0; m < 4; ++m) { const float gt = pre[wr * 64 + fr + ai * HALF + m * 16] * cin; u32x4 w[2];
#pragma unroll
                for (int bj = 0; bj < 2; ++bj) { const f32x4 v0 = acc[ai][bj][m][0] * gt, v1 = acc[ai][bj][m][1] * gt;
                    w[bj].x = cvt_pk_bf16(v0[0], v0[1]); w[bj].y = cvt_pk_bf16(v0[2], v0[3]); w[bj].z = cvt_pk_bf16(v1[0], v1[1]); w[bj].w = cvt_pk_bf16(v1[2], v1[3]); }
                wide_store(O + (size_t)(rowe + ai * HALF + m * 16) * ldc + colq, ldc, odd, w[0], w[1]); }
    }
};
struct EpiMoeDownF8 {
    static constexpr bool PERM = true, AFTER_DRAIN = false, WIDE = true;
    unsigned char* O; int ldc; const float* gate; float cin;
    __device__ __forceinline__ int pre_desc(const Unit& u, const char*& src) const { src = (const char*)(gate + (size_t)u.pm * BM); return 2; }
    __device__ __forceinline__ void operator()(const f32x4 (&acc)[2][2][4][2], const Unit& u, int wr, int wc, int fr, int fq, const PG8_LAS float* pre) const {
        const bool odd = (fr & 1) != 0;
        const int rowe = u.pm * BM + wr * 64 + (fr & ~1), colq = u.pn * BM + wc * 64 + 8 * fq + (odd ? 32 : 0);
#pragma unroll
        for (int ai = 0; ai < 2; ++ai)
#pragma unroll
            for (int m = 0; m < 4; ++m) { const float gt = pre[wr * 64 + fr + ai * HALF + m * 16] * cin; unsigned lo[2], hi[2];
#pragma unroll
                for (int bj = 0; bj < 2; ++bj) { const f32x4 v0 = acc[ai][bj][m][0] * gt, v1 = acc[ai][bj][m][1] * gt;
                    lo[bj] = pk4_fp8(v0[0], v0[1], v0[2], v0[3]); hi[bj] = pk4_fp8(v1[0], v1[1], v1[2], v1[3]); }
                const unsigned sl = odd ? lo[0] : lo[1], sh = odd ? hi[0] : hi[1];
                const unsigned rl = (unsigned)__builtin_amdgcn_update_dpp(0, (int)sl, 0xB1, 0xF, 0xF, false), rh = (unsigned)__builtin_amdgcn_update_dpp(0, (int)sh, 0xB1, 0xF, 0xF, false);
                const unsigned long long pa = odd ? ((unsigned long long)rl | ((unsigned long long)rh << 32)) : ((unsigned long long)lo[0] | ((unsigned long long)hi[0] << 32));
                const unsigned long long pb = odd ? ((unsigned long long)lo[1] | ((unsigned long long)hi[1] << 32)) : ((unsigned long long)rl | ((unsigned long long)rh << 32));
                unsigned char* p = O + (size_t)(rowe + ai * HALF + m * 16) * ldc + colq;
                *(unsigned long long*)p = pa; *(unsigned long long*)(p + ldc) = pb; }
    }
};
struct EpiRope {
    static constexpr bool PERM = true, AFTER_DRAIN = false, WIDE = false;
    bf16_t* O; int ldc; const float* tab; int rope_pn0, seq;
    __device__ __forceinline__ void operator()(const f32x4 (&acc)[2][2][4][2], const Unit& u, int wr, int wc, int fr, int fq) const {
        const int row0 = u.pm * BM + wr * 64 + fr, col0 = u.pn * BM + wc * 32 + 8 * fq;
        if (u.pn < rope_pn0) {
#pragma unroll
            for (int ai = 0; ai < 2; ++ai)
#pragma unroll
                for (int m = 0; m < 4; ++m) { bf16_t* rowp = O + (size_t)(row0 + ai * HALF + m * 16) * ldc + col0;
#pragma unroll
                    for (int bj = 0; bj < 2; ++bj) { const f32x4 v0 = acc[ai][bj][m][0], v1 = acc[ai][bj][m][1];
                        u32x4 w; w.x = cvt_pk_bf16(v0[0], v0[1]); w.y = cvt_pk_bf16(v0[2], v0[3]); w.z = cvt_pk_bf16(v1[0], v1[1]); w.w = cvt_pk_bf16(v1[2], v1[3]);
                        *(u32x4*)(rowp + bj * HALF) = w; } }
        } else {
#pragma unroll
            for (int ai = 0; ai < 2; ++ai)
#pragma unroll
                for (int m = 0; m < 4; ++m) { const int row = row0 + ai * HALF + m * 16; bf16_t* rowp = O + (size_t)row * ldc + col0;
                    const float* t = tab + (size_t)(row % seq) * 32 + 8 * fq; const f32x4 c0 = *(const f32x4*)t, c1 = *(const f32x4*)(t + 4);
#pragma unroll
                    for (int bj = 0; bj < 2; ++bj) { const f32x4 v0 = acc[ai][bj][m][0], v1 = acc[ai][bj][m][1];
                        u32x4 w; w.x = cvt_pk_bf16(v0[0] * c0[0] - v0[1] * c0[1], v0[0] * c0[1] + v0[1] * c0[0]); w.y = cvt_pk_bf16(v0[2] * c0[2] - v0[3] * c0[3], v0[2] * c0[3] + v0[3] * c0[2]);
                        w.z = cvt_pk_bf16(v1[0] * c1[0] - v1[1] * c1[1], v1[0] * c1[1] + v1[1] * c1[0]); w.w = cvt_pk_bf16(v1[2] * c1[2] - v1[3] * c1[3], v1[2] * c1[3] + v1[3] * c1[2]);
                        *(u32x4*)(rowp + bj * HALF) = w; }
                    asm volatile("" ::: "memory"); }
        }
    }
};

typedef int v4i_t __attribute__((ext_vector_type(4)));
typedef int v8i_t __attribute__((ext_vector_type(8)));
template <bool FP8> __device__ __forceinline__ void mma_block(f32x4 (&acc)[4][2], const bf16x8 (&At)[4][2], const bf16x8 (&Bt)[2][2]) {
    __builtin_amdgcn_s_setprio(1);
#pragma unroll
    for (int m = 0; m < 4; ++m)
#pragma unroll
        for (int n = 0; n < 2; ++n) {
            if constexpr (FP8) {
                const v8i_t b = __builtin_shufflevector(__builtin_bit_cast(v4i_t, Bt[n][0]), __builtin_bit_cast(v4i_t, Bt[n][1]), 0, 1, 2, 3, 4, 5, 6, 7);
                const v8i_t a = __builtin_shufflevector(__builtin_bit_cast(v4i_t, At[m][0]), __builtin_bit_cast(v4i_t, At[m][1]), 0, 1, 2, 3, 4, 5, 6, 7);
                asm volatile("v_mfma_f32_16x16x128_f8f6f4 %0, %1, %2, %0" : "+v"(acc[m][n]) : "v"(b), "v"(a));
            } else {
#pragma unroll
                for (int k = 0; k < 2; ++k) acc[m][n] = __builtin_amdgcn_mfma_f32_16x16x32_bf16(Bt[n][k], At[m][k], acc[m][n], 0, 0, 0);
            }
        }
    __builtin_amdgcn_s_setprio(0);
}
typedef double f64x2_t __attribute__((ext_vector_type(2)));
__device__ __forceinline__ f32x4 zero4() { double a, b; asm volatile("v_mov_b64 %0, 0" : "=v"(a)); asm volatile("v_mov_b64 %0, 0" : "=v"(b)); const f64x2_t d = {a, b}; return __builtin_bit_cast(f32x4, d); }
template <class Epi, class Sched, bool ALIGN_EPI = false, bool SP2 = false, bool FP8 = false>
__device__ __forceinline__ void gemm_phase(PG8_LAS unsigned char* lds, const Gemm g, const Sched& S, const Epi& E) {
    const int tid = threadIdx.x, wid = __builtin_amdgcn_readfirstlane(tid >> 6), lane = tid & 63, wr = wid >> 2, wc = wid & 3, fr = lane & 15, fq = lane >> 4;
    const int K = g.K, nt = K / BK, lda = g.lda ? g.lda : K;
    unsigned voffA[2], voffB[2];
#pragma unroll
    for (int i = 0; i < 2; ++i) { int R, C; stage_rc(tid * 16 + i * 8192, R, C); const int Rb = Epi::PERM ? ((R & ~31) * (Epi::WIDE ? 2 : 1) + perm32(R & 31)) : R;
        voffA[i] = (unsigned)(R * lda + C) * 2u; voffB[i] = (unsigned)(Rb * K + C) * 2u; }
    const size_t kstep = (size_t)(BK * 2);
    const size_t hstep = (size_t)(Epi::WIDE ? 32 : HALF) * K * 2;
    const size_t tstep = (size_t)BM * K * 2;
    const size_t hstepA = (size_t)HALF * lda * 2, tstepA = 2 * hstepA;
    const unsigned ldsw = (unsigned)wid * 1024u;
    const int aoff = lds_byte(wr * 64 + fr, fq * 8), boff = lds_byte(wc * 32 + fr, fq * 8);
#define PG8_SA(b, h) (((b) * 2 + (h)) * HTB)
#define PG8_SB(b, h) ((4 + (b) * 2 + (h)) * HTB)
#define PG8_STAGE(bufoff, gbase, voff) do { _Pragma("unroll") for (int _i = 0; _i < 2; ++_i) \
        __builtin_amdgcn_global_load_lds((const unsigned*)((const char*)(gbase) + (voff)[_i]), (PG8_LAS unsigned*)(lds + (bufoff) + ldsw + _i * 8192), 16, 0, 0); } while (0)
#define PG8_LDA(dst, b, h) do { _Pragma("unroll") for (int m = 0; m < 4; ++m) _Pragma("unroll") for (int k = 0; k < 2; ++k) dst[m][k] = *(const PG8_LAS bf16x8*)(lds + PG8_SA(b, h) + aoff + m * 2048 + k * 1024); } while (0)
#define PG8_LDB(dst, b, h) do { _Pragma("unroll") for (int n = 0; n < 2; ++n) _Pragma("unroll") for (int k = 0; k < 2; ++k) dst[n][k] = *(const PG8_LAS bf16x8*)(lds + PG8_SB(b, h) + boff + n * 2048 + k * 1024); } while (0)
#define PG8_MMA(ai, bj, At, Bt) mma_block<FP8>(acc[ai][bj], At, Bt)
#define PG8_WAIT_V(n) asm volatile("s_waitcnt vmcnt(" #n ")" ::: "memory")
#define PG8_WAIT_L(n) asm volatile("s_waitcnt lgkmcnt(" #n ")" ::: "memory")
#define PG8_BAR __builtin_amdgcn_s_barrier()
#define PG8_SCHED __builtin_amdgcn_sched_barrier(0)
    Unit cur, nxt; int ui = 0;
    if (!S.next(0, cur)) return;
    f32x4 acc[2][2][4][2];
#pragma unroll
    for (int a = 0; a < 2; ++a)
#pragma unroll
        for (int b = 0; b < 2; ++b)
#pragma unroll
            for (int m = 0; m < 4; ++m)
#pragma unroll
                for (int n = 0; n < 2; ++n) acc[a][b][m][n] = zero4();
    bf16x8 At[4][2], B0[2][2], B1[2][2];
    const char* cA = (const char*)g.A + (size_t)cur.pm * tstepA; const char* cB = (const char*)g.Bt + (size_t)cur.e * g.estride + (size_t)cur.pn * tstep;
    S.a_ready(cur);
#define PG8_PRE(unit_, slot_) do { const char* src_; const int md_ = E.pre_desc(unit_, src_); \
        if (md_ == 1) { if (wid < 4) __builtin_amdgcn_global_load_lds((const unsigned*)(src_ + (size_t)(wid * 64 + lane) * 16), (PG8_LAS unsigned*)(lds + PRE_OFF + (slot_) * PRE_SLOT + wid * 1024), 16, 0, 0); } \
        else if (md_ == 2) { if (wid == 0) __builtin_amdgcn_global_load_lds((const unsigned*)(src_ + (size_t)lane * 16), (PG8_LAS unsigned*)(lds + PRE_OFF + (slot_) * PRE_SLOT), 16, 0, 0); } } while (0)
    PG8_PRE(cur, 0);
    if constexpr (SP2) {
        PG8_STAGE(PG8_SB(0, 0), cB, voffB); PG8_STAGE(PG8_SB(0, 1), cB + hstep, voffB); PG8_STAGE(PG8_SA(0, 0), cA, voffA); PG8_STAGE(PG8_SA(0, 1), cA + hstepA, voffA);
        PG8_STAGE(PG8_SB(1, 0), cB + kstep, voffB); PG8_STAGE(PG8_SA(1, 0), cA + kstep, voffA); PG8_STAGE(PG8_SB(1, 1), cB + hstep + kstep, voffB);
        if (wr == 1) PG8_BAR;
        PG8_WAIT_V(8); PG8_BAR;
        PG8_WAIT_V(6); PG8_BAR;
    } else {
        PG8_STAGE(PG8_SB(0, 0), cB, voffB); PG8_STAGE(PG8_SA(0, 0), cA, voffA); PG8_STAGE(PG8_SB(0, 1), cB + hstep, voffB); PG8_STAGE(PG8_SA(0, 1), cA + hstepA, voffA);
        if (wr == 1) PG8_BAR;
        PG8_WAIT_V(4); PG8_BAR;
        PG8_STAGE(PG8_SB(1, 0), cB + kstep, voffB); PG8_STAGE(PG8_SA(1, 0), cA + kstep, voffA); PG8_STAGE(PG8_SB(1, 1), cB + hstep + kstep, voffB);
        PG8_WAIT_V(6); PG8_BAR;
    }
    for (;;) {
        const bool has_next = S.next(ui + 1, nxt);
        const char* nA = has_next ? (const char*)g.A + (size_t)nxt.pm * tstepA : cA; const char* nB = has_next ? (const char*)g.Bt + (size_t)nxt.e * g.estride + (size_t)nxt.pn * tstep : cB;
#pragma nounroll
        for (int t = 0; t < nt; t += 2) {
            const bool last = (t == nt - 2);
            const char* a1 = cA + (size_t)(t + 1) * kstep;
            const char* a2 = last ? nA : cA + (size_t)(t + 2) * kstep; const char* b2 = last ? nB : cB + (size_t)(t + 2) * kstep;
            const char* a3 = a2 + kstep; const char* b3 = b2 + kstep;
            if (last && has_next) S.a_ready(nxt);
            if constexpr (SP2) {
            PG8_LDB(B0, 0, 0); PG8_LDB(B1, 0, 1); PG8_SCHED; PG8_LDA(At, 0, 0); PG8_STAGE(PG8_SA(1, 1), a1 + hstepA, voffA);
            PG8_WAIT_V(8); PG8_WAIT_L(0); PG8_BAR; PG8_MMA(0, 0, At, B0); PG8_MMA(0, 1, At, B1); PG8_BAR; PG8_SCHED;
            PG8_LDA(At, 0, 1); PG8_STAGE(PG8_SB(0, 0), b2, voffB); PG8_STAGE(PG8_SB(0, 1), b2 + hstep, voffB); PG8_STAGE(PG8_SA(0, 0), a2, voffA);
            PG8_WAIT_V(8); PG8_WAIT_L(0); PG8_BAR; PG8_MMA(1, 0, At, B0); PG8_MMA(1, 1, At, B1); PG8_BAR; PG8_SCHED;
            PG8_LDB(B0, 1, 0); PG8_LDB(B1, 1, 1); PG8_SCHED; PG8_LDA(At, 1, 0); PG8_STAGE(PG8_SA(0, 1), a2 + hstepA, voffA);
            PG8_WAIT_V(8); PG8_WAIT_L(0); PG8_BAR; PG8_MMA(0, 0, At, B0); PG8_MMA(0, 1, At, B1); PG8_BAR; PG8_SCHED;
            PG8_LDA(At, 1, 1); PG8_STAGE(PG8_SB(1, 0), b3, voffB); PG8_STAGE(PG8_SB(1, 1), b3 + hstep, voffB); PG8_STAGE(PG8_SA(1, 0), a3, voffA);
            PG8_WAIT_V(8); PG8_WAIT_L(0); PG8_BAR; PG8_MMA(1, 0, At, B0); PG8_MMA(1, 1, At, B1); PG8_BAR; PG8_SCHED;
            } else {
            PG8_LDB(B0, 0, 0); PG8_SCHED; PG8_LDA(At, 0, 0); PG8_STAGE(PG8_SA(1, 1), a1 + hstepA, voffA);
            PG8_WAIT_L(8); PG8_BAR; PG8_WAIT_L(0); PG8_MMA(0, 0, At, B0); PG8_BAR; PG8_SCHED;
            PG8_LDB(B1, 0, 1); PG8_STAGE(PG8_SB(0, 0), b2, voffB);
            PG8_BAR; PG8_WAIT_L(0); PG8_MMA(0, 1, At, B1); PG8_BAR;
            PG8_LDA(At, 0, 1); PG8_STAGE(PG8_SA(0, 0), a2, voffA);
            PG8_BAR; PG8_WAIT_L(0); PG8_MMA(1, 0, At, B0); PG8_BAR; PG8_SCHED;
            PG8_STAGE(PG8_SB(0, 1), b2 + hstep, voffB);
            PG8_WAIT_V(6); PG8_BAR; PG8_MMA(1, 1, At, B1); PG8_BAR;
            PG8_LDB(B0, 1, 0); PG8_SCHED; PG8_LDA(At, 1, 0); PG8_STAGE(PG8_SA(0, 1), a2 + hstepA, voffA);
            PG8_WAIT_L(8); PG8_BAR; PG8_WAIT_L(0); PG8_MMA(0, 0, At, B0); PG8_BAR; PG8_SCHED;
            PG8_LDB(B1, 1, 1); PG8_STAGE(PG8_SB(1, 0), b3, voffB);
            PG8_BAR; PG8_WAIT_L(0); PG8_MMA(0, 1, At, B1); PG8_BAR;
            PG8_LDA(At, 1, 1); PG8_STAGE(PG8_SA(1, 0), a3, voffA);
            PG8_BAR; PG8_WAIT_L(0); PG8_MMA(1, 0, At, B0); PG8_BAR; PG8_SCHED;
            PG8_STAGE(PG8_SB(1, 1), b3 + hstep, voffB);
            PG8_WAIT_V(6); PG8_BAR; PG8_MMA(1, 1, At, B1); PG8_BAR;
            }
        }
        if constexpr (ALIGN_EPI) { if (wr == 0) PG8_BAR; }
        if constexpr (FP8) {
#pragma unroll
            for (int a = 0; a < 2; ++a)
#pragma unroll
                for (int b = 0; b < 2; ++b) asm volatile("s_nop 15\n\ts_nop 15" : "+v"(acc[a][b][0][0]), "+v"(acc[a][b][0][1]), "+v"(acc[a][b][1][0]), "+v"(acc[a][b][1][1]), "+v"(acc[a][b][2][0]), "+v"(acc[a][b][2][1]), "+v"(acc[a][b][3][0]), "+v"(acc[a][b][3][1]));
        }
        if constexpr (!Epi::AFTER_DRAIN) { if (has_next) PG8_PRE(nxt, (ui + 1) & 1);
            E(acc, cur, wr, wc, fr, fq, (const PG8_LAS float*)(lds + PRE_OFF + (ui & 1) * PRE_SLOT)); S.done(cur); }
        if (!has_next) break;
#pragma unroll
        for (int a = 0; a < 2; ++a)
#pragma unroll
            for (int b = 0; b < 2; ++b)
#pragma unroll
                for (int m = 0; m < 4; ++m)
#pragma unroll
                    for (int n = 0; n < 2; ++n) acc[a][b][m][n] = zero4();
        cur = nxt; cA = nA; cB = nB; ++ui;
        if constexpr (ALIGN_EPI) { if (wr == 1) PG8_BAR; }
    }
    PG8_WAIT_V(0);
    if constexpr (!ALIGN_EPI) { if (wr == 0) PG8_BAR; }
    PG8_BAR;
    if constexpr (Epi::AFTER_DRAIN) { E.fused(acc, cur, wr, wc, fr, fq, lds, wid, lane); S.done(cur); }
#undef PG8_PRE
#undef PG8_SA
#undef PG8_SB
#undef PG8_STAGE
#undef PG8_LDA
#undef PG8_LDB
#undef PG8_MMA
#undef PG8_WAIT_V
#undef PG8_WAIT_L
#undef PG8_BAR
#undef PG8_SCHED
}
}
#ifndef PG8_SP2
#define PG8_SP2 true
#endif
#ifndef PG8_ALIGN
#define PG8_ALIGN true
#endif

constexpr int NWAVES = 8;
constexpr int BATCH = 8, SEQ = 4096, DM = 1024, NTOK = BATCH * SEQ;
constexpr int FFD = 2816, FFE = 3584, NEXP = 8;
constexpr int NSLOT = (NTOK * 2 / 256 + NEXP) * 256;
constexpr float NORM_EPS = 1e-6f, SUBLN_EPS = 1e-5f, LOG2E = 1.4426950408889634f;
constexpr int N_IN = 41;
enum { I_X = 0, I_A_NORM, I_A_WQKV, I_A_WO, I_F0_NORM, I_F0_WG, I_F0_WU, I_F0_WD, I_B_NORM, I_B_WQKV, I_B_LQ1, I_B_LK1, I_B_LQ2, I_B_LK2, I_B_SUBLN, I_B_WO,
       I_M1_NORM, I_M1_WR, I_M1_WG, I_M1_WU, I_M1_WD, I_C_NORM, I_C_WIN, I_C_QNORM, I_C_WQUP, I_C_KVNORM, I_C_WKVUP, I_C_WO, I_F2_NORM, I_F2_WG, I_F2_WU, I_F2_WD,
       I_D_NORM, I_D_WQKV, I_D_WO, I_M3_NORM, I_M3_WR, I_M3_WG, I_M3_WU, I_M3_WD, I_FINAL_NORM };

constexpr size_t MiB = 1ull << 20, KiB = 1024;
constexpr size_t WS_CTL = 0, CTL_ZERO_BYTES = 64 * KiB;
constexpr size_t WS_ROPE = 1 * MiB;
constexpr size_t WS_WGCNT = 1 * MiB + 512 * KiB;
constexpr size_t WS_KN = 1 * MiB + 576 * KiB;
constexpr size_t WS_TOKE = 2 * MiB, WS_TOKG = WS_TOKE + 256 * KiB, WS_TOKS = WS_TOKG + 256 * KiB;
constexpr size_t WS_SGATE = 3 * MiB;
constexpr size_t WS_W = 4 * MiB;
constexpr size_t W_QKV_A = WS_W, W_O_A = WS_W + 9 * MiB, W_GU0 = WS_W + 10 * MiB, W_D0 = WS_W + 21 * MiB, W_QKV_B = WS_W + 27 * MiB, W_O_B = WS_W + 33 * MiB,
                 W_IN_C = WS_W + 35 * MiB, W_QUP_C = WS_W + 37 * MiB, W_KVUP_C = WS_W + 39 * MiB, W_O_C = WS_W + 40 * MiB, W_GU2 = WS_W + 42 * MiB, W_D2 = WS_W + 53 * MiB,
                 W_QKV_D = WS_W + 59 * MiB, W_O_D = WS_W + 65 * MiB;
constexpr size_t W_MOE_GU = 72 * MiB, W_MOE_D = 128 * MiB, W_MOE_L2 = 84 * MiB;
constexpr size_t WS_H = 240 * MiB;
constexpr size_t WS_XB = 304 * MiB;
constexpr size_t WS_BIG = 436 * MiB;
constexpr size_t WS_END = 898 * MiB;
constexpr size_t WS_XR = WS_BIG + 288 * MiB;
constexpr size_t WS_SS = WS_END, SS_BYTES = 16 * MiB;
constexpr size_t WS_SSS = WS_END + 16 * MiB;
constexpr size_t WS_GWR = 1 * MiB + 640 * KiB;
static_assert(WS_BIG + (size_t)NSLOT * FFE * 2 <= WS_END && WS_XB + (size_t)NSLOT * DM * 2 <= WS_BIG && WS_H + (size_t)NTOK * DM * 2 <= WS_XB && W_MOE_D + W_MOE_L2 + 8ull * 1024 * 3584 <= WS_H, "d_ws map");
constexpr size_t C_LAT = WS_BIG, C_Q = WS_BIG + 48 * MiB, C_KV = WS_BIG + 144 * MiB;
constexpr size_t C_QN = WS_XB, C_KVN = WS_XB + 24 * MiB, C_KPE = WS_XB + 40 * MiB;
constexpr int CW_TMO = 0, CW_QB = 64, CW_BAR = 4096;

constexpr int RING_OFF = 0, RING_BYTES = 131072;
constexpr int MISC_OFF = RING_BYTES + 320;
constexpr int RESTAB_OFF = RING_BYTES + 1024;
constexpr int LDS_BYTES = 149504;
static_assert(RESTAB_OFF + 8192 <= pg8::PRE_OFF && pg8::PRE_OFF + 2 * pg8::PRE_SLOT <= LDS_BYTES, "LDS map");
#define GAS __attribute__((address_space(1)))
#define LAS __attribute__((address_space(3)))
typedef unsigned short bf16;
typedef unsigned v4u __attribute__((ext_vector_type(4)));
typedef float f32x4 __attribute__((ext_vector_type(4)));
typedef short bf16x8 __attribute__((ext_vector_type(8)));
typedef GAS unsigned gu32;
typedef GAS unsigned long long gu64;
#define RLX_AGENT __ATOMIC_RELAXED, __HIP_MEMORY_SCOPE_AGENT
#define LDS_WAIT() asm volatile("s_waitcnt lgkmcnt(0)" ::: "memory")
#define VM_WAIT() asm volatile("s_waitcnt vmcnt(0)" ::: "memory")
__device__ __forceinline__ unsigned long long rt() { return __builtin_amdgcn_s_memrealtime(); }
__device__ __forceinline__ unsigned f2bf(float f) { unsigned u = __builtin_bit_cast(unsigned, f); return (u + 0x7fffu + ((u >> 16) & 1u)) >> 16; }
__device__ __forceinline__ unsigned pk2(float lo, float hi) { return f2bf(lo) | (f2bf(hi) << 16); }

#define XB_TMO      128
#define XB_XCNT(j)  (256  + 64 * (j))
#define XB_XSUB(j)  (1280 + 64 * (j))
#define XB_XGEN(j)  (2304 + 64 * (j))
#define XB_TOP      3328
#define XB_TOPGEN   3392
#define XCD_BAR_WORDS 3456
#define XB_SPIN_CAP (1u << 18)

__device__ __forceinline__ unsigned xb_ld(unsigned* p)              { return __hip_atomic_load(p, __ATOMIC_RELAXED, __HIP_MEMORY_SCOPE_AGENT); }
__device__ __forceinline__ unsigned xb_add(unsigned* p, unsigned v) { return __hip_atomic_fetch_add(p, v, __ATOMIC_RELAXED, __HIP_MEMORY_SCOPE_AGENT); }
__device__ __forceinline__ unsigned xb_xcc_id() { return (unsigned)__builtin_amdgcn_s_getreg((3 << 11) | 20) & 0xFu; }
#define XB_SPIN(cond, bar) do { unsigned _sp = 0; while (cond) { __builtin_amdgcn_s_sleep(1); \
    if ((++_sp & 255u) == 0u) { if (xb_ld(&(bar)[XB_TMO])) break; if (_sp > XB_SPIN_CAP) { atomicAdd(&(bar)[XB_TMO], 1u); break; } } } } while (0)

struct XcdBarrier {
    unsigned* bar; unsigned x;
    volatile LAS unsigned* st;
};

__device__ __forceinline__ XcdBarrier xcd_barrier_post(unsigned* bar, volatile LAS unsigned* st) {
    XcdBarrier b; b.bar = bar; b.x = xb_xcc_id(); b.st = st;
    if (threadIdx.x == 0) (void)xb_add(&bar[XB_XCNT(b.x)], 1u);
    return b;
}
__device__ __forceinline__ void xcd_barrier_complete(unsigned* bar, unsigned x, unsigned& nloc, unsigned& nx) {
    const unsigned G = gridDim.x * gridDim.y * gridDim.z;
    unsigned sum, cnt, mine, sp = 0u;
    for (;;) {
        sum = 0u; cnt = 0u; mine = 0u;
#pragma unroll
        for (unsigned j = 0; j < 16; ++j) { const unsigned c = xb_ld(&bar[XB_XCNT(j)]); sum += c; cnt += (c > 0u) ? 1u : 0u; mine = (j == x) ? c : mine; }
        if (sum == G) break;
        __builtin_amdgcn_s_sleep(1);
        if ((++sp & 255u) == 0u) { if (xb_ld(&bar[XB_TMO])) break; if (sp > XB_SPIN_CAP) { atomicAdd(&bar[XB_TMO], 1u); break; } }
    }
    nloc = mine > 0u ? mine : 1u; nx = cnt > 0u ? cnt : 1u;
}

__device__ __forceinline__ void xcd_barrier(const XcdBarrier& b) {
    asm volatile("s_waitcnt vmcnt(0)" ::: "memory");
    __syncthreads();
    if (threadIdx.x == 0) {
        unsigned* bar = b.bar;
        __builtin_amdgcn_s_waitcnt(0);
        unsigned nloc = b.st[0], nx = b.st[1];
        if (nloc == 0u) { xcd_barrier_complete(bar, b.x, nloc, nx); b.st[0] = nloc; b.st[1] = nx; }
        const unsigned old = xb_add(&bar[XB_XSUB(b.x)], 1u);
        const unsigned gen = old / nloc;
        if (old + 1u == (gen + 1u) * nloc) {
            __builtin_amdgcn_fence(__ATOMIC_RELEASE, "agent");
            asm volatile("s_waitcnt vmcnt(0)" ::: "memory");
            const unsigned og = xb_add(&bar[XB_TOP], 1u);
            const unsigned tg = og / nx;
            if (og + 1u == (tg + 1u) * nx) xb_add(&bar[XB_TOPGEN], 1u);
            else XB_SPIN(xb_ld(&bar[XB_TOPGEN]) == tg, bar);
            __builtin_amdgcn_fence(__ATOMIC_ACQUIRE, "agent");
            xb_add(&bar[XB_XGEN(b.x)], 1u);
            asm volatile("s_waitcnt vmcnt(0)" ::: "memory");
        } else {
            XB_SPIN(xb_ld(&bar[XB_XGEN(b.x)]) == gen, bar);
            __builtin_amdgcn_fence(__ATOMIC_ACQUIRE, "agent");
            asm volatile("s_waitcnt vmcnt(0)" ::: "memory");
        }
    }
    __syncthreads();
}

__device__ __forceinline__ float wave_sum(float v) {
#pragma unroll
    for (int o = 1; o < 64; o <<= 1) v += __shfl_xor(v, o);
    return v;
}
__device__ __forceinline__ float bf_lo(unsigned w) { return __builtin_bit_cast(float, w << 16); }
__device__ __forceinline__ float bf_hi(unsigned w) { return __builtin_bit_cast(float, w & 0xffff0000u); }
__device__ __forceinline__ void ld8(const bf16* p, float* f) {
    const v4u w = *(const GAS v4u*)p;
    f[0] = bf_lo(w.x); f[1] = bf_hi(w.x); f[2] = bf_lo(w.y); f[3] = bf_hi(w.y); f[4] = bf_lo(w.z); f[5] = bf_hi(w.z); f[6] = bf_lo(w.w); f[7] = bf_hi(w.w);
}
__device__ __forceinline__ float ex2(float x) { return __builtin_amdgcn_exp2f(x); }

struct Frame {
    LAS unsigned char* lds;
    volatile LAS unsigned* MISC;
    gu32* ctl;
    int tid, lane, wave, G, bid;
    const float* const* in;
};

enum { MAP_ID = 0, MAP_GATE, MAP_UP, MAP_CIN, MAP_CQUP, MAP_CKVUP };
__device__ __forceinline__ int map_row(int map, int n) {
    if (map == MAP_GATE) return ((n >> 7) << 8) + (n & 127);
    if (map == MAP_UP) return ((n >> 7) << 8) + 128 + (n & 127);
    if (map == MAP_CIN) { if (n < 640) return n; const int i = n - 640; return 640 + ((i & 15) << 1) + (i >> 4); }
    if (map == MAP_CQUP) { const int h = n / 96, j = n - 96 * h; if (j < 64) return 64 * h + j; const int i = j - 64; return 1024 + 32 * h + ((i & 15) << 1) + (i >> 4); }
    if (map == MAP_CKVUP) { const int h = n >> 7, j = n & 127; return j < 64 ? 64 * h + j : 1024 + 64 * h + (j - 64); }
    return n;
}
__device__ __forceinline__ void conv_item(const float* W, int K, int N, bf16* WT, int map, int nscale, float scale, const float* gain, LAS float* scr, int item, int lane) {
    const int nblk = N / 32, kb = item / nblk, nb = item - kb * nblk, k0 = 64 * kb, n0 = 32 * nb;
#pragma unroll
    for (int i = 0; i < 8; ++i) { const int kk = 8 * i + (lane >> 3); const f32x4 w = *(const GAS f32x4*)(W + (size_t)(k0 + kk) * N + n0 + 4 * (lane & 7));
        const float gk = gain ? gain[k0 + kk] : 1.0f;
        LAS float* dd = scr + kk * 33 + 4 * (lane & 7); dd[0] = w.x * gk; dd[1] = w.y * gk; dd[2] = w.z * gk; dd[3] = w.w * gk; }
    LDS_WAIT(); asm volatile("" ::: "memory");
    const int c = lane & 7;
#pragma unroll
    for (int j = 0; j < 4; ++j) { const int n = (lane >> 3) + 8 * j; const LAS float* s = scr + (8 * c) * 33 + n; const int nn = n0 + n; const float sc = nn < nscale ? scale : 1.0f;
        v4u o; o.x = pk2(s[0 * 33] * sc, s[1 * 33] * sc); o.y = pk2(s[2 * 33] * sc, s[3 * 33] * sc); o.z = pk2(s[4 * 33] * sc, s[5 * 33] * sc); o.w = pk2(s[6 * 33] * sc, s[7 * 33] * sc);
        *(GAS v4u*)(WT + (size_t)map_row(map, nn) * K + k0 + 8 * c) = o; }
    LDS_WAIT(); asm volatile("" ::: "memory");
}
__device__ __forceinline__ void conv_matrix(const float* W, int K, int N, bf16* WT, int map, int nscale, float scale, const float* gain, LAS float* scr, int gw, int NGW, int& base, int lane) {
    const int nit = (K / 64) * (N / 32);
    int first = gw - base; if (first < 0) first += NGW;
    for (int it = first; it < nit; it += NGW) conv_item(W, K, N, WT, map, nscale, scale, gain, scr, it, lane);
    base = (base + nit) % NGW;
}
__device__ __forceinline__ void conv_item_f8(const float* W, int K, int N, unsigned char* WT, int map, float scale, const float* gain, LAS float* scr, int item, int lane) {
    const int nblk = N / 32, kb = item / nblk, nb = item - kb * nblk, k0 = 64 * kb, n0 = 32 * nb;
#pragma unroll
    for (int i = 0; i < 8; ++i) { const int kk = 8 * i + (lane >> 3); const f32x4 w = *(const GAS f32x4*)(W + (size_t)(k0 + kk) * N + n0 + 4 * (lane & 7));
        const float gk = gain ? gain[k0 + kk] : 1.0f;
        LAS float* dd = scr + kk * 33 + 4 * (lane & 7); dd[0] = w.x * gk; dd[1] = w.y * gk; dd[2] = w.z * gk; dd[3] = w.w * gk; }
    LDS_WAIT(); asm volatile("" ::: "memory");
    const int c = lane & 3;
#pragma unroll
    for (int j = 0; j < 2; ++j) { const int n = (lane >> 2) + 16 * j; const LAS float* s = scr + (16 * c) * 33 + n;
        v4u o; o.x = pg8::pk4_fp8(s[0 * 33] * scale, s[1 * 33] * scale, s[2 * 33] * scale, s[3 * 33] * scale); o.y = pg8::pk4_fp8(s[4 * 33] * scale, s[5 * 33] * scale, s[6 * 33] * scale, s[7 * 33] * scale);
        o.z = pg8::pk4_fp8(s[8 * 33] * scale, s[9 * 33] * scale, s[10 * 33] * scale, s[11 * 33] * scale); o.w = pg8::pk4_fp8(s[12 * 33] * scale, s[13 * 33] * scale, s[14 * 33] * scale, s[15 * 33] * scale);
        *(GAS v4u*)(WT + (size_t)map_row(map, n0 + n) * K + k0 + 16 * c) = o; }
    LDS_WAIT(); asm volatile("" ::: "memory");
}
__device__ __forceinline__ void conv_item_f8q(const float* W, int K, int N, unsigned char* WT, int map, float scale, int nscale, float qscale, const float* gain, LAS float* scr, int item, int lane) {
    const int nblk = N / 32, kb = item / nblk, nb = item - kb * nblk, k0 = 64 * kb, n0 = 32 * nb;
#pragma unroll
    for (int i = 0; i < 8; ++i) { const int kk = 8 * i + (lane >> 3); const f32x4 w = *(const GAS f32x4*)(W + (size_t)(k0 + kk) * N + n0 + 4 * (lane & 7));
        const float gk = (gain ? gain[k0 + kk] : 1.0f) * scale * ((n0 < nscale) ? qscale : 1.0f);
        LAS float* dd = scr + kk * 33 + 4 * (lane & 7); dd[0] = w.x * gk; dd[1] = w.y * gk; dd[2] = w.z * gk; dd[3] = w.w * gk; }
    LDS_WAIT(); asm volatile("" ::: "memory");
    const int c = lane & 3;
#pragma unroll
    for (int j = 0; j < 2; ++j) { const int n = (lane >> 2) + 16 * j; const LAS float* s = scr + (16 * c) * 33 + n;
        v4u o; o.x = pg8::pk4_fp8(s[0 * 33], s[1 * 33], s[2 * 33], s[3 * 33]); o.y = pg8::pk4_fp8(s[4 * 33], s[5 * 33], s[6 * 33], s[7 * 33]);
        o.z = pg8::pk4_fp8(s[8 * 33], s[9 * 33], s[10 * 33], s[11 * 33]); o.w = pg8::pk4_fp8(s[12 * 33], s[13 * 33], s[14 * 33], s[15 * 33]);
        *(GAS v4u*)(WT + (size_t)map_row(map, n0 + n) * K + k0 + 16 * c) = o; }
    LDS_WAIT(); asm volatile("" ::: "memory");
}
__device__ __forceinline__ void conv_matrix_f8q(const float* W, int K, int N, unsigned char* WT, int map, float scale, int nscale, float qscale, const float* gain, LAS float* scr, int gw, int NGW, int& base, int lane) {
    const int nit = (K / 64) * (N / 32);
    int first = gw - base; if (first < 0) first += NGW;
    for (int it = first; it < nit; it += NGW) conv_item_f8q(W, K, N, WT, map, scale, nscale, qscale, gain, scr, it, lane);
    base = (base + nit) % NGW;
}
__device__ __forceinline__ void conv_matrix_f8(const float* W, int K, int N, unsigned char* WT, int map, float scale, const float* gain, LAS float* scr, int gw, int NGW, int& base, int lane) {
    const int nit = (K / 64) * (N / 32);
    int first = gw - base; if (first < 0) first += NGW;
    for (int it = first; it < nit; it += NGW) conv_item_f8(W, K, N, WT, map, scale, gain, scr, it, lane);
    base = (base + nit) % NGW;
}
constexpr float F8_SA = 16.0f, F8_SW1 = 512.0f, F8_SACT = 8.0f, F8_SW2 = 1024.0f;
__device__ __forceinline__ void conv_moe(const float* Wg, const float* Wu, const float* Wd, const float* gain, unsigned char* wgu, unsigned char* wd, LAS float* scr, int gw, int NGW, int lane, int e_lo = 0, int e_hi = NEXP) {
    int base = 0;
    for (int e = e_lo; e < e_hi; ++e) {
        unsigned char* gu = wgu + (size_t)e * 2 * FFE * DM;
        conv_matrix_f8(Wg + (size_t)e * DM * FFE, DM, FFE, gu, MAP_GATE, F8_SW1, gain, scr, gw, NGW, base, lane);
        conv_matrix_f8(Wu + (size_t)e * DM * FFE, DM, FFE, gu, MAP_UP, F8_SW1, gain, scr, gw, NGW, base, lane);
        conv_matrix_f8(Wd + (size_t)e * FFE * DM, FFE, DM, wd + (size_t)e * DM * FFE, MAP_ID, F8_SW2, nullptr, scr, gw, NGW, base, lane);
    }
}

constexpr float F8_SY = 32.0f;
__device__ __forceinline__ void rowy8_load(const unsigned char* yrow, int lane, float (&v)[16]) {
    typedef unsigned u32x2_ __attribute__((ext_vector_type(2))); typedef float f32x2_ __attribute__((ext_vector_type(2)));
    const u32x2_ a = *(const GAS u32x2_*)(yrow + 8 * lane), b = *(const GAS u32x2_*)(yrow + 512 + 8 * lane);
    const unsigned w[4] = {a.x, a.y, b.x, b.y};
#pragma unroll
    for (int q = 0; q < 4; ++q) { const f32x2_ lo = __builtin_amdgcn_cvt_pk_f32_fp8((int)w[q], false), hi = __builtin_amdgcn_cvt_pk_f32_fp8((int)w[q], true);
        v[4 * q] = lo[0] * (1.0f / F8_SY); v[4 * q + 1] = lo[1] * (1.0f / F8_SY); v[4 * q + 2] = hi[0] * (1.0f / F8_SY); v[4 * q + 3] = hi[1] * (1.0f / F8_SY); }
}
__device__ __forceinline__ void rowb_load(const bf16* xrow, int lane, float (&v)[16]) { ld8(xrow + 8 * lane, v); ld8(xrow + 512 + 8 * lane, v + 8); }
__device__ __forceinline__ void rowb_add(const bf16* yrow, int lane, float (&v)[16]) { float t[16]; ld8(yrow + 8 * lane, t); ld8(yrow + 512 + 8 * lane, t + 8);
#pragma unroll
    for (int i = 0; i < 16; ++i) v[i] += t[i]; }
__device__ __forceinline__ float rowb_store_ss(bf16* xrow, int lane, const float (&v)[16]) {
    unsigned w[8]; float s = 0.f;
#pragma unroll
    for (int i = 0; i < 8; ++i) { w[i] = pk2(v[2 * i], v[2 * i + 1]); const float a = bf_lo(w[i]), b = bf_hi(w[i]); s += a * a + b * b; }
    v4u o0 = {w[0], w[1], w[2], w[3]}, o1 = {w[4], w[5], w[6], w[7]};
    *(GAS v4u*)(xrow + 8 * lane) = o0; *(GAS v4u*)(xrow + 512 + 8 * lane) = o1;
    return wave_sum(s);
}
__device__ __forceinline__ void rowb_store_f8(unsigned char* xrow8, int lane, const float (&v)[16]) {
    typedef unsigned u32x2_ __attribute__((ext_vector_type(2))); u32x2_ q0, q1;
    q0.x = pg8::pk4_fp8(v[0] * F8_SA, v[1] * F8_SA, v[2] * F8_SA, v[3] * F8_SA); q0.y = pg8::pk4_fp8(v[4] * F8_SA, v[5] * F8_SA, v[6] * F8_SA, v[7] * F8_SA);
    q1.x = pg8::pk4_fp8(v[8] * F8_SA, v[9] * F8_SA, v[10] * F8_SA, v[11] * F8_SA); q1.y = pg8::pk4_fp8(v[12] * F8_SA, v[13] * F8_SA, v[14] * F8_SA, v[15] * F8_SA);
    *(GAS u32x2_*)(xrow8 + 8 * lane) = q0; *(GAS u32x2_*)(xrow8 + 512 + 8 * lane) = q1; }
__device__ __forceinline__ float ss_total(const float* ss, int row) { const f32x4 a = *(const GAS f32x4*)(ss + (size_t)row * pg8::SSW); return (a[0] + a[1]) + (a[2] + a[3]); }
__device__ __forceinline__ void ss_store(float* ss, int row, float s, int lane) { if (lane == 0) *(GAS f32x4*)(ss + (size_t)row * pg8::SSW) = (f32x4){s, 0.f, 0.f, 0.f}; }
template <int MODE>
__device__ __forceinline__ void row_phase(Frame& F, const float* xin, bf16* XR, float* ss, const float* g, float* out, const bf16* Y, const int* toks,
                                          const float* gWr, int* toke, float* tokg, int* wgcnt, unsigned char* x8 = nullptr) {
    const int RPW = (NTOK + F.G - 1) / F.G; const int r0 = F.bid * RPW, r1 = (r0 + RPW < NTOK) ? r0 + RPW : NTOK;
    LAS int* cnt = (LAS int*)(F.lds + RING_OFF);
    if (MODE == 1) { if (F.tid < 8) cnt[F.tid] = 0; __syncthreads(); }
    f32x4 wr[16][2];
    if (MODE == 1) {
#pragma unroll
        for (int i = 0; i < 16; ++i) { const int k = (i < 8) ? 8 * F.lane + i : 512 + 8 * F.lane + (i - 8); wr[i][0] = *(const GAS f32x4*)(gWr + (size_t)k * 8); wr[i][1] = *(const GAS f32x4*)(gWr + (size_t)k * 8 + 4); } }
    if (MODE == 0) {
        for (int rA = r0 + F.wave; rA < r1; rA += 2 * NWAVES) {
            const bool hasB = rA + NWAVES < r1; const int rB = hasB ? rA + NWAVES : rA;
            const GAS f32x4* xa = (const GAS f32x4*)(xin + (size_t)rA * DM); const GAS f32x4* xb = (const GAS f32x4*)(xin + (size_t)rB * DM);
            const f32x4 a0 = xa[2 * F.lane], a1 = xa[2 * F.lane + 1], a2 = xa[128 + 2 * F.lane], a3 = xa[128 + 2 * F.lane + 1];
            const f32x4 c0 = xb[2 * F.lane], c1 = xb[2 * F.lane + 1], c2 = xb[128 + 2 * F.lane], c3 = xb[128 + 2 * F.lane + 1];
            { float v[16] = {a0.x, a0.y, a0.z, a0.w, a1.x, a1.y, a1.z, a1.w, a2.x, a2.y, a2.z, a2.w, a3.x, a3.y, a3.z, a3.w};
              const float s = rowb_store_ss(XR + (size_t)rA * DM, F.lane, v); ss_store(ss, rA, s, F.lane); if (x8) rowb_store_f8(x8 + (size_t)rA * DM, F.lane, v); }
            if (hasB) { float v[16] = {c0.x, c0.y, c0.z, c0.w, c1.x, c1.y, c1.z, c1.w, c2.x, c2.y, c2.z, c2.w, c3.x, c3.y, c3.z, c3.w};
              const float s = rowb_store_ss(XR + (size_t)rB * DM, F.lane, v); ss_store(ss, rB, s, F.lane); if (x8) rowb_store_f8(x8 + (size_t)rB * DM, F.lane, v); } }
    } else {
        for (int rA = r0 + F.wave; rA < r1; rA += 2 * NWAVES) {
            const bool hasB = rA + NWAVES < r1; const int rB = hasB ? rA + NWAVES : rA;
            float vA[16], vB[16]; int sA0 = 0, sA1 = 0, sB0 = 0, sB1 = 0; float tA = 0.f, tB = 0.f;
            if (MODE == 2 || MODE == 3) { sA0 = toks[2 * rA]; sA1 = toks[2 * rA + 1]; sB0 = toks[2 * rB]; sB1 = toks[2 * rB + 1]; }
            rowb_load(XR + (size_t)rA * DM, F.lane, vA); rowb_load(XR + (size_t)rB * DM, F.lane, vB);
            if (MODE == 1) { tA = ss_total(ss, rA); tB = ss_total(ss, rB); }
            if (MODE == 2 || MODE == 3) { float yA0[16], yA1[16], yB0[16], yB1[16];
                if (MOE_Y8) { const unsigned char* Y8 = (const unsigned char*)Y; rowy8_load(Y8 + (size_t)sA0 * DM, F.lane, yA0); rowy8_load(Y8 + (size_t)sA1 * DM, F.lane, yA1); rowy8_load(Y8 + (size_t)sB0 * DM, F.lane, yB0); rowy8_load(Y8 + (size_t)sB1 * DM, F.lane, yB1); }
                else { rowb_load(Y + (size_t)sA0 * DM, F.lane, yA0); rowb_load(Y + (size_t)sA1 * DM, F.lane, yA1); rowb_load(Y + (size_t)sB0 * DM, F.lane, yB0); rowb_load(Y + (size_t)sB1 * DM, F.lane, yB1); }
#pragma unroll
                for (int i = 0; i < 16; ++i) { vA[i] = (vA[i] + yA0[i]) + yA1[i]; vB[i] = (vB[i] + yB0[i]) + yB1[i]; } }
#pragma unroll
            for (int half = 0; half < 2; ++half) {
                if (half == 1 && !hasB) break;
                const int r = half ? rB : rA; float (&v)[16] = half ? vB : vA;
                if (MODE == 2) { const float s = rowb_store_ss(XR + (size_t)r * DM, F.lane, v); ss_store(ss, r, s, F.lane); }
                if (MODE == 3) { float s = 0.f;
#pragma unroll
                    for (int i = 0; i < 16; ++i) s += v[i] * v[i];
                    const float rstd = 1.0f / sqrtf(wave_sum(s) * (1.0f / DM) + NORM_EPS);
                    const GAS f32x4* gr = (const GAS f32x4*)g; const f32x4 g0 = gr[2 * F.lane], g1 = gr[2 * F.lane + 1], g2 = gr[128 + 2 * F.lane], g3 = gr[128 + 2 * F.lane + 1];
                    GAS f32x4* orow = (GAS f32x4*)(out + (size_t)r * DM);
                    orow[2 * F.lane] = (f32x4){v[0], v[1], v[2], v[3]} * rstd * g0; orow[2 * F.lane + 1] = (f32x4){v[4], v[5], v[6], v[7]} * rstd * g1;
                    orow[128 + 2 * F.lane] = (f32x4){v[8], v[9], v[10], v[11]} * rstd * g2; orow[128 + 2 * F.lane + 1] = (f32x4){v[12], v[13], v[14], v[15]} * rstd * g3; }
                if (MODE == 1) {
                    const float rstd = 1.0f / sqrtf((half ? tB : tA) * (1.0f / DM) + NORM_EPS);
                    float lg[8];
#pragma unroll
                    for (int e = 0; e < 8; ++e) lg[e] = 0.f;
#pragma unroll
                    for (int i = 0; i < 16; ++i) { const f32x4 w0 = wr[i][0], w1 = wr[i][1]; const float hv = v[i];
                        lg[0] += hv * w0.x; lg[1] += hv * w0.y; lg[2] += hv * w0.z; lg[3] += hv * w0.w; lg[4] += hv * w1.x; lg[5] += hv * w1.y; lg[6] += hv * w1.z; lg[7] += hv * w1.w; }
                    {
                        const bool b5 = (F.lane & 32) != 0, b4 = (F.lane & 16) != 0, b3 = (F.lane & 8) != 0;
                        float a4[4], a2[2];
#pragma unroll
                        for (int i = 0; i < 4; ++i) { const float keep = b5 ? lg[4 + i] : lg[i], send = b5 ? lg[i] : lg[4 + i]; a4[i] = keep + __shfl_xor(send, 32); }
#pragma unroll
                        for (int i = 0; i < 2; ++i) { const float keep = b4 ? a4[2 + i] : a4[i], send = b4 ? a4[i] : a4[2 + i]; a2[i] = keep + __shfl_xor(send, 16); }
                        float c = (b3 ? a2[1] : a2[0]) + __shfl_xor(b3 ? a2[0] : a2[1], 8);
                        c += __shfl_xor(c, 4); c += __shfl_xor(c, 2); c += __shfl_xor(c, 1);
                        c *= rstd;
#pragma unroll
                        for (int e = 0; e < 8; ++e) lg[e] = __builtin_bit_cast(float, __builtin_amdgcn_readlane(__builtin_bit_cast(int, c), 8 * e));
                    }
                    int e0 = 0; float l0 = lg[0];
#pragma unroll
                    for (int e = 1; e < 8; ++e) if (lg[e] > l0) { l0 = lg[e]; e0 = e; }
                    int e1 = -1; float l1 = -INFINITY;
#pragma unroll
                    for (int e = 0; e < 8; ++e) if (e != e0 && lg[e] > l1) { l1 = lg[e]; e1 = e; }
                    const float g0 = 1.0f / (1.0f + __expf(l1 - l0)), g1 = 1.0f - g0;
                    if (F.lane == 0) { toke[2 * r] = e0; toke[2 * r + 1] = e1; tokg[2 * r] = g0; tokg[2 * r + 1] = g1; __hip_atomic_fetch_add(&cnt[e0], 1, __ATOMIC_RELAXED, __HIP_MEMORY_SCOPE_WORKGROUP); __hip_atomic_fetch_add(&cnt[e1], 1, __ATOMIC_RELAXED, __HIP_MEMORY_SCOPE_WORKGROUP); }
                }
            }
        }
    }
    if (MODE == 1) { __syncthreads(); if (F.tid < 8) wgcnt[F.bid * 8 + F.tid] = cnt[F.tid]; __syncthreads(); }
}

__device__ __forceinline__ void slot_phase(Frame& F, LAS int* tot, const int* toke, const float* tokg, int* toks, float* sgate, float* sss, const float* ss, const bf16* XR, unsigned char* XB) {
    const int RPW = (NTOK + F.G - 1) / F.G; const int r0 = F.bid * RPW, r1 = (r0 + RPW < NTOK) ? r0 + RPW : NTOK;
    LAS int* slotof = tot + 64;
    const int np = 2 * (r1 - r0);
    for (int p = F.tid; p < np; p += NWAVES * 64) { const int idx = 2 * r0 + p; const int e = toke[idx]; const int slot = __hip_atomic_fetch_add(&tot[16 + e], 1, __ATOMIC_RELAXED, __HIP_MEMORY_SCOPE_WORKGROUP);
        toks[idx] = slot; sgate[slot] = tokg[idx]; slotof[p] = slot; }
    __syncthreads();
    for (int p = F.wave; p < np; p += NWAVES) { const int tok = r0 + (p >> 1); const int slot = slotof[p];
        float v[16]; rowb_load(XR + (size_t)tok * DM, F.lane, v);
        if (F.lane == 0) sss[slot] = __builtin_amdgcn_rsqf(ss_total(ss, tok) * (1.0f / DM) + NORM_EPS);
        GAS unsigned long long* d = (GAS unsigned long long*)(XB + (size_t)slot * DM);
        d[F.lane] = (unsigned long long)pg8::pk4_fp8(v[0] * F8_SA, v[1] * F8_SA, v[2] * F8_SA, v[3] * F8_SA) | ((unsigned long long)pg8::pk4_fp8(v[4] * F8_SA, v[5] * F8_SA, v[6] * F8_SA, v[7] * F8_SA) << 32);
        d[64 + F.lane] = (unsigned long long)pg8::pk4_fp8(v[8] * F8_SA, v[9] * F8_SA, v[10] * F8_SA, v[11] * F8_SA) | ((unsigned long long)pg8::pk4_fp8(v[12] * F8_SA, v[13] * F8_SA, v[14] * F8_SA, v[15] * F8_SA) << 32); }
    __syncthreads();
}

__device__ __forceinline__ void kpe_phase(Frame& F, const bf16* LAT, const float* tab, bf16* KPE) {
    for (int i = F.bid * NWAVES * 64 + F.tid; i < NTOK * 16; i += F.G * NWAVES * 64) { const int r = i >> 4, p = i & 15;
        const unsigned w = *(const GAS unsigned*)(LAT + (size_t)r * 768 + 640 + 2 * p); const float x1 = bf_lo(w), x2 = bf_hi(w);
        const float c = tab[(size_t)(r % SEQ) * 32 + 2 * p], sn = tab[(size_t)(r % SEQ) * 32 + 2 * p + 1];
        *(GAS unsigned*)(KPE + (size_t)r * 32 + 2 * p) = pk2(x1 * c - x2 * sn, x1 * sn + x2 * c); }
}
__device__ __forceinline__ void latpost_phase(Frame& F, const bf16* LAT, const float* qg, const float* kvg, const float* tab, bf16* QN, bf16* KVN, bf16* KPE) {
    const int gw = F.bid * NWAVES + F.wave, NGW = F.G * NWAVES;
    for (int r = gw; r < NTOK; r += NGW) {
        const bf16* row = LAT + (size_t)r * 768;
        float q[6]; float s = 0.f;
#pragma unroll
        for (int i = 0; i < 6; ++i) { q[i] = bf_lo((unsigned)row[F.lane + 64 * i]); s += q[i] * q[i]; }
        const float rq = 1.0f / sqrtf(wave_sum(s) * (1.0f / 384.0f) + NORM_EPS);
#pragma unroll
        for (int i = 0; i < 6; ++i) QN[(size_t)r * 384 + F.lane + 64 * i] = (bf16)f2bf(q[i] * rq * qg[F.lane + 64 * i]);
        float k[4]; s = 0.f;
#pragma unroll
        for (int i = 0; i < 4; ++i) { k[i] = bf_lo((unsigned)row[384 + F.lane + 64 * i]); s += k[i] * k[i]; }
        const float rk = 1.0f / sqrtf(wave_sum(s) * (1.0f / 256.0f) + NORM_EPS);
#pragma unroll
        for (int i = 0; i < 4; ++i) KVN[(size_t)r * 256 + F.lane + 64 * i] = (bf16)f2bf(k[i] * rk * kvg[F.lane + 64 * i]);
        if (F.lane < 16) { const float x1 = bf_lo((unsigned)row[640 + 2 * F.lane]), x2 = bf_lo((unsigned)row[640 + 2 * F.lane + 1]);
            const float c = tab[(size_t)(r % SEQ) * 32 + 2 * F.lane], sn = tab[(size_t)(r % SEQ) * 32 + 2 * F.lane + 1];
            *(GAS unsigned*)(KPE + (size_t)r * 32 + 2 * F.lane) = pk2(x1 * c - x2 * sn, x1 * sn + x2 * c); }
    }
}

namespace fa {
typedef float f32x16 __attribute__((ext_vector_type(16)));
typedef short s16x4 __attribute__((ext_vector_type(4)));
typedef short v4i16_t __attribute__((ext_vector_type(4)));
typedef float f32x2_t __attribute__((ext_vector_type(2)));
typedef __bf16 bf16x2_t __attribute__((ext_vector_type(2)));
__device__ __forceinline__ unsigned cvtpk(float lo, float hi) { f32x2_t v = {lo, hi}; bf16x2_t b = __builtin_convertvector(v, bf16x2_t); return __builtin_bit_cast(unsigned, b); }
__device__ __forceinline__ float fsub1(float a, float b) { float r; asm("v_sub_f32_e32 %0, %1, %2" : "=v"(r) : "v"(a), "v"(b)); return r; }
__device__ __forceinline__ float fadd1(float a, float b) { float r; asm("v_add_f32_e32 %0, %1, %2" : "=v"(r) : "v"(a), "v"(b)); return r; }
__device__ __forceinline__ bf16x8 pack8(const f32x16& x, int s) {
    v4u p; p.x = cvtpk(x[8 * s], x[8 * s + 1]); p.y = cvtpk(x[8 * s + 2], x[8 * s + 3]); p.z = cvtpk(x[8 * s + 4], x[8 * s + 5]); p.w = cvtpk(x[8 * s + 6], x[8 * s + 7]);
    return __builtin_bit_cast(bf16x8, p);
}
__device__ __forceinline__ s16x4 vtr(const LAS unsigned char* p) { return __builtin_bit_cast(s16x4, __builtin_amdgcn_ds_read_tr16_b64_v4i16((LAS v4i16_t*)p)); }
#define FA_MFMA(a, b, c) __builtin_amdgcn_mfma_f32_32x32x16_bf16((a), (b), (c), 0, 0, 0)
#define FA_CI(i) (((i) & 3) + 8 * ((i) >> 2))

struct Desc {
    const bf16* q0; const bf16* q1; int qstride;
    const bf16* k0; int kstride; const bf16* k1; int k1stride;
    const bf16* v; int vstride;
    int qpos0;
    int t_lo, t_hi;
    int W;
    float sl2;
    const LAS float* pm; LAS unsigned* ecnt;
    const float* ropetab;
};
template <int DQK0, int DQK1, int DV> struct Geo {
    static constexpr int DQK = DQK0 + DQK1, RSK = DQK * 2 + 16, RSV = DV * 2 + 64, KBYTES = 64 * RSK, VBYTES = 64 * RSV, BUF = KBYTES + VBYTES;
    static constexpr int C0 = DQK0 / 8, C1 = DQK1 / 8, CV = DV / 8, NV = DV / 64;
};
#define FA_OFFSETS() unsigned koff, k1off = 0u, voff[G::NV], klds, k1lds = 0u, vlds[G::NV]; \
        { const int row_ = tid / G::C0, ch_ = tid % G::C0; koff = (unsigned)(row_ * d.kstride + ch_ * 8) * 2u; klds = (unsigned)(row_ * G::RSK + ch_ * 16); } \
        if (G::C1 > 0) { const int row_ = tid / (G::C1 > 0 ? G::C1 : 1), ch_ = tid % (G::C1 > 0 ? G::C1 : 1); k1off = (unsigned)(row_ * d.k1stride + ch_ * 8) * 2u; k1lds = (unsigned)(row_ * G::RSK + DQK0 * 2 + ch_ * 16); } \
        _Pragma("unroll") for (int i_ = 0; i_ < G::NV; ++i_) { const int c_ = tid + 512 * i_, row_ = c_ / G::CV, ch_ = c_ % G::CV; voff[i_] = (unsigned)(row_ * d.vstride + ch_ * 8) * 2u; vlds[i_] = (unsigned)(G::KBYTES + row_ * G::RSV + ch_ * 16); }
#define FA_RSRC() const __amdgpu_buffer_rsrc_t rk0 = __builtin_amdgcn_make_buffer_rsrc((void*)d.k0, 0, 0x7fffffff, 0x00020000), rv = __builtin_amdgcn_make_buffer_rsrc((void*)d.v, 0, 0x7fffffff, 0x00020000), \
        rk1 = __builtin_amdgcn_make_buffer_rsrc((void*)(G::C1 > 0 ? d.k1 : d.k0), 0, 0x7fffffff, 0x00020000)
#define FA_GLOAD(t_) do { const int key0_ = (t_) * 64;     \
        sk0 = __builtin_bit_cast(v4u, __builtin_amdgcn_raw_buffer_load_b128(rk0, (int)koff, key0_ * d.kstride * 2, 0)); \
        if (G::C1 > 0) { if (tid < 64 * G::C1) sk1 = __builtin_bit_cast(v4u, __builtin_amdgcn_raw_buffer_load_b128(rk1, (int)k1off, key0_ * d.k1stride * 2, 0)); } \
        _Pragma("unroll") for (int i_ = 0; i_ < G::NV; ++i_) sv[i_] = __builtin_bit_cast(v4u, __builtin_amdgcn_raw_buffer_load_b128(rv, (int)voff[i_], key0_ * d.vstride * 2, 0)); } while (0)
#define FA_LSTORE(buf_) do { LAS unsigned char* kb_ = lds + (buf_) * G::BUF; \
        *(LAS v4u*)(kb_ + klds) = sk0; \
        if (G::C1 > 0) { if (tid < 64 * G::C1) *(LAS v4u*)(kb_ + k1lds) = sk1; } \
        _Pragma("unroll") for (int i_ = 0; i_ < G::NV; ++i_) *(LAS v4u*)(kb_ + vlds[i_]) = sv[i_]; } while (0)
#define FA_QK1(kbuf_, kb_, P_) do { const LAS unsigned char* kp_ = (kbuf_) + (32 * (kb_) + r) * G::RSK + h * 16; \
        _Pragma("unroll") for (int s_ = 0; s_ < G::DQK / 16; ++s_) { bf16x8 qv_; if (QLDS) qv_ = *(const LAS bf16x8*)(qs + s_ * 1024); else qv_ = qf[s_]; \
            const bf16x8 kf_ = *(const LAS bf16x8*)(kp_ + s_ * 32); P_ = FA_MFMA(kf_, qv_, s_ == 0 ? zero : P_); } } while (0)
#define FA_PV(vbuf_) do { const LAS unsigned char* vp_ = (vbuf_) + (4 * h + ((lane & 15) >> 2)) * G::RSV + ((lane >> 4) & 1) * 32 + (lane & 3) * 8; \
        _Pragma("unroll") for (int ks_ = 0; ks_ < 4; ++ks_) _Pragma("unroll") for (int c_ = 0; c_ < DV / 32; ++c_) { \
            const s16x4 lo_ = vtr(vp_ + (16 * ks_) * G::RSV + c_ * 64), hi_ = vtr(vp_ + (16 * ks_ + 8) * G::RSV + c_ * 64); \
            const bf16x8 vf_ = {lo_[0], lo_[1], lo_[2], lo_[3], hi_[0], hi_[1], hi_[2], hi_[3]}; o[c_] = FA_MFMA(vf_, pf[ks_], o[c_]); } } while (0)

template <int DQK0, int DQK1, int DV, bool BIAS, bool QLDS, bool EXIT = false>
__device__ __forceinline__ void flash_unit(LAS unsigned char* lds, const Desc& d, int tid, f32x16 (&o)[DV / 32], float& m_out, float& l_out) {
    typedef Geo<DQK0, DQK1, DV> G;
    const int lane = tid & 63, wave = __builtin_amdgcn_readfirstlane(tid >> 6), r = lane & 31, h = lane >> 5;
    bf16x8 qf[G::DQK / 16];
    LAS unsigned char* qs = lds + 2 * G::BUF + wave * (G::DQK / 16) * 1024 + lane * 16;
    { const unsigned qoff = (unsigned)((wave * 32 + r) * d.qstride);
#pragma unroll
      for (int s = 0; s < DQK0 / 16; ++s) qf[s] = *(const GAS bf16x8*)(d.q0 + qoff + s * 16 + h * 8);
#pragma unroll
      for (int s = 0; s < DQK1 / 16; ++s) qf[DQK0 / 16 + s] = *(const GAS bf16x8*)(d.q1 + qoff + s * 16 + h * 8);
      if (DQK1 > 0) { if (d.ropetab) {
#pragma unroll
          for (int s = 0; s < DQK1 / 16; ++s) { const float* t = d.ropetab + (size_t)(d.qpos0 + wave * 32 + r) * 32 + 16 * s + 8 * h; const f32x4 c0 = *(const GAS f32x4*)t, c1 = *(const GAS f32x4*)(t + 4);
              const v4u w = __builtin_bit_cast(v4u, qf[DQK0 / 16 + s]); v4u o_; float a, b;
              a = bf_lo(w.x); b = bf_hi(w.x); o_.x = pk2(a * c0[0] - b * c0[1], a * c0[1] + b * c0[0]);
              a = bf_lo(w.y); b = bf_hi(w.y); o_.y = pk2(a * c0[2] - b * c0[3], a * c0[3] + b * c0[2]);
              a = bf_lo(w.z); b = bf_hi(w.z); o_.z = pk2(a * c1[0] - b * c1[1], a * c1[1] + b * c1[0]);
              a = bf_lo(w.w); b = bf_hi(w.w); o_.w = pk2(a * c1[2] - b * c1[3], a * c1[3] + b * c1[2]);
              qf[DQK0 / 16 + s] = __builtin_bit_cast(bf16x8, o_); } } }
      if (QLDS) {
#pragma unroll
          for (int s = 0; s < G::DQK / 16; ++s) *(LAS bf16x8*)(qs + s * 1024) = qf[s]; } }
    float qn = 0.f;
    if (EXIT) {
#pragma unroll
        for (int s = 0; s < G::DQK / 16; ++s)
#pragma unroll
            for (int j = 0; j < 8; ++j) { const float f = bf_lo((unsigned)(unsigned short)qf[s][j]); qn += f * f; }
        qn += __shfl_xor(qn, 32); qn = sqrtf(qn) * 1.01f;
    }
    f32x16 zero;
#pragma unroll
    for (int i = 0; i < 16; ++i) zero[i] = 0.f;
#pragma unroll
    for (int c = 0; c < DV / 32; ++c)
#pragma unroll
        for (int i = 0; i < 16; ++i) o[c][i] = 0.f;
    float m = -1e30f, l = 0.f;
    const int qmin = d.qpos0 + wave * 32, qpos = qmin + r;
    if (__builtin_amdgcn_readfirstlane(tid) >= 256) __builtin_amdgcn_s_setprio(1);
    v4u sk0, sk1, sv[G::NV];
    FA_OFFSETS();
    FA_RSRC();
    FA_GLOAD(d.t_hi); FA_LSTORE(0); __syncthreads();
    int buf = 0; unsigned prev0 = 0u, prev1 = 0u; bool done_w = false;
    for (int t = d.t_hi; t >= d.t_lo; --t) {
        if (QLDS) { int tl = tid; asm volatile("" : "+v"(tl));
            { const int row_ = tl / G::C0, ch_ = tl % G::C0; koff = (unsigned)(row_ * d.kstride + ch_ * 8) * 2u; klds = (unsigned)(row_ * G::RSK + ch_ * 16); }
#pragma unroll
            for (int i_ = 0; i_ < G::NV; ++i_) { const int c_ = tl + 512 * i_, row_ = c_ / G::CV, ch_ = c_ % G::CV; voff[i_] = (unsigned)(row_ * d.vstride + ch_ * 8) * 2u; vlds[i_] = (unsigned)(G::KBYTES + row_ * G::RSV + ch_ * 16); } }
        if (t > d.t_lo) FA_GLOAD(t - 1);
        const int k0 = t * 64;
        const bool act = (k0 <= qmin + 31 && k0 + 63 >= qmin - d.W) && !done_w;
        const LAS unsigned char* kbuf = lds + buf * G::BUF; const LAS unsigned char* vbuf = kbuf + G::KBYTES;
        bf16x8 pf[4];
        if (act) {
            f32x16 p[2];
            FA_QK1(kbuf, 0, p[0]); FA_QK1(kbuf, 1, p[1]);
            if (BIAS) {
#pragma unroll
                for (int i = 0; i < 16; ++i) { p[0][i] = __builtin_fmaf(d.sl2, (float)FA_CI(i), p[0][i]); p[1][i] = __builtin_fmaf(d.sl2, (float)FA_CI(i), p[1][i]); } }
            const int dq0 = qpos - k0 - 4 * h;
            const float off0 = BIAS ? d.sl2 * (float)dq0 : 0.f, off1 = BIAS ? d.sl2 * (float)(dq0 - 32) : 0.f;
            if (k0 + 63 > qmin || k0 < qmin + 31 - d.W) {
#pragma unroll
                for (int kb = 0; kb < 2; ++kb) { const int dq = dq0 - 32 * kb;
#pragma unroll
                    for (int i = 0; i < 16; ++i) { const bool ok = (FA_CI(i) <= dq) && (FA_CI(i) >= dq - d.W); p[kb][i] = ok ? p[kb][i] : -INFINITY; } }
            }
            float mx0 = p[0][0], mx1 = p[1][0];
#pragma unroll
            for (int i = 1; i < 16; ++i) { mx0 = fmaxf(mx0, p[0][i]); mx1 = fmaxf(mx1, p[1][i]); }
            float tm = fmaxf(mx0 - off0, mx1 - off1);
            tm = fmaxf(tm, __shfl_xor(tm, 32));
            if (__any(tm > m + 8.0f)) {
                const float mn = fmaxf(m, tm), al = ex2(m - mn); m = mn; l *= al;
#pragma unroll
                for (int c = 0; c < DV / 32; ++c)
#pragma unroll
                    for (int i = 0; i < 16; ++i) o[c][i] *= al;
            }
            const float mk0 = m + off0, mk1 = m + off1; float ps = 0.f;
#pragma unroll
            for (int i = 0; i < 16; ++i) { p[0][i] = ex2(p[0][i] - mk0); p[1][i] = ex2(p[1][i] - mk1); ps += p[0][i] + p[1][i]; }
            l += ps;
            pf[0] = pack8(p[0], 0); pf[1] = pack8(p[0], 1); pf[2] = pack8(p[1], 0); pf[3] = pack8(p[1], 1);
        }
        if (EXIT) {
            if (!done_w && t > d.t_lo) { const float bound = qn * d.pm[t - 1] + d.sl2 * (float)(k0 - 1 - qpos); done_w = __all(bound - m < -40.0f); }
            if (!done_w && lane == 0) __hip_atomic_fetch_add(&d.ecnt[t & 1], 1u, __ATOMIC_RELAXED, __HIP_MEMORY_SCOPE_WORKGROUP);
        }
        if (t > d.t_lo) FA_LSTORE(buf ^ 1);
        if (act) { FA_PV(vbuf); }
        __syncthreads();
        buf ^= 1;
        if (EXIT) { const unsigned c = d.ecnt[t & 1]; if (t & 1) { if (c == prev1) break; prev1 = c; } else { if (c == prev0) break; prev0 = c; } }
    }
    if (EXIT) __syncthreads();
    __builtin_amdgcn_s_setprio(0);
    m_out = m; l_out = l;
}
__device__ __forceinline__ void sb_unit(LAS unsigned char* lds, const Desc& d, int tid, f32x16 (&o)[2], LAS unsigned* ecnt) {
    typedef Geo<64, 0, 64> G; constexpr int DQK0 = 64, DV = 64; constexpr bool QLDS = false; LAS unsigned char* qs = nullptr;
    const int lane = tid & 63, wave = __builtin_amdgcn_readfirstlane(tid >> 6), r = lane & 31, h = lane >> 5;
    bf16x8 qf[4];
    { const unsigned qoff = (unsigned)((wave * 32 + r) * d.qstride);
#pragma unroll
      for (int s = 0; s < 4; ++s) qf[s] = *(const GAS bf16x8*)(d.q0 + qoff + s * 16 + h * 8); }
    f32x16 zero;
#pragma unroll
    for (int i = 0; i < 16; ++i) { zero[i] = 0.f; o[0][i] = 0.f; o[1][i] = 0.f; }
    float carry = 1.0f;
    const int qmin = d.qpos0 + wave * 32, qpos = qmin + r;
    v4u sk0, sk1, sv[G::NV];
    FA_OFFSETS();
    FA_RSRC();
    if (tid < 2) ecnt[tid] = 0u;
    FA_GLOAD(d.t_hi); FA_LSTORE(0); __syncthreads();
    int buf = 0; unsigned prev0 = 0u, prev1 = 0u; bool done_w = false;
    for (int t = d.t_hi; t >= d.t_lo; --t) {
        if (t > d.t_lo) FA_GLOAD(t - 1);
        const int k0 = t * 64;
        if (k0 < qmin + 31 && !done_w) {
            const LAS unsigned char* kbuf = lds + buf * G::BUF; const LAS unsigned char* vbuf = kbuf + G::KBYTES;
            f32x16 p[2];
            FA_QK1(kbuf, 0, p[0]); FA_QK1(kbuf, 1, p[1]);
            const int dq0 = qpos - k0 - 4 * h;
            if (k0 + 63 >= qmin) {
#pragma unroll
                for (int kb = 0; kb < 2; ++kb) { const int dq = dq0 - 32 * kb;
#pragma unroll
                    for (int i = 0; i < 16; ++i) p[kb][i] = (FA_CI(i) < dq) ? p[kb][i] : -INFINITY; }
            }
#pragma unroll
            for (int kk = 0; kk < 2; ++kk) { const int kb = 1 - kk;
                float T[4];
#pragma unroll
                for (int g = 0; g < 4; ++g) {
                    float kp[4], bt[4];
#pragma unroll
                    for (int j = 0; j < 4; ++j) { const float ez = ex2(p[kb][4 * g + j]); kp[j] = __builtin_amdgcn_rcpf(1.0f + ez); bt[j] = ez * kp[j]; }
                    const float e2 = kp[3], e1 = e2 * kp[2], e0 = e1 * kp[1]; T[g] = e0 * kp[0];
                    p[kb][4 * g + 3] = bt[3]; p[kb][4 * g + 2] = bt[2] * e2; p[kb][4 * g + 1] = bt[1] * e1; p[kb][4 * g] = bt[0] * e0;
                }
                float PT[4];
#pragma unroll
                for (int g = 0; g < 4; ++g) PT[g] = __shfl_xor(T[g], 32);
                const float S3 = carry * (h ? 1.0f : PT[3]);
                const float S2 = S3 * T[3] * (h ? PT[3] : PT[2]);
                const float S1 = S2 * T[2] * (h ? PT[2] : PT[1]);
                const float S0 = S1 * T[1] * (h ? PT[1] : PT[0]);
                carry = S0 * T[0] * (h ? PT[0] : 1.0f);
#pragma unroll
                for (int j = 0; j < 4; ++j) { p[kb][12 + j] *= S3; p[kb][8 + j] *= S2; p[kb][4 + j] *= S1; p[kb][j] *= S0; }
            }
            bf16x8 pf[4]; pf[0] = pack8(p[0], 0); pf[1] = pack8(p[0], 1); pf[2] = pack8(p[1], 0); pf[3] = pack8(p[1], 1);
            FA_PV(vbuf);
            done_w = __all(carry <= 1e-30f);
        }
        if (!done_w && lane == 0) __hip_atomic_fetch_add(&ecnt[t & 1], 1u, __ATOMIC_RELAXED, __HIP_MEMORY_SCOPE_WORKGROUP);
        if (t > d.t_lo) FA_LSTORE(buf ^ 1);
        __syncthreads();
        buf ^= 1;
        const unsigned c = ecnt[t & 1];
        if (t & 1) { if (c == prev1) break; prev1 = c; } else { if (c == prev0) break; prev0 = c; }
    }
    __syncthreads();
}
}
#ifndef B_EXIT
#define B_EXIT 1
#endif
__device__ __forceinline__ int vcu_of(const Frame& F) { return (F.G % 8 == 0) ? (F.bid % 8) * (F.G / 8) + F.bid / 8 : F.bid; }
template <int NV> __device__ __forceinline__ void store_rows_own(bf16* out, int rstride, int wave, int lane, const fa::f32x16 (&o)[NV], float scale) {
    const int r = lane & 31, h = lane >> 5; bf16* rowp = out + (unsigned)((wave * 32 + r) * rstride + 4 * h);
#pragma unroll
    for (int c = 0; c < NV; ++c)
#pragma unroll
        for (int g = 0; g < 4; ++g) { const unsigned lo = fa::cvtpk(o[c][4 * g] * scale, o[c][4 * g + 1] * scale), hi = fa::cvtpk(o[c][4 * g + 2] * scale, o[c][4 * g + 3] * scale);
            *(GAS unsigned long long*)(rowp + 32 * c + 8 * g) = (unsigned long long)lo | ((unsigned long long)hi << 32); }
}
template <int NV> __device__ __forceinline__ void store_rows(bf16* out, int rstride, int wave, int lane, const fa::f32x16 (&o)[NV], float scale) {
    const int r = lane & 31, h = lane >> 5; bf16* rowp = out + (unsigned)((wave * 32 + r) * rstride + 8 * h);
#pragma unroll
    for (int c = 0; c < NV; ++c)
#pragma unroll
        for (int k = 0; k < 4; k += 2) {
            unsigned ax = fa::cvtpk(o[c][4 * k] * scale, o[c][4 * k + 1] * scale), ay = fa::cvtpk(o[c][4 * k + 2] * scale, o[c][4 * k + 3] * scale);
            unsigned bx = fa::cvtpk(o[c][4 * k + 4] * scale, o[c][4 * k + 5] * scale), by = fa::cvtpk(o[c][4 * k + 6] * scale, o[c][4 * k + 7] * scale);
            const auto r0 = __builtin_amdgcn_permlane32_swap(ax, bx, false, false); const auto r1 = __builtin_amdgcn_permlane32_swap(ay, by, false, false);
            const v4u w = {r0[0], r1[0], r0[1], r1[1]};
            *(GAS v4u*)(rowp + 32 * c + 8 * k) = w; }
}
template <int NV> __device__ __forceinline__ void store_rows_f8(unsigned char* out, int rstride, int wave, int lane, const fa::f32x16 (&o)[NV], float scale) {
    const int r = lane & 31, h = lane >> 5; unsigned char* rowp = out + (size_t)(wave * 32 + r) * rstride + 8 * h;
#pragma unroll
    for (int c = 0; c < NV; ++c)
#pragma unroll
        for (int k = 0; k < 4; k += 2) {
            unsigned ax = pg8::pk4_fp8(o[c][4 * k] * scale, o[c][4 * k + 1] * scale, o[c][4 * k + 2] * scale, o[c][4 * k + 3] * scale);
            unsigned bx = pg8::pk4_fp8(o[c][4 * k + 4] * scale, o[c][4 * k + 5] * scale, o[c][4 * k + 6] * scale, o[c][4 * k + 7] * scale);
            const auto r0 = __builtin_amdgcn_permlane32_swap(ax, bx, false, false);
            *(GAS unsigned long long*)(rowp + 32 * c + 8 * k) = (unsigned long long)r0[0] | ((unsigned long long)r0[1] << 32); }
}
__device__ __forceinline__ void fast_attn_c(Frame& F, const bf16* Q, const bf16* KV, const bf16* KPE, const float* ropetab, bf16* OUT) {
    const int v = vcu_of(F);
    for (int P = v; P < BATCH * 16 * 8; P += F.G) {
        const int bh = P >> 3, pi = P & 7, b = bh >> 4, hd = bh & 15;
        for (int half = 0; half < 2; ++half) { const int qb = half ? pi : 15 - pi; const long row0 = (long)b * SEQ + qb * 256;
            fa::Desc d; d.q0 = Q + row0 * 1536 + 64 * hd; d.q1 = Q + row0 * 1536 + 1024 + 32 * hd; d.qstride = 1536;
            d.k0 = KV + (long)b * SEQ * 2048 + 64 * hd; d.kstride = 2048; d.k1 = KPE + (long)b * SEQ * 32; d.k1stride = 32;
            d.v = KV + (long)b * SEQ * 2048 + 1024 + 64 * hd; d.vstride = 2048; d.qpos0 = qb * 256; d.t_lo = 0; d.t_hi = 4 * qb + 3; d.W = 1 << 29; d.sl2 = 0.f; d.pm = nullptr; d.ecnt = nullptr; d.ropetab = ropetab;
            fa::f32x16 o[2]; float m, l;
            fa::flash_unit<64, 32, 64, false, false>(F.lds + RING_OFF, d, F.tid, o, m, l);
            const float lt = l + __shfl_xor(l, 32);
            if (WOC_F8) store_rows_f8<2>((unsigned char*)OUT + row0 * 1024 + 64 * hd, 1024, F.wave, F.lane, o, F8_SA / lt); else store_rows<2>(OUT + row0 * 1024 + 64 * hd, 1024, F.wave, F.lane, o, 1.0f / lt);
        }
    }
}
__device__ __forceinline__ void fast_attn_d(Frame& F, const bf16* QKV, bf16* OUT) {
    const int v = vcu_of(F);
    LAS unsigned* ecnt = (LAS unsigned*)(F.lds + RING_OFF + 2 * fa::Geo<64, 0, 64>::BUF);
    for (int P = v; P < BATCH * 16 * 8; P += F.G) {
        const int bh = P >> 3, pi = P & 7, b = bh >> 4, hd = bh & 15;
        for (int half = 0; half < 2; ++half) { const int qb = half ? pi : 15 - pi; const long row0 = (long)b * SEQ + qb * 256;
            fa::Desc d; d.q0 = QKV + row0 * 3072 + 64 * hd; d.q1 = nullptr; d.qstride = 3072;
            d.k0 = QKV + (long)b * SEQ * 3072 + 1024 + 64 * hd; d.kstride = 3072; d.k1 = nullptr; d.k1stride = 0;
            d.v = QKV + (long)b * SEQ * 3072 + 2048 + 64 * hd; d.vstride = 3072; d.qpos0 = qb * 256; d.t_lo = 0; d.t_hi = 4 * qb + 3; d.W = 1 << 29; d.sl2 = 0.f; d.pm = nullptr; d.ecnt = nullptr; d.ropetab = nullptr;
            fa::f32x16 o[2];
            fa::sb_unit(F.lds + RING_OFF, d, F.tid, o, ecnt);
            if (WOD_F8) store_rows_f8<2>((unsigned char*)OUT + row0 * 1024 + 64 * hd, 1024, F.wave, F.lane, o, F8_SA); else store_rows<2>(OUT + row0 * 1024 + 64 * hd, 1024, F.wave, F.lane, o, 1.0f);
        }
    }
}
__device__ __forceinline__ void fast_attn_b(Frame& F, const bf16* QKV, const float* KN, unsigned* queue, bf16* OUT, const float* lq1, const float* lk1, const float* lq2, const float* lk2, const float* subln) {
    float d1 = 0.f, d2 = 0.f;
    for (int i = 0; i < 64; ++i) { d1 += lq1[i] * lk1[i]; d2 += lq2[i] * lk2[i]; }
    const float lam_init = 0.8f - 0.6f * expf(-0.3f * 1.0f), lam = __builtin_bit_cast(float, __builtin_amdgcn_readfirstlane(__builtin_bit_cast(int, expf(d1) - expf(d2) + lam_init)));
    LAS int* qslot = (LAS int*)(F.lds + RING_OFF + 2 * fa::Geo<64, 0, 128>::BUF + NWAVES * 4096 + 512);
    for (;;) {
        if (F.tid == 0) *qslot = (int)__hip_atomic_fetch_add(queue, 1u, __ATOMIC_RELAXED, __HIP_MEMORY_SCOPE_AGENT);
        __syncthreads();
        const int P = *qslot;
        __syncthreads();
        if (P >= BATCH * 8 * 8) break;
        const int hd = 7 - (P >> 6), b = (P >> 3) & 7, pi = P & 7;
        for (int half = 0; half < 2; ++half) { const int qb = half ? pi : 15 - pi; const long row0 = (long)b * SEQ + qb * 256;
            fa::f32x16 o[4]; float m, l;
            bf16* orow = OUT + row0 * 1024 + 128 * hd;
            for (int mm = 0; mm < 2; ++mm) {
                fa::Desc d; d.q0 = QKV + row0 * 3072 + 128 * hd + 64 * mm; d.q1 = nullptr; d.qstride = 3072;
                d.k0 = QKV + (long)b * SEQ * 3072 + 1024 + 128 * hd + 64 * mm; d.kstride = 3072; d.k1 = nullptr; d.k1stride = 0;
                d.v = QKV + (long)b * SEQ * 3072 + 2048 + 128 * hd; d.vstride = 3072; d.qpos0 = qb * 256; d.t_lo = 0; d.t_hi = 4 * qb + 3; d.W = 1 << 29; d.sl2 = exp2f(-(float)(hd + 1)) * LOG2E;
                LAS float* pm = (LAS float*)(F.lds + RING_OFF + 2 * fa::Geo<64, 0, 128>::BUF + NWAVES * 4096); LAS unsigned* ecnt = (LAS unsigned*)(pm + 64);
                if (F.wave == 0) { int ln = F.lane; asm volatile("" : "+v"(ln)); float kv = (ln <= d.t_hi) ? KN[((size_t)b * 16 + 2 * hd + mm) * 64 + ln] * 1.01f : 0.f;
#pragma unroll
                    for (int o_ = 1; o_ < 64; o_ <<= 1) { const float u = __shfl_up(kv, o_); if (F.lane >= o_) kv = fmaxf(kv, u); }
                    pm[F.lane] = kv; if (F.lane < 2) ecnt[F.lane] = 0u; }
                d.pm = pm; d.ecnt = ecnt; d.ropetab = nullptr;
                fa::flash_unit<64, 0, 128, true, true, (B_EXIT != 0)>(F.lds + RING_OFF, d, F.tid, o, m, l);
                const float rl = 1.0f / (l + __shfl_xor(l, 32));
                if (mm == 0) { store_rows_own<4>(orow, 1024, F.wave, F.lane, o, rl); }
                else {
                    int l2 = F.lane; asm volatile("" : "+v"(l2)); const int r = l2 & 31, h = l2 >> 5;
                    float ss = 0.f; const bf16* rowp = orow + (unsigned)((F.wave * 32 + r) * 1024 + 4 * h);
#pragma unroll
                    for (int c = 0; c < 4; ++c) {
#pragma unroll
                        for (int g = 0; g < 4; ++g) { const unsigned long long w = *(const GAS unsigned long long*)(rowp + 32 * c + 8 * g); const unsigned lo = (unsigned)w, hi = (unsigned)(w >> 32);
                            const float a0 = bf_lo(lo) - lam * o[c][4 * g] * rl, a1 = bf_hi(lo) - lam * o[c][4 * g + 1] * rl, a2 = bf_lo(hi) - lam * o[c][4 * g + 2] * rl, a3 = bf_hi(hi) - lam * o[c][4 * g + 3] * rl;
                            o[c][4 * g] = a0; o[c][4 * g + 1] = a1; o[c][4 * g + 2] = a2; o[c][4 * g + 3] = a3; ss += (a0 * a0 + a1 * a1) + (a2 * a2 + a3 * a3); }
                        asm volatile("" ::: "memory"); }
                    ss += __shfl_xor(ss, 32);
                    const float rs = (1.0f - lam_init) / sqrtf(ss * (1.0f / 128.0f) + SUBLN_EPS);
#pragma unroll
                    for (int c = 0; c < 4; ++c) {
#pragma unroll
                        for (int g = 0; g < 4; ++g) { const f32x4 sg = *(const GAS f32x4*)(subln + 32 * c + 8 * g + 4 * h);
                            o[c][4 * g] *= sg[0]; o[c][4 * g + 1] *= sg[1]; o[c][4 * g + 2] *= sg[2]; o[c][4 * g + 3] *= sg[3]; }
                        asm volatile("" ::: "memory"); }
                    store_rows_own<4>(orow, 1024, F.wave, F.lane, o, rs);
                }
            }
        }
    }
}
__device__ __forceinline__ void fast_attn_a(Frame& F, const bf16* QKV, bf16* OG, float* LSE) {
    const int v = vcu_of(F);
    for (int U = v; U < 3 * BATCH * 8 * 16; U += F.G) {
        const int j = U & 15, hd = (U >> 4) & 7, b = (U >> 7) & 7, g = U >> 10; const int dil = 1 << (2 * g), res = j & (dil - 1), qblk = j >> (2 * g);
        const long tok0 = (long)b * SEQ + res;
        fa::Desc d; d.qstride = dil * 4608; d.q0 = QKV + (tok0 + (long)qblk * 256 * dil) * 4608 + g * 512 + hd * 64; d.q1 = nullptr;
        d.k0 = QKV + tok0 * 4608 + 1536 + g * 512 + hd * 64; d.kstride = d.qstride; d.k1 = nullptr; d.k1stride = 0;
        d.v = QKV + tok0 * 4608 + 3072 + g * 512 + hd * 64; d.vstride = d.qstride; d.qpos0 = qblk * 256;
        d.t_lo = (qblk * 256 - 128) < 0 ? 0 : (qblk * 256 - 128) / 64; d.t_hi = 4 * qblk + 3; d.W = 128; d.sl2 = exp2f(-(float)(g * 8 + hd + 1) / 3.0f) * LOG2E * (float)dil; d.pm = nullptr; d.ecnt = nullptr; d.ropetab = nullptr;
        fa::f32x16 o[2]; float m, l;
        fa::flash_unit<64, 0, 64, true, false>(F.lds + RING_OFF, d, F.tid, o, m, l);
        const float lt = l + __shfl_xor(l, 32);
        bf16* og = OG + (size_t)g * NTOK * 512;
        store_rows<2>(og + (tok0 + (long)qblk * 256 * dil) * 512 + hd * 64, dil * 512, F.wave, F.lane, o, 1.0f / lt);
        if (F.lane < 32) LSE[(size_t)g * NTOK * 8 + (tok0 + ((long)qblk * 256 + F.wave * 32 + F.lane) * dil) * 8 + hd] = m + log2f(lt);
    }
}
__device__ __forceinline__ void merge_a(Frame& F, const bf16* OG, const float* LSE, bf16* OUT) {
    const long stride = (long)F.G * NWAVES * 64, NI = (long)NTOK * 64;
    for (long i = (long)F.bid * NWAVES * 64 + F.tid; i < NI; i += 2 * stride) {
        const bool has2 = i + stride < NI; const long i2 = has2 ? i + stride : i;
        const long tokA = i >> 6, tokB = i2 >> 6; const int cA = (int)(i & 63), cB = (int)(i2 & 63), hA = cA >> 3, hB = cB >> 3;
        const float lA0 = LSE[tokA * 8 + hA], lA1 = LSE[(size_t)NTOK * 8 + tokA * 8 + hA], lA2 = LSE[(size_t)2 * NTOK * 8 + tokA * 8 + hA];
        const float lB0 = LSE[tokB * 8 + hB], lB1 = LSE[(size_t)NTOK * 8 + tokB * 8 + hB], lB2 = LSE[(size_t)2 * NTOK * 8 + tokB * 8 + hB];
        float a0[8], a1[8], a2[8], b0[8], b1[8], b2[8];
        ld8(OG + tokA * 512 + cA * 8, a0); ld8(OG + (size_t)NTOK * 512 + tokA * 512 + cA * 8, a1); ld8(OG + (size_t)2 * NTOK * 512 + tokA * 512 + cA * 8, a2);
        ld8(OG + tokB * 512 + cB * 8, b0); ld8(OG + (size_t)NTOK * 512 + tokB * 512 + cB * 8, b1); ld8(OG + (size_t)2 * NTOK * 512 + tokB * 512 + cB * 8, b2);
        { const float mx = fmaxf(lA0, fmaxf(lA1, lA2)); const float w0 = ex2(lA0 - mx), w1 = ex2(lA1 - mx), w2 = ex2(lA2 - mx), rw = 1.0f / (w0 + w1 + w2);
          float y[8];
#pragma unroll
          for (int e = 0; e < 8; ++e) y[e] = (w0 * a0[e] + w1 * a1[e] + w2 * a2[e]) * rw;
          v4u w; w.x = pk2(y[0], y[1]); w.y = pk2(y[2], y[3]); w.z = pk2(y[4], y[5]); w.w = pk2(y[6], y[7]);
          *(GAS v4u*)(OUT + tokA * 512 + cA * 8) = w; }
        if (has2) { const float mx = fmaxf(lB0, fmaxf(lB1, lB2)); const float w0 = ex2(lB0 - mx), w1 = ex2(lB1 - mx), w2 = ex2(lB2 - mx), rw = 1.0f / (w0 + w1 + w2);
          float y[8];
#pragma unroll
          for (int e = 0; e < 8; ++e) y[e] = (w0 * b0[e] + w1 * b1[e] + w2 * b2[e]) * rw;
          v4u w; w.x = pk2(y[0], y[1]); w.y = pk2(y[2], y[3]); w.z = pk2(y[4], y[5]); w.w = pk2(y[6], y[7]);
          *(GAS v4u*)(OUT + tokB * 512 + cB * 8) = w; }
    }
}

__device__ __forceinline__ void knorm_phase(Frame& F, const bf16* QKV, float* KN) {
    const int gw = F.bid * NWAVES + F.wave, NGW = F.G * NWAVES;
    for (int it = gw; it < BATCH * 64 * 16; it += NGW) {
        const int hm = it & 15, tile = (it >> 4) & 63, b = it >> 10;
        const bf16* row = QKV + ((size_t)b * SEQ + tile * 64 + F.lane) * 3072 + 1024 + hm * 64;
        float s = 0.f;
#pragma unroll
        for (int c = 0; c < 8; ++c) { float f[8]; ld8(row + 8 * c, f);
#pragma unroll
            for (int e = 0; e < 8; ++e) s += f[e] * f[e]; }
        float mx = sqrtf(s);
#pragma unroll
        for (int o_ = 1; o_ < 64; o_ <<= 1) mx = fmaxf(mx, __shfl_xor(mx, o_));
        if (F.lane == 0) KN[((size_t)b * 16 + hm) * 64 + tile] = mx;
    }
}

__device__ __forceinline__ int wave_sum_i(int v) {
#pragma unroll
    for (int o = 1; o < 64; o <<= 1) v += __shfl_xor(v, o);
    return v;
}
__device__ __forceinline__ void moe_layout(Frame& F, const int* wgcnt, LAS int* tot) {
    int t = 0, bfr = 0;
    for (int w = F.lane; w < F.G; w += 64) { const int c = wgcnt[w * 8 + F.wave]; t += c; bfr += (w < F.bid) ? c : 0; }
    t = wave_sum_i(t); bfr = wave_sum_i(bfr);
    if (F.lane == 0) { tot[F.wave] = t; tot[8 + F.wave] = bfr; }
    __syncthreads();
    if (F.tid == 0) { int ps = 0; for (int e = 0; e < 8; ++e) { tot[16 + e] = ps + tot[8 + e]; ps += ((tot[e] + 255) >> 8) << 8; F.MISC[16 + e] = (unsigned)(ps >> 8); } F.MISC[24] = (unsigned)(ps >> 8); }
    __syncthreads();
}

__device__ __forceinline__ void ropeq_phase(Frame& F, bf16* Q, const float* tab) {
    const int gw = F.bid * NWAVES + F.wave, NGW = F.G * NWAVES;
    for (int r = gw; r < NTOK; r += NGW) {
        GAS v4u* p = (GAS v4u*)(Q + (size_t)r * 1536 + 1024) + F.lane; v4u w = *p;
        const float* t = tab + (size_t)(r % SEQ) * 32 + 8 * (F.lane & 3); const f32x4 c0 = *(const GAS f32x4*)t, c1 = *(const GAS f32x4*)(t + 4);
        float a, b;
        a = bf_lo(w.x); b = bf_hi(w.x); w.x = pk2(a * c0[0] - b * c0[1], a * c0[1] + b * c0[0]);
        a = bf_lo(w.y); b = bf_hi(w.y); w.y = pk2(a * c0[2] - b * c0[3], a * c0[3] + b * c0[2]);
        a = bf_lo(w.z); b = bf_hi(w.z); w.z = pk2(a * c1[0] - b * c1[1], a * c1[1] + b * c1[0]);
        a = bf_lo(w.w); b = bf_hi(w.w); w.w = pk2(a * c1[2] - b * c1[3], a * c1[3] + b * c1[2]);
        *p = w;
    }
}

#ifndef MK_SPLIT
#define MK_SPLIT 0
#endif
#ifndef NAIVE_A
#define NAIVE_A 0
#endif
#ifndef NAIVE_B
#define NAIVE_B 0
#endif
#ifndef NAIVE_C
#define NAIVE_C 0
#endif
#ifndef NAIVE_D
#define NAIVE_D 0
#endif
#ifndef QKVD_F8
#define QKVD_F8 1
#endif
#ifndef FFN2_F8
#define FFN2_F8 1
#endif
constexpr int N_PHASES = 32;
struct Args { const float* in[N_IN]; float* out; unsigned char* ws; int ph_lo, ph_hi; };
static_assert(sizeof(Args) == N_IN * 8 + 8 + 8 + 8, "Args has no padding holes");

__global__ void __launch_bounds__(NWAVES * 64, 2) fwd_kernel(Args args) {
    extern __shared__ __attribute__((aligned(16))) unsigned char lds[];
    Frame F;
    F.lds = (LAS unsigned char*)lds;
    F.MISC = (volatile LAS unsigned*)(F.lds + MISC_OFF);
    F.tid = threadIdx.x; F.lane = F.tid & 63; F.wave = __builtin_amdgcn_readfirstlane(F.tid >> 6);
    F.G = gridDim.x; F.bid = blockIdx.x;
    unsigned char* ws = args.ws;
    F.ctl = (gu32*)(ws + WS_CTL);
    if (F.tid < 64) F.MISC[F.tid] = 0u;
    __syncthreads();
    XcdBarrier bar; bar.bar = (unsigned*)(F.ctl + CW_BAR); bar.x = 0; bar.st = nullptr;
    if (!MK_SPLIT) bar = xcd_barrier_post((unsigned*)(F.ctl + CW_BAR), F.MISC + 8);
    const int lo = args.ph_lo, hi = args.ph_hi;
#ifndef CT_LO
#define CT_LO 0
#endif
#ifndef CT_HI
#define CT_HI 1000
#endif
#define IN(k) ((k) >= CT_LO && (k) < CT_HI && lo <= (k) && (k) < hi)
#ifndef PROBE_MASK
#define PROBE_MASK 0ull
#endif
#define NREP(k) ((((unsigned long long)(PROBE_MASK) >> (k)) & 1ull) ? 2 : 1)
#define SEAM(k) do { if (!MK_SPLIT && IN(k) && IN((k) + 1)) xcd_barrier(bar); } while (0)
#define WSP(T, off) ((T*)(ws + (off)))
#define GEMM_STATIC(EPI_T, Ap, Bp, M_, N_, K_, ...) do { pg8::Gemm g{(const pg8::bf16_t*)(Ap), (const pg8::bf16_t*)(Bp), M_, N_, K_, 0}; pg8::StaticOrder S; S.init(M_, N_, F.G, F.bid); \
        EPI_T E{__VA_ARGS__}; pg8::gemm_phase<EPI_T, pg8::StaticOrder, PG8_ALIGN, PG8_SP2>(F.lds + RING_OFF, g, S, E); } while (0)
#define GEMM_STATIC_LDA(EPI_T, Ap, lda_, Bp, M_, N_, K_, ...) do { pg8::Gemm g{(const pg8::bf16_t*)(Ap), (const pg8::bf16_t*)(Bp), M_, N_, K_, 0, lda_}; pg8::StaticOrder S; S.init(M_, N_, F.G, F.bid); \
        EPI_T E{__VA_ARGS__}; pg8::gemm_phase<EPI_T, pg8::StaticOrder, PG8_ALIGN, PG8_SP2>(F.lds + RING_OFF, g, S, E); } while (0)
#define GEMM_STATIC_F8(EPI_T, Ap, Bp, M_, N_, K_, ...) do { pg8::Gemm g{(const pg8::bf16_t*)(Ap), (const pg8::bf16_t*)(Bp), M_, N_, K_, 0}; pg8::StaticOrder S; S.init(M_, N_, F.G, F.bid); \
        EPI_T E{__VA_ARGS__}; pg8::gemm_phase<EPI_T, pg8::StaticOrder, PG8_ALIGN, PG8_SP2, true>(F.lds + RING_OFF, g, S, E); } while (0)
#define GEMM_MOE(EPI_T, Ap, Bp, N_, K_, ...) do { if (MK_SPLIT) moe_layout(F, WSP(int, WS_WGCNT), (LAS int*)(F.lds + RING_OFF));     \
        pg8::Gemm g{(const pg8::bf16_t*)(Ap), (const pg8::bf16_t*)(Bp), 0, N_, K_, (size_t)(N_) * (K_) * 2}; pg8::MoeOrder S; const int nblk_ = (int)F.MISC[24]; S.so.init(nblk_ * 256, N_, F.G, F.bid); \
        _Pragma("unroll") for (int j_ = 0; j_ < 8; ++j_) S.pend[j_] = __builtin_amdgcn_readfirstlane((int)F.MISC[16 + j_]); \
        __syncthreads(); EPI_T E{__VA_ARGS__}; pg8::gemm_phase<EPI_T, pg8::MoeOrder, PG8_ALIGN, PG8_SP2, true>(F.lds + RING_OFF, g, S, E); } while (0)
    const float* const* in = args.in;
    const bool M3_SPLIT = (F.G == 256) && !MK_SPLIT && lo == 0 && hi >= N_PHASES;
    bf16* H = WSP(bf16, WS_H); bf16* XB = WSP(bf16, WS_XB); bf16* BIG = WSP(bf16, WS_BIG); bf16* XR = WSP(bf16, WS_XR);
    float* SS = WSP(float, WS_SS);
#define SSQ(s) (SS + (size_t)(s) * NTOK * pg8::SSW)
    const float QS = 0.125f * LOG2E;
    const int gw = F.bid * NWAVES + F.wave, NGW = F.G * NWAVES;
    LAS float* scr = (LAS float*)(F.lds + RING_OFF + F.wave * 16384);
#define PH(k) if (IN(k)) for (int rep_ = 0; rep_ < NREP(k); ++rep_)

    PH(0) {
        int base = 0;
        if (QKVA_F8) conv_matrix_f8q(in[I_A_WQKV], DM, 4608, ws + W_QKV_A, MAP_ID, F8_SW1, 1536, QS, in[I_A_NORM], scr, gw, NGW, base, F.lane);
        else conv_matrix(in[I_A_WQKV], DM, 4608, WSP(bf16, W_QKV_A), MAP_ID, 1536, QS, in[I_A_NORM], scr, gw, NGW, base, F.lane);
        conv_matrix(in[I_A_WO], 512, DM, WSP(bf16, W_O_A), MAP_ID, 0, 1.f, nullptr, scr, gw, NGW, base, F.lane);
        conv_matrix(in[I_F0_WG], DM, FFD, WSP(bf16, W_GU0), MAP_GATE, 0, 1.f, in[I_F0_NORM], scr, gw, NGW, base, F.lane);
        conv_matrix(in[I_F0_WU], DM, FFD, WSP(bf16, W_GU0), MAP_UP, 0, 1.f, in[I_F0_NORM], scr, gw, NGW, base, F.lane);
        conv_matrix(in[I_F0_WD], FFD, DM, WSP(bf16, W_D0), MAP_ID, 0, 1.f, nullptr, scr, gw, NGW, base, F.lane);
        conv_matrix(in[I_B_WQKV], DM, 3072, WSP(bf16, W_QKV_B), MAP_ID, 1024, QS, in[I_B_NORM], scr, gw, NGW, base, F.lane);
        conv_matrix(in[I_B_WO], DM, DM, WSP(bf16, W_O_B), MAP_ID, 0, 1.f, nullptr, scr, gw, NGW, base, F.lane);
        conv_matrix(in[I_C_WIN], DM, 672, WSP(bf16, W_IN_C), MAP_CIN, 0, 1.f, in[I_C_NORM], scr, gw, NGW, base, F.lane);
        conv_matrix(in[I_C_WQUP], 384, 1536, WSP(bf16, W_QUP_C), MAP_CQUP, 1536, 0.10206207261596575f * LOG2E, in[I_C_QNORM], scr, gw, NGW, base, F.lane);
        conv_matrix(in[I_C_WKVUP], 256, 2048, WSP(bf16, W_KVUP_C), MAP_CKVUP, 0, 1.f, in[I_C_KVNORM], scr, gw, NGW, base, F.lane);
        if (WOC_F8) conv_matrix_f8(in[I_C_WO], DM, DM, ws + W_O_C, MAP_ID, F8_SW1, nullptr, scr, gw, NGW, base, F.lane); else conv_matrix(in[I_C_WO], DM, DM, WSP(bf16, W_O_C), MAP_ID, 0, 1.f, nullptr, scr, gw, NGW, base, F.lane);
        if (FFN2_F8) { conv_matrix_f8(in[I_F2_WG], DM, FFD, ws + W_GU2, MAP_GATE, F8_SW1, in[I_F2_NORM], scr, gw, NGW, base, F.lane); conv_matrix_f8(in[I_F2_WU], DM, FFD, ws + W_GU2, MAP_UP, F8_SW1, in[I_F2_NORM], scr, gw, NGW, base, F.lane);
                       conv_matrix_f8(in[I_F2_WD], FFD, DM, ws + W_D2, MAP_ID, F8_SW2, nullptr, scr, gw, NGW, base, F.lane); }
        else { conv_matrix(in[I_F2_WG], DM, FFD, WSP(bf16, W_GU2), MAP_GATE, 0, 1.f, in[I_F2_NORM], scr, gw, NGW, base, F.lane); conv_matrix(in[I_F2_WU], DM, FFD, WSP(bf16, W_GU2), MAP_UP, 0, 1.f, in[I_F2_NORM], scr, gw, NGW, base, F.lane);
               conv_matrix(in[I_F2_WD], FFD, DM, WSP(bf16, W_D2), MAP_ID, 0, 1.f, nullptr, scr, gw, NGW, base, F.lane); }
        if (QKVD_F8) conv_matrix_f8q(in[I_D_WQKV], DM, 3072, ws + W_QKV_D, MAP_ID, F8_SW1, 1024, QS, in[I_D_NORM], scr, gw, NGW, base, F.lane);
        else conv_matrix(in[I_D_WQKV], DM, 3072, WSP(bf16, W_QKV_D), MAP_ID, 1024, QS, in[I_D_NORM], scr, gw, NGW, base, F.lane);
        if (WOD_F8) conv_matrix_f8(in[I_D_WO], DM, DM, ws + W_O_D, MAP_ID, F8_SW1, nullptr, scr, gw, NGW, base, F.lane); else conv_matrix(in[I_D_WO], DM, DM, WSP(bf16, W_O_D), MAP_ID, 0, 1.f, nullptr, scr, gw, NGW, base, F.lane);
        conv_moe(in[I_M1_WG], in[I_M1_WU], in[I_M1_WD], in[I_M1_NORM], ws + W_MOE_GU, ws + W_MOE_D, scr, gw, NGW, F.lane);
        conv_moe(in[I_M3_WG], in[I_M3_WU], in[I_M3_WD], in[I_M3_NORM], ws + W_MOE_GU + W_MOE_L2, ws + W_MOE_D + W_MOE_L2, scr, gw, NGW, F.lane, 0, M3_SPLIT ? 4 : NEXP);
        { GAS v4u* z = (GAS v4u*)(ws + W_IN_C + (size_t)672 * DM * 2); const v4u zz = {0u, 0u, 0u, 0u};
          for (int i = F.bid * NWAVES * 64 + F.tid; i < 96 * DM * 2 / 16; i += F.G * NWAVES * 64) z[i] = zz; }
        { float* tab = WSP(float, WS_ROPE);
          for (int i = F.bid * NWAVES * 64 + F.tid; i < SEQ * 16; i += F.G * NWAVES * 64) { const int pos = i >> 4, fi = i & 15;
              const float inv = exp2f(-(float)fi * (13.287712379549449f / 16.0f)); const float ang = (float)pos * inv;
              const double rev = (double)ang * 0.15915494309189535; const float fr = (float)(rev - floor(rev + 0.5));
              tab[2 * i] = __builtin_amdgcn_cosf(fr); tab[2 * i + 1] = __builtin_amdgcn_sinf(fr); } }
        { float* gwr = WSP(float, WS_GWR);
          for (int i = F.bid * NWAVES * 64 + F.tid; i < 2 * DM * 8; i += F.G * NWAVES * 64) { const int l = i >> 13, j = i & 8191;
              gwr[i] = (l ? in[I_M3_WR] : in[I_M1_WR])[j] * (l ? in[I_M3_NORM] : in[I_M1_NORM])[j >> 3]; } }
        row_phase<0>(F, in[I_X], XR, SSQ(0), nullptr, nullptr, nullptr, nullptr, nullptr, nullptr, nullptr, nullptr, QKVA_F8 ? (unsigned char*)XB : nullptr);
    }
    SEAM(0);
    PH(1) { if (QKVA_F8) GEMM_STATIC_F8(pg8::EpiBf16, XB, ws + W_QKV_A, NTOK, 4608, DM / 2, BIG, 4608, SSQ(0), 1.0f / (F8_SA * F8_SW1)); else GEMM_STATIC(pg8::EpiBf16, XR, ws + W_QKV_A, NTOK, 4608, DM, BIG, 4608, SSQ(0), 1.0f); }
    SEAM(1);
    PH(2) { fast_attn_a(F, BIG, XB, WSP(float, WS_XB + 96 * MiB)); }
    SEAM(2);
    PH(3) { merge_a(F, XB, WSP(float, WS_XB + 96 * MiB), H); }
    SEAM(3);
    PH(4) GEMM_STATIC(pg8::EpiResidB, H, ws + W_O_A, NTOK, DM, 512, XR, DM, 1.0f, SSQ(1), (PG8_LAS float*)(F.lds + RESTAB_OFF), nullptr, 0.0f);
    SEAM(4);
    PH(5) GEMM_STATIC(pg8::EpiSwiglu, XR, ws + W_GU0, NTOK, 2 * FFD, DM, BIG, FFD, SSQ(1));
    SEAM(5);
    PH(6) GEMM_STATIC(pg8::EpiResidB, BIG, ws + W_D0, NTOK, DM, FFD, XR, DM, 1.0f, SSQ(2), (PG8_LAS float*)(F.lds + RESTAB_OFF), nullptr, 0.0f);
    SEAM(6);
    PH(7) GEMM_STATIC(pg8::EpiBf16, XR, ws + W_QKV_B, NTOK, 3072, DM, BIG, 3072, SSQ(2), 1.0f);
    SEAM(7);
    PH(8) { knorm_phase(F, BIG, WSP(float, WS_KN)); }
    SEAM(8);
    PH(9) { fast_attn_b(F, BIG, WSP(float, WS_KN), (unsigned*)(F.ctl + CW_QB), H, in[I_B_LQ1], in[I_B_LK1], in[I_B_LQ2], in[I_B_LK2], in[I_B_SUBLN]); }
    SEAM(9);
    PH(10) GEMM_STATIC(pg8::EpiResidB, H, ws + W_O_B, NTOK, DM, DM, XR, DM, 1.0f, SSQ(3), (PG8_LAS float*)(F.lds + RESTAB_OFF), nullptr, 0.0f);
    SEAM(10);
    PH(11) row_phase<1>(F, nullptr, XR, SSQ(3), nullptr, nullptr, nullptr, nullptr, WSP(float, WS_GWR), WSP(int, WS_TOKE), WSP(float, WS_TOKG), WSP(int, WS_WGCNT));
    SEAM(11);
    PH(12) { LAS int* tot = (LAS int*)(F.lds + RING_OFF); moe_layout(F, WSP(int, WS_WGCNT), tot); slot_phase(F, tot, WSP(int, WS_TOKE), WSP(float, WS_TOKG), WSP(int, WS_TOKS), WSP(float, WS_SGATE), WSP(float, WS_SSS), SSQ(3), XR, (unsigned char*)XB); }
    SEAM(12);
    PH(13) GEMM_MOE(pg8::EpiSwigluF8, XB, ws + W_MOE_GU, 2 * FFE, DM / 2, (unsigned char*)BIG, FFE, 1.0f / (F8_SA * F8_SW1), F8_SACT, WSP(float, WS_SSS), nullptr);
    SEAM(13);
    PH(14) { if (MOE_Y8) GEMM_MOE(pg8::EpiMoeDownF8, BIG, ws + W_MOE_D, DM, FFE / 2, (unsigned char*)XB, DM, WSP(float, WS_SGATE), F8_SY / (F8_SACT * F8_SW2)); else GEMM_MOE(pg8::EpiMoeDown, BIG, ws + W_MOE_D, DM, FFE / 2, XB, DM, WSP(float, WS_SGATE), 1.0f / (F8_SACT * F8_SW2));
             if (M3_SPLIT && F.bid >= 32) conv_moe(in[I_M3_WG], in[I_M3_WU], in[I_M3_WD], in[I_M3_NORM], ws + W_MOE_GU + W_MOE_L2, ws + W_MOE_D + W_MOE_L2, scr, (F.bid - 32) * NWAVES + F.wave, (F.G - 32) * NWAVES, F.lane, 5, 8); }
    SEAM(14);
    PH(15) row_phase<2>(F, nullptr, XR, SSQ(4), nullptr, nullptr, XB, WSP(int, WS_TOKS), nullptr, nullptr, nullptr, nullptr);
    SEAM(15);
    PH(16) { GEMM_STATIC(pg8::EpiLat, XR, ws + W_IN_C, NTOK, 768, DM, WSP(bf16, C_LAT), SSQ(4), SSQ(8), SSQ(9), (PG8_LAS float*)(F.lds + RESTAB_OFF));
             if (M3_SPLIT && F.bid >= 128) conv_moe(in[I_M3_WG], in[I_M3_WU], in[I_M3_WD], in[I_M3_NORM], ws + W_MOE_GU + W_MOE_L2, ws + W_MOE_D + W_MOE_L2, scr, (F.bid - 128) * NWAVES + F.wave, (F.G - 128) * NWAVES, F.lane, 4, 5); }
    SEAM(16);
    PH(17) { kpe_phase(F, WSP(bf16, C_LAT), WSP(float, WS_ROPE), WSP(bf16, C_KPE));
             GEMM_STATIC_LDA(pg8::EpiBf16, ws + C_LAT, 768, ws + W_QUP_C, NTOK, 1536, 384, WSP(bf16, C_Q), 1536, SSQ(8), 1.0f);
             GEMM_STATIC_LDA(pg8::EpiBf16, ws + C_LAT + 384 * 2, 768, ws + W_KVUP_C, NTOK, 2048, 256, WSP(bf16, C_KV), 2048, SSQ(9), 1.0f); }
    SEAM(19);
    PH(20) { fast_attn_c(F, WSP(bf16, C_Q), WSP(bf16, C_KV), WSP(bf16, C_KPE), WSP(float, WS_ROPE), H); }
    SEAM(20);
    PH(21) { if (FFN2_F8 && WOC_F8) GEMM_STATIC_F8(pg8::EpiResidB8, H, ws + W_O_C, NTOK, DM, DM / 2, XR, DM, 1.0f / (F8_SA * F8_SW1), SSQ(5), (PG8_LAS float*)(F.lds + RESTAB_OFF), (unsigned char*)XB, F8_SA);
             else if (FFN2_F8) GEMM_STATIC(pg8::EpiResidB8, H, ws + W_O_C, NTOK, DM, DM, XR, DM, 1.0f, SSQ(5), (PG8_LAS float*)(F.lds + RESTAB_OFF), (unsigned char*)XB, F8_SA); else GEMM_STATIC(pg8::EpiResidB, H, ws + W_O_C, NTOK, DM, DM, XR, DM, 1.0f, SSQ(5), (PG8_LAS float*)(F.lds + RESTAB_OFF), nullptr, 0.0f); }
    SEAM(21);
    PH(22) { if (FFN2_F8) GEMM_STATIC_F8(pg8::EpiSwigluF8, XB, ws + W_GU2, NTOK, 2 * FFD, DM / 2, (unsigned char*)BIG, FFD, 1.0f / (F8_SA * F8_SW1), F8_SACT, nullptr, SSQ(5)); else GEMM_STATIC(pg8::EpiSwiglu, XR, ws + W_GU2, NTOK, 2 * FFD, DM, BIG, FFD, SSQ(5)); }
    SEAM(22);
    PH(23) { if (FFN2_F8 && QKVD_F8) GEMM_STATIC_F8(pg8::EpiResidB8, BIG, ws + W_D2, NTOK, DM, FFD / 2, XR, DM, 1.0f / (F8_SACT * F8_SW2), SSQ(6), (PG8_LAS float*)(F.lds + RESTAB_OFF), (unsigned char*)XB, F8_SA);
             else if (FFN2_F8) GEMM_STATIC_F8(pg8::EpiResidB, BIG, ws + W_D2, NTOK, DM, FFD / 2, XR, DM, 1.0f / (F8_SACT * F8_SW2), SSQ(6), (PG8_LAS float*)(F.lds + RESTAB_OFF), nullptr, 0.0f);
             else GEMM_STATIC(pg8::EpiResidB, BIG, ws + W_D2, NTOK, DM, FFD, XR, DM, 1.0f, SSQ(6), (PG8_LAS float*)(F.lds + RESTAB_OFF), nullptr, 0.0f); }
    SEAM(23);
    PH(24) { if (QKVD_F8) GEMM_STATIC_F8(pg8::EpiBf16, XB, ws + W_QKV_D, NTOK, 3072, DM / 2, BIG, 3072, SSQ(6), 1.0f / (F8_SA * F8_SW1)); else GEMM_STATIC(pg8::EpiBf16, XR, ws + W_QKV_D, NTOK, 3072, DM, BIG, 3072, SSQ(6), 1.0f); }
    SEAM(24);
    PH(25) { fast_attn_d(F, BIG, H); }
    SEAM(25);
    PH(26) { if (WOD_F8) GEMM_STATIC_F8(pg8::EpiResidB, H, ws + W_O_D, NTOK, DM, DM / 2, XR, DM, 1.0f / (F8_SA * F8_SW1), SSQ(7), (PG8_LAS float*)(F.lds + RESTAB_OFF), nullptr, 0.0f);
             else GEMM_STATIC(pg8::EpiResidB, H, ws + W_O_D, NTOK, DM, DM, XR, DM, 1.0f, SSQ(7), (PG8_LAS float*)(F.lds + RESTAB_OFF), nullptr, 0.0f); }
    SEAM(26);
    PH(27) row_phase<1>(F, nullptr, XR, SSQ(7), nullptr, nullptr, nullptr, nullptr, WSP(float, WS_GWR) + DM * 8, WSP(int, WS_TOKE), WSP(float, WS_TOKG), WSP(int, WS_WGCNT));
    SEAM(27);
    PH(28) { LAS int* tot = (LAS int*)(F.lds + RING_OFF); moe_layout(F, WSP(int, WS_WGCNT), tot); slot_phase(F, tot, WSP(int, WS_TOKE), WSP(float, WS_TOKG), WSP(int, WS_TOKS), WSP(float, WS_SGATE), WSP(float, WS_SSS), SSQ(7), XR, (unsigned char*)XB); }
    SEAM(28);
    PH(29) GEMM_MOE(pg8::EpiSwigluF8, XB, ws + W_MOE_GU + W_MOE_L2, 2 * FFE, DM / 2, (unsigned char*)BIG, FFE, 1.0f / (F8_SA * F8_SW1), F8_SACT, WSP(float, WS_SSS), nullptr);
    SEAM(29);
    PH(30) { if (MOE_Y8) GEMM_MOE(pg8::EpiMoeDownF8, BIG, ws + W_MOE_D + W_MOE_L2, DM, FFE / 2, (unsigned char*)XB, DM, WSP(float, WS_SGATE), F8_SY / (F8_SACT * F8_SW2)); else GEMM_MOE(pg8::EpiMoeDown, BIG, ws + W_MOE_D + W_MOE_L2, DM, FFE / 2, XB, DM, WSP(float, WS_SGATE), 1.0f / (F8_SACT * F8_SW2)); }
    SEAM(30);
    PH(31) row_phase<3>(F, nullptr, XR, nullptr, in[I_FINAL_NORM], args.out, XB, WSP(int, WS_TOKS), nullptr, nullptr, nullptr, nullptr);
#undef IN
#undef SEAM
}

extern "C" void kernel_launch(void* const* d_in, const int* in_sizes, int n_in, void* d_out, int out_size, void* d_ws, size_t ws_size, hipStream_t stream) {
    static int grid = 0;
    if (grid == 0) {
        if (n_in != N_IN || out_size != NTOK * DM || ws_size < WS_SSS + 5 * MiB) { fprintf(stderr, "kernel_launch: unexpected problem shape (n_in %d, out %d, ws %zu)\n", n_in, out_size, ws_size); grid = -1; return; }
        int dev = 0, cus = 0, per_cu = 0;
        if (hipGetDevice(&dev) != hipSuccess || hipDeviceGetAttribute(&cus, hipDeviceAttributeMultiprocessorCount, dev) != hipSuccess) { grid = -1; return; }
        if (hipFuncSetAttribute((const void*)fwd_kernel, hipFuncAttributeMaxDynamicSharedMemorySize, LDS_BYTES) != hipSuccess) { fprintf(stderr, "kernel_launch: hipFuncSetAttribute failed\n"); grid = -1; return; }
        if (hipOccupancyMaxActiveBlocksPerMultiprocessor(&per_cu, (const void*)fwd_kernel, NWAVES * 64, LDS_BYTES) != hipSuccess || per_cu < 1) { fprintf(stderr, "kernel_launch: occupancy query reports %d\n", per_cu); }
        (void)hipGetLastError();
        grid = cus;
    }
    if (grid < 0) return;
    (void)hipMemsetAsync((char*)d_ws + WS_CTL, 0, CTL_ZERO_BYTES, stream);
    Args a{};
    for (int i = 0; i < N_IN; ++i) a.in[i] = (const float*)d_in[i];
    a.out = (float*)d_out; a.ws = (unsigned char*)d_ws;
#if MK_SPLIT
    for (int p = 0; p < N_PHASES; ++p) { a.ph_lo = p; a.ph_hi = p + 1; hipLaunchKernelGGL(fwd_kernel, dim3(grid), dim3(NWAVES * 64), LDS_BYTES, stream, a); }
#else
    a.ph_lo = 0; a.ph_hi = N_PHASES;
    hipLaunchKernelGGL(fwd_kernel, dim3(grid), dim3(NWAVES * 64), LDS_BYTES, stream, a);
#endif
}
```
